# Optimizing an MI355X kernel written in HIP

```python
import math
import jax, jax.numpy as jnp
from jax import lax
import numpy as np

D_MODEL = 1024
BATCH = 8
SEQ = 4096
DEPTH = 1

CHUNK = 64
D_MIX = D_MODEL
D_A = D_MIX // 2
D_B = D_MIX - D_A
H_A = 8
DH_A = D_A // H_A
H_B = 8
DH_B = D_B // H_B
SGU_BLOCK = 128
Q_BLOCK = 128
D_FF = 2816
N_SUB = 3
OFF_Z_A = 0
OFF_Q = 2 * D_A
OFF_K = OFF_Q + D_B
OFF_V = OFF_K + D_B
OFF_F = OFF_V + D_B
N_IN = OFF_F + H_B
EPS = 1e-6
NEG_INF = -1e30

kernel_name = 'hybrid_sgu_fox_macaron_block'


def rms_norm(x, g):
    xf = x.astype(jnp.float32)
    y = xf * lax.rsqrt(jnp.mean(xf * xf, axis=-1, keepdims=True) + EPS)
    return (y * g.astype(jnp.float32)).astype(x.dtype)


def layer_norm(x, g, b):
    xf = x.astype(jnp.float32)
    mu = jnp.mean(xf, axis=-1, keepdims=True)
    xc = xf - mu
    y = xc * lax.rsqrt(jnp.mean(xc * xc, axis=-1, keepdims=True) + EPS)
    return (y * g.astype(jnp.float32) + b.astype(jnp.float32)).astype(x.dtype)


def modulate(x, g_pre, shift, scale):
    return rms_norm(x, g_pre) * (1 + scale[:, None, :]) + shift[:, None, :]


def swiglu(h, w_gate, w_up, w_down):
    return (jax.nn.silu(h @ w_gate) * (h @ w_up)) @ w_down


def spatial_gating(z, ln_g, ln_b, w_s, b_s):
    b_, s_, _ = z.shape
    z = jax.nn.gelu(z)
    u, v = z[..., :D_A], z[..., D_A:]
    v = layer_norm(v, ln_g, ln_b)
    v = v.reshape(b_, s_ // SGU_BLOCK, SGU_BLOCK, H_A, DH_A)
    pos = jnp.arange(SGU_BLOCK)
    mask = (pos[None, :] // CHUNK) <= (pos[:, None] // CHUNK)
    w = jnp.where(mask[None], w_s, jnp.zeros((), w_s.dtype))
    gate = jnp.einsum('hij,bnjhc->bnihc', w, v) + b_s.T[None, None, :, :, None]
    return u * gate.reshape(b_, s_, D_A)


def forgetting_attention(q, k, v, log_f):
    s_ = q.shape[2]
    cum = jnp.cumsum(log_f, axis=-1)
    scale = DH_B ** -0.5
    outs = []
    for blk in range(s_ // Q_BLOCK):
        q0 = blk * Q_BLOCK
        q1 = q0 + Q_BLOCK
        logits = jnp.einsum('bhqd,bhkd->bhqk', q[:, :, q0:q1], k[:, :, :q1]).astype(jnp.float32) * scale
        logits = logits + cum[:, :, q0:q1, None] - cum[:, :, None, :q1]
        qpos = q0 + jnp.arange(Q_BLOCK)
        kpos = jnp.arange(q1)
        logits = jnp.where(kpos[None, :] <= qpos[:, None], logits, NEG_INF)
        p = jax.nn.softmax(logits, axis=-1).astype(v.dtype)
        outs.append(jnp.einsum('bhqk,bhkd->bhqd', p, v[:, :, :q1]))
    return jnp.concatenate(outs, axis=2)


def hybrid_mixer(h, w_in, sgu_ln_g, sgu_ln_b, sgu_w, sgu_b, fox_b_f, gnorm_a_g, gnorm_b_g, w_out):
    b_, s_, _ = h.shape
    proj = h @ w_in
    y_a = spatial_gating(proj[..., OFF_Z_A:OFF_Q], sgu_ln_g, sgu_ln_b, sgu_w, sgu_b)

    def heads(t):
        return t.reshape(b_, s_, H_B, DH_B).transpose(0, 2, 1, 3)

    q = heads(proj[..., OFF_Q:OFF_K])
    k = heads(proj[..., OFF_K:OFF_V])
    v = heads(proj[..., OFF_V:OFF_F])
    log_f = jax.nn.log_sigmoid(proj[..., OFF_F:N_IN].astype(jnp.float32)
                               + fox_b_f.astype(jnp.float32)).transpose(0, 2, 1)
    y_b = forgetting_attention(q, k, v, log_f).transpose(0, 2, 1, 3).reshape(b_, s_, D_B)
    y = jnp.concatenate([rms_norm(y_a, gnorm_a_g), rms_norm(y_b, gnorm_b_g)], axis=-1)
    return y @ w_out


def setup_inputs(seed: int = 0) -> dict:
    key = jax.random.key(seed)
    ks = jax.random.split(key, 20)
    f32 = jnp.float32
    n = lambda k, shape, s: jax.random.normal(k, shape, f32) * s
    return {
        'x': n(ks[0], (BATCH, SEQ, D_MODEL), 1.0),
        'c': n(ks[1], (BATCH, D_MODEL), 1.0),
        'w_ada': n(ks[2], (DEPTH, D_MODEL, N_SUB * 3 * D_MODEL), 0.1 * D_MODEL ** -0.5),
        'b_ada': n(ks[3], (DEPTH, N_SUB * 3 * D_MODEL), 0.01),
        'norm_pre_g': 1.0 + n(ks[4], (DEPTH, N_SUB, D_MODEL), 0.02),
        'norm_post_g': 1.0 + n(ks[5], (DEPTH, N_SUB, D_MODEL), 0.02),
        'ffn_w_gate': n(ks[6], (DEPTH, 2, D_MODEL, D_FF), D_MODEL ** -0.5),
        'ffn_w_up': n(ks[7], (DEPTH, 2, D_MODEL, D_FF), D_MODEL ** -0.5),
        'ffn_w_down': n(ks[8], (DEPTH, 2, D_FF, D_MODEL), D_FF ** -0.5),
        'w_in': n(ks[9], (DEPTH, D_MODEL, N_IN), D_MODEL ** -0.5),
        'sgu_ln_g': 1.0 + n(ks[10], (DEPTH, D_A), 0.02),
        'sgu_ln_b': n(ks[11], (DEPTH, D_A), 0.02),
        'sgu_w': n(ks[12], (DEPTH, H_A, SGU_BLOCK, SGU_BLOCK), SGU_BLOCK ** -0.5),
        'sgu_b': 1.0 + n(ks[13], (DEPTH, H_A, SGU_BLOCK), 0.02),
        'fox_b_f': 2.0 + n(ks[14], (DEPTH, H_B), 0.5),
        'gnorm_a_g': 1.0 + n(ks[15], (DEPTH, D_A), 0.02),
        'gnorm_b_g': 1.0 + n(ks[16], (DEPTH, D_B), 0.02),
        'w_out': n(ks[17], (DEPTH, D_MIX, D_MODEL), D_MIX ** -0.5),
    }


def reference(x, c, w_ada, b_ada, norm_pre_g, norm_post_g, ffn_w_gate, ffn_w_up, ffn_w_down,
              w_in, sgu_ln_g, sgu_ln_b, sgu_w, sgu_b, fox_b_f, gnorm_a_g, gnorm_b_g, w_out):
    b_ = x.shape[0]
    for l in range(DEPTH):
        mod = (jax.nn.silu(c) @ w_ada[l] + b_ada[l]).reshape(b_, N_SUB, 3, D_MODEL)
        shift, scale, gate = mod[:, :, 0], mod[:, :, 1], mod[:, :, 2]

        h = modulate(x, norm_pre_g[l, 0], shift[:, 0], scale[:, 0])
        h = swiglu(h, ffn_w_gate[l, 0], ffn_w_up[l, 0], ffn_w_down[l, 0])
        x = x + 0.5 * (1 + gate[:, 0, None, :]) * rms_norm(h, norm_post_g[l, 0])

        h = modulate(x, norm_pre_g[l, 1], shift[:, 1], scale[:, 1])
        h = hybrid_mixer(h, w_in[l], sgu_ln_g[l], sgu_ln_b[l], sgu_w[l], sgu_b[l], fox_b_f[l],
                         gnorm_a_g[l], gnorm_b_g[l], w_out[l])
        x = x + (1 + gate[:, 1, None, :]) * rms_norm(h, norm_post_g[l, 1])

        h = modulate(x, norm_pre_g[l, 2], shift[:, 2], scale[:, 2])
        h = swiglu(h, ffn_w_gate[l, 1], ffn_w_up[l, 1], ffn_w_down[l, 1])
        x = x + 0.5 * (1 + gate[:, 2, None, :]) * rms_norm(h, norm_post_g[l, 2])
    return x
```

```cpp
#include <hip/hip_runtime.h>
#include <hip/hip_cooperative_groups.h>
#include <hip/hip_bf16.h>
#include <cstdio>
#include <cstdint>
#include <cmath>
namespace cg = cooperative_groups;
__device__ __forceinline__ int otid() { int t = threadIdx.x; asm volatile("" : "+v"(t)); return t; }
namespace pg8 {
#define PG8_LAS __attribute__((address_space(3)))
typedef unsigned short bf16_t;
typedef short bf16x8 __attribute__((ext_vector_type(8)));
typedef float f32x4 __attribute__((ext_vector_type(4)));
typedef unsigned u32x4 __attribute__((ext_vector_type(4)));
constexpr int BM = 256, BK = 64, HALF = 128, HTB = HALF * BK * 2  , STAGE_BYTES = 8 * HTB, NXCD = 8, WGM = 8;

__host__ __device__ __forceinline__ int lds_byte(int r, int c) { const int st = (r >> 4) * 2 + (c >> 5), rr = r & 15, cc = c & 31, ob = rr * 64 + cc * 2; return st * 1024 + (ob ^ (((ob >> 9) & 1) << 5)); }
__host__ __device__ __forceinline__ void stage_rc(int b, int& R, int& C) { const int st = b / 1024, sb = b % 1024, swz = sb ^ (((sb >> 9) & 1) << 5); R = (st >> 1) * 16 + swz / 64; C = (st & 1) * 32 + (swz % 64) / 2; }
__host__ __device__ __forceinline__ int perm32(int rho) { const int n = rho >> 4, i = rho & 15; return 8 * (i >> 2) + 4 * n + (i & 3); }

struct Unit { int pm, pn; };
struct Gemm { const bf16_t* A; const bf16_t* Bt; int M, N, K; };

struct StaticOrder {
    int nM, nN, nwg, G, c;
    __host__ __device__ void init(int M, int N, int G_, int c_) { nM = M / BM; nN = N / BM; nwg = nM * nN; G = G_; c = c_; }
    __host__ __device__ bool next(int i, Unit& u) const {
        const long L = (long)i * G + c; if (L >= nwg) return false;
        int wgid = (int)L; { const int q = nwg / NXCD, r = nwg % NXCD, xcd = wgid % NXCD, off = wgid / NXCD; wgid = (xcd < r ? xcd * (q + 1) : r * (q + 1) + (xcd - r) * q) + off; }
        const int nig = WGM * nN, gid = wgid / nig, fm = gid * WGM, gsz = (nM - fm) < WGM ? (nM - fm) : WGM;
        u.pm = fm + ((wgid % nig) % gsz); u.pn = (wgid % nig) / gsz; return true;
    }
    __device__ __forceinline__ void a_ready(const Unit&) const {}
    __device__ __forceinline__ void done(const Unit&) const {}
};

__device__ __forceinline__ unsigned cvt_pk_bf16(float lo, float hi) { unsigned r; asm volatile("v_cvt_pk_bf16_f32 %0, %1, %2" : "=v"(r) : "v"(lo), "v"(hi)); return r; }
typedef float f32x2 __attribute__((ext_vector_type(2)));
__device__ __forceinline__ float fast_sigmoid(float t) { return __builtin_amdgcn_rcpf(1.0f + __builtin_amdgcn_exp2f(-1.4426950408889634f * t)); }
struct EpiSwiGLU {
    static constexpr bool PERM = true, AFTER_DRAIN = false;
    bf16_t* O; int ldc;
    __device__ __forceinline__ void operator()(const f32x4 (&acc)[2][2][4][2], const Unit& u, int wr, int wc, int fr, int fq) const {
        const int row0 = u.pm * BM + wr * 64 + fr; const int col0 = u.pn * HALF + wc * 32 + 8 * fq;
#pragma unroll
        for (int ai = 0; ai < 2; ++ai)
#pragma unroll
            for (int m = 0; m < 4; ++m) { bf16_t* rowp = O + (size_t)(row0 + ai * HALF + m * 16) * ldc + col0;
                float o[8];
#pragma unroll
                for (int n = 0; n < 2; ++n)
#pragma unroll
                    for (int e = 0; e < 4; ++e) { const float g = acc[ai][0][m][n][e], up = acc[ai][1][m][n][e]; o[n * 4 + e] = g * fast_sigmoid(g) * up; }
                u32x4 w; w.x = cvt_pk_bf16(o[0], o[1]); w.y = cvt_pk_bf16(o[2], o[3]); w.z = cvt_pk_bf16(o[4], o[5]); w.w = cvt_pk_bf16(o[6], o[7]);
                *(u32x4*)rowp = w; }
    }
};
struct EpiBf16Ss {
    static constexpr bool PERM = true, AFTER_DRAIN = false;
    bf16_t* O; int ldc; float* ss; int M;
    __device__ __forceinline__ void operator()(const f32x4 (&acc)[2][2][4][2], const Unit& u, int wr, int wc, int fr, int fq) const {
        const int row0 = u.pm * BM + wr * 64 + fr; const int col0 = u.pn * BM + wc * 32 + 8 * fq;
        float* ssp = ss + (size_t)(u.pn * 4 + wc) * M;
#pragma unroll
        for (int ai = 0; ai < 2; ++ai)
#pragma unroll
            for (int m = 0; m < 4; ++m) { const int row = row0 + ai * HALF + m * 16; bf16_t* rowp = O + (size_t)row * ldc + col0; float q = 0.f;
#pragma unroll
                for (int bj = 0; bj < 2; ++bj) { const f32x4 v0 = acc[ai][bj][m][0], v1 = acc[ai][bj][m][1];
                    q += (v0[0] * v0[0] + v0[1] * v0[1]) + (v0[2] * v0[2] + v0[3] * v0[3]) + (v1[0] * v1[0] + v1[1] * v1[1]) + (v1[2] * v1[2] + v1[3] * v1[3]);
                    u32x4 w; w.x = cvt_pk_bf16(v0[0], v0[1]); w.y = cvt_pk_bf16(v0[2], v0[3]); w.z = cvt_pk_bf16(v1[0], v1[1]); w.w = cvt_pk_bf16(v1[2], v1[3]);
                    *(u32x4*)(rowp + bj * HALF) = w; }
                q += __shfl_xor(q, 16); q += __shfl_xor(q, 32);
                if (fq == 0) ssp[row] = q; }
    }
};
struct EpiMixIn {
    static constexpr bool PERM = true, AFTER_DRAIN = false;
    bf16_t* ZG; bf16_t* Q; size_t qkv_stride; float qscale;
    __device__ __forceinline__ void operator()(const f32x4 (&acc)[2][2][4][2], const Unit& u, int wr, int wc, int fr, int fq) const {
        const int row0 = u.pm * BM + wr * 64 + fr;
        bf16_t* base; int ldc, colt; float sc = 1.f; const bool gelu = u.pn < 4;
        if (u.pn < 4) { base = ZG; ldc = 1024; colt = u.pn * BM; }
        else { const int t = (u.pn - 4) >> 1; base = Q + (size_t)t * qkv_stride; ldc = 512; colt = ((u.pn - 4) & 1) * BM; if (t == 0) sc = qscale; }
        const int col0 = colt + wc * 32 + 8 * fq;
#pragma unroll
        for (int ai = 0; ai < 2; ++ai)
#pragma unroll
            for (int m = 0; m < 4; ++m) { bf16_t* rowp = base + (size_t)(row0 + ai * HALF + m * 16) * ldc + col0;
#pragma unroll
                for (int bj = 0; bj < 2; ++bj) { float o[8];
#pragma unroll
                    for (int n = 0; n < 2; ++n)
#pragma unroll
                        for (int e = 0; e < 4; ++e) { float x = acc[ai][bj][m][n][e];
                            if (gelu) { const float t = 1.5957691216057308f * (x + 0.044715f * x * x * x); x = x * fast_sigmoid(t); } else x *= sc;
                            o[n * 4 + e] = x; }
                    u32x4 w; w.x = cvt_pk_bf16(o[0], o[1]); w.y = cvt_pk_bf16(o[2], o[3]); w.z = cvt_pk_bf16(o[4], o[5]); w.w = cvt_pk_bf16(o[6], o[7]);
                    *(u32x4*)(rowp + bj * HALF) = w; } }
    }
};

template <class Epi, class Sched, bool ALIGN_EPI = false, bool SP2 = false>
__device__ __forceinline__ void gemm_phase(PG8_LAS unsigned char* lds, const Gemm g, const Sched& S, const Epi& E) {
    const int tid = otid(), wid = __builtin_amdgcn_readfirstlane(tid >> 6), lane = tid & 63, wr = wid >> 2, wc = wid & 3, fr = lane & 15, fq = lane >> 4;
    const int K = g.K, nt = K / BK;
    unsigned voffA[2], voffB[2];
#pragma unroll
    for (int i = 0; i < 2; ++i) { int R, C; stage_rc(tid * 16 + i * 8192, R, C); const int Rb = Epi::PERM ? ((R & ~31) + perm32(R & 31)) : R;
        voffA[i] = (unsigned)(R * K + C) * 2u; voffB[i] = (unsigned)(Rb * K + C) * 2u; }
    const size_t kstep = (size_t)(BK * 2);
    const size_t hstep = (size_t)HALF * K * 2;
    const size_t tstep = 2 * hstep;
    const unsigned ldsw = (unsigned)wid * 1024u;
    const int aoff = lds_byte(wr * 64 + fr, fq * 8), boff = lds_byte(wc * 32 + fr, fq * 8);
#define PG8_SA(b, h) (((b) * 2 + (h)) * HTB)
#define PG8_SB(b, h) ((4 + (b) * 2 + (h)) * HTB)
#define PG8_STAGE(bufoff, gbase, voff) do { _Pragma("unroll") for (int _i = 0; _i < 2; ++_i) \
        __builtin_amdgcn_global_load_lds((const unsigned*)((const char*)(gbase) + (voff)[_i]), (PG8_LAS unsigned*)(lds + (bufoff) + ldsw + _i * 8192), 16, 0, 0); } while (0)
#define PG8_LDA(dst, b, h) do { _Pragma("unroll") for (int m = 0; m < 4; ++m) _Pragma("unroll") for (int k = 0; k < 2; ++k) dst[m][k] = *(const PG8_LAS bf16x8*)(lds + PG8_SA(b, h) + aoff + m * 2048 + k * 1024); } while (0)
#define PG8_LDB(dst, b, h) do { _Pragma("unroll") for (int n = 0; n < 2; ++n) _Pragma("unroll") for (int k = 0; k < 2; ++k) dst[n][k] = *(const PG8_LAS bf16x8*)(lds + PG8_SB(b, h) + boff + n * 2048 + k * 1024); } while (0)
#define PG8_MMA(ai, bj, At, Bt) do { __builtin_amdgcn_s_setprio(1); _Pragma("unroll") for (int m = 0; m < 4; ++m) _Pragma("unroll") for (int n = 0; n < 2; ++n) _Pragma("unroll") for (int k = 0; k < 2; ++k) \
        acc[ai][bj][m][n] = __builtin_amdgcn_mfma_f32_16x16x32_bf16(Bt[n][k], At[m][k], acc[ai][bj][m][n], 0, 0, 0); __builtin_amdgcn_s_setprio(0); } while (0)
#define PG8_WAIT_V(n) asm volatile("s_waitcnt vmcnt(" #n ")" ::: "memory")
#define PG8_WAIT_L(n) asm volatile("s_waitcnt lgkmcnt(" #n ")" ::: "memory")
#define PG8_BAR __builtin_amdgcn_s_barrier()
#define PG8_SCHED __builtin_amdgcn_sched_barrier(0)
    Unit cur, nxt; int ui = 0;
    if (!S.next(0, cur)) return;
    f32x4 acc[2][2][4][2];
#pragma unroll
    for (int a = 0; a < 2; ++a)
#pragma unroll
        for (int b = 0; b < 2; ++b)
#pragma unroll
            for (int m = 0; m < 4; ++m)
#pragma unroll
                for (int n = 0; n < 2; ++n) acc[a][b][m][n] = (f32x4){0.f, 0.f, 0.f, 0.f};
    bf16x8 At[4][2], B0[2][2], B1[2][2];
    const char* cA = (const char*)g.A + (size_t)cur.pm * tstep; const char* cB = (const char*)g.Bt + (size_t)cur.pn * tstep;
    S.a_ready(cur);
    if constexpr (SP2) {
        PG8_STAGE(PG8_SB(0, 0), cB, voffB); PG8_STAGE(PG8_SB(0, 1), cB + hstep, voffB); PG8_STAGE(PG8_SA(0, 0), cA, voffA); PG8_STAGE(PG8_SA(0, 1), cA + hstep, voffA);
        if (wr == 1) PG8_BAR;
        PG8_WAIT_V(2); PG8_BAR;
        PG8_STAGE(PG8_SB(1, 0), cB + kstep, voffB); PG8_STAGE(PG8_SA(1, 0), cA + kstep, voffA); PG8_STAGE(PG8_SB(1, 1), cB + hstep + kstep, voffB);
        PG8_WAIT_V(6); PG8_BAR;
    } else {
        PG8_STAGE(PG8_SB(0, 0), cB, voffB); PG8_STAGE(PG8_SA(0, 0), cA, voffA); PG8_STAGE(PG8_SB(0, 1), cB + hstep, voffB); PG8_STAGE(PG8_SA(0, 1), cA + hstep, voffA);
        if (wr == 1) PG8_BAR;
        PG8_WAIT_V(4); PG8_BAR;
        PG8_STAGE(PG8_SB(1, 0), cB + kstep, voffB); PG8_STAGE(PG8_SA(1, 0), cA + kstep, voffA); PG8_STAGE(PG8_SB(1, 1), cB + hstep + kstep, voffB);
        PG8_WAIT_V(6); PG8_BAR;
    }
    for (;;) {
        const bool has_next = S.next(ui + 1, nxt);
        const char* nA = has_next ? (const char*)g.A + (size_t)nxt.pm * tstep : cA; const char* nB = has_next ? (const char*)g.Bt + (size_t)nxt.pn * tstep : cB;
        for (int t = 0; t < nt; t += 2) {
            const bool last = (t == nt - 2);
            const char* a1 = cA + (size_t)(t + 1) * kstep;
            const char* a2 = last ? nA : cA + (size_t)(t + 2) * kstep; const char* b2 = last ? nB : cB + (size_t)(t + 2) * kstep;
            const char* a3 = a2 + kstep; const char* b3 = b2 + kstep;
            if (last && has_next) S.a_ready(nxt);
            if constexpr (SP2) {
            PG8_LDB(B0, 0, 0); PG8_LDB(B1, 0, 1); PG8_SCHED; PG8_LDA(At, 0, 0); PG8_STAGE(PG8_SA(1, 1), a1 + hstep, voffA);
            PG8_WAIT_V(8); PG8_WAIT_L(0); PG8_BAR; PG8_MMA(0, 0, At, B0); PG8_MMA(0, 1, At, B1); PG8_BAR; PG8_SCHED;
            PG8_LDA(At, 0, 1); PG8_STAGE(PG8_SB(0, 0), b2, voffB); PG8_STAGE(PG8_SB(0, 1), b2 + hstep, voffB); PG8_STAGE(PG8_SA(0, 0), a2, voffA);
            PG8_WAIT_V(8); PG8_WAIT_L(0); PG8_BAR; PG8_MMA(1, 0, At, B0); PG8_MMA(1, 1, At, B1); PG8_BAR; PG8_SCHED;
            PG8_LDB(B0, 1, 0); PG8_LDB(B1, 1, 1); PG8_SCHED; PG8_LDA(At, 1, 0); PG8_STAGE(PG8_SA(0, 1), a2 + hstep, voffA);
            PG8_WAIT_V(8); PG8_WAIT_L(0); PG8_BAR; PG8_MMA(0, 0, At, B0); PG8_MMA(0, 1, At, B1); PG8_BAR; PG8_SCHED;
            PG8_LDA(At, 1, 1); PG8_STAGE(PG8_SB(1, 0), b3, voffB); PG8_STAGE(PG8_SB(1, 1), b3 + hstep, voffB); PG8_STAGE(PG8_SA(1, 0), a3, voffA);
            PG8_WAIT_V(8); PG8_WAIT_L(0); PG8_BAR; PG8_MMA(1, 0, At, B0); PG8_MMA(1, 1, At, B1); PG8_BAR; PG8_SCHED;
            } else {
            PG8_LDB(B0, 0, 0); PG8_SCHED; PG8_LDA(At, 0, 0); PG8_STAGE(PG8_SA(1, 1), a1 + hstep, voffA);
            PG8_WAIT_L(8); PG8_BAR; PG8_WAIT_L(0); PG8_MMA(0, 0, At, B0); PG8_BAR; PG8_SCHED;
            PG8_LDB(B1, 0, 1); PG8_STAGE(PG8_SB(0, 0), b2, voffB);
            PG8_BAR; PG8_WAIT_L(0); PG8_MMA(0, 1, At, B1); PG8_BAR;
            PG8_LDA(At, 0, 1); PG8_STAGE(PG8_SA(0, 0), a2, voffA);
            PG8_BAR; PG8_WAIT_L(0); PG8_MMA(1, 0, At, B0); PG8_BAR; PG8_SCHED;
            PG8_STAGE(PG8_SB(0, 1), b2 + hstep, voffB);
            PG8_WAIT_V(6); PG8_BAR; PG8_MMA(1, 1, At, B1); PG8_BAR;
            PG8_LDB(B0, 1, 0); PG8_SCHED; PG8_LDA(At, 1, 0); PG8_STAGE(PG8_SA(0, 1), a2 + hstep, voffA);
            PG8_WAIT_L(8); PG8_BAR; PG8_WAIT_L(0); PG8_MMA(0, 0, At, B0); PG8_BAR; PG8_SCHED;
            PG8_LDB(B1, 1, 1); PG8_STAGE(PG8_SB(1, 0), b3, voffB);
            PG8_BAR; PG8_WAIT_L(0); PG8_MMA(0, 1, At, B1); PG8_BAR;
            PG8_LDA(At, 1, 1); PG8_STAGE(PG8_SA(1, 0), a3, voffA);
            PG8_BAR; PG8_WAIT_L(0); PG8_MMA(1, 0, At, B0); PG8_BAR; PG8_SCHED;
            PG8_STAGE(PG8_SB(1, 1), b3 + hstep, voffB);
            PG8_WAIT_V(6); PG8_BAR; PG8_MMA(1, 1, At, B1); PG8_BAR;
            }
        }
        if constexpr (ALIGN_EPI) { if (wr == 0) PG8_BAR; }
        if constexpr (!Epi::AFTER_DRAIN) { E(acc, cur, wr, wc, fr, fq); S.done(cur); }
        if (!has_next) break;
#pragma unroll
        for (int a = 0; a < 2; ++a)
#pragma unroll
            for (int b = 0; b < 2; ++b)
#pragma unroll
                for (int m = 0; m < 4; ++m)
#pragma unroll
                    for (int n = 0; n < 2; ++n) acc[a][b][m][n] = (f32x4){0.f, 0.f, 0.f, 0.f};
        cur = nxt; cA = nA; cB = nB; ++ui;
        if constexpr (ALIGN_EPI) { if (wr == 1) PG8_BAR; }
    }
    PG8_WAIT_V(0);
    if constexpr (!ALIGN_EPI) { if (wr == 0) PG8_BAR; }
    PG8_BAR;
    if constexpr (Epi::AFTER_DRAIN) { E.fused(acc, cur, wr, wc, fr, fq, lds, wid, lane); S.done(cur); }
#undef PG8_SA
#undef PG8_SB
#undef PG8_STAGE
#undef PG8_LDA
#undef PG8_LDB
#undef PG8_MMA
#undef PG8_WAIT_V
#undef PG8_WAIT_L
#undef PG8_BAR
#undef PG8_SCHED
}
}

#ifndef PG8_SP2
#define PG8_SP2 true
#endif
#ifndef PG8_ALIGN
#define PG8_ALIGN true
#endif
#include <hip/hip_bf16.h>
#include <cmath>
namespace attn_body {
using bf16=__hip_bfloat16;
using bf16x8=__attribute__((ext_vector_type(8)))short;
using s16x4=__attribute__((ext_vector_type(4)))short;
using f32x16=__attribute__((ext_vector_type(16)))float;
using u32x4=__attribute__((ext_vector_type(4)))unsigned;
using u32x2=__attribute__((ext_vector_type(2)))unsigned;
constexpr int BATCH=8,NHEAD=8,SEQ=4096,D=64,DM=NHEAD*D,OPITCH=1024;
constexpr int NW=8,QBLK=32,QB=QBLK*NW,KVBLK=64,NQB=SEQ/QB;
constexpr int ATTN_PITCH=DM, ATTN_UNIT_ROWS=QB;
__device__ __forceinline__ int crow(int r,int hi){return (r&3)+8*(r>>2)+4*hi;}
#define SBAR() __builtin_amdgcn_sched_barrier(0)
__device__ __forceinline__ void cmask(f32x16&p0,f32x16&p1,int jb,int qrel,int hi){
  const float NEG=-INFINITY; int kb=64*jb+4*hi;
  #pragma unroll
  for(int r=0;r<16;++r){int kv=kb+(r&3)+8*(r>>2); if(kv>qrel)p0[r]=NEG; if(kv+32>qrel)p1[r]=NEG;}
}

constexpr int NSLOT=3, SLOTB=8192;
constexpr int LDS_K=0, LDS_V=NSLOT*SLOTB, LDS_WS=2*NSLOT*SLOTB, LDS_OST=LDS_WS+NW*64*4, LDS_BIAS=LDS_OST+NW*4096, LDS_BYTES=LDS_BIAS+SEQ*8;
constexpr float C2=0.125f*1.4426950408889634f;
__device__ __forceinline__ void glds16(const void*gsrc,unsigned lds_dst){unsigned keep;
  asm volatile("s_mov_b32 %0, m0\n\ts_mov_b32 m0, %2\n\ts_nop 0\n\tglobal_load_lds_dwordx4 %1, off\n\ts_mov_b32 m0, %0":"=&s"(keep):"v"(gsrc),"s"(lds_dst):"memory");}
__device__ __forceinline__ float max3f(float a,float b,float c){float r;asm("v_max3_f32 %0, %1, %2, %3":"=v"(r):"v"(a),"v"(b),"v"(c));return r;}
__device__ __forceinline__ float max2f(float a,float b){float r;asm("v_max_f32_e32 %0, %1, %2":"=v"(r):"v"(a),"v"(b));return r;}
__device__ __forceinline__ float fadd_s(float a,float b){float r;asm("v_add_f32_e32 %0, %1, %2":"=v"(r):"v"(a),"v"(b));return r;}
__device__ __forceinline__ float fsub_s(float a,float b){float r;asm("v_sub_f32_e32 %0, %1, %2":"=v"(r):"v"(a),"v"(b));return r;}
typedef float f32x2_t __attribute__((ext_vector_type(2))); typedef __bf16 bf16x2_t __attribute__((ext_vector_type(2)));
__device__ __forceinline__ unsigned cvtpk_s(float lo,float hi){f32x2_t v={lo,hi};bf16x2_t b=__builtin_convertvector(v,bf16x2_t);return __builtin_bit_cast(unsigned,b);}
#define WAIT_BAR(N) asm volatile("s_waitcnt vmcnt(" #N ") lgkmcnt(0)\n\ts_barrier":::"memory")

__device__ __forceinline__ void qkt(f32x16&p0,f32x16&p1,const char*Kslot,const bf16x8*qr,const f32x16&negm,int r32,int hi,bf16x8 kx0,bf16x8 kx1,bf16x8 qx){
  const char*kb=Kslot+hi*1024+r32*16;
  p0=__builtin_amdgcn_mfma_f32_32x32x16_bf16(kx0,qx,negm,0,0,0);p1=__builtin_amdgcn_mfma_f32_32x32x16_bf16(kx1,qx,negm,0,0,0);
  #pragma unroll
  for(int d0=0;d0<4;++d0){
    const bf16x8 b0=*reinterpret_cast<const bf16x8*>(kb+d0*2048);
    const bf16x8 b1=*reinterpret_cast<const bf16x8*>(kb+d0*2048+512);
    p0=__builtin_amdgcn_mfma_f32_32x32x16_bf16(b0,qr[d0],p0,0,0,0);p1=__builtin_amdgcn_mfma_f32_32x32x16_bf16(b1,qr[d0],p1,0,0,0);}
}
typedef __attribute__((address_space(3))) const char* lds_cptr;
typedef short v4i16_t __attribute__((ext_vector_type(4)));
__device__ __forceinline__ void kload8(bf16x8*kf,lds_cptr kp){
  kf[0]=*(const __attribute__((address_space(3))) bf16x8*)(kp);      kf[1]=*(const __attribute__((address_space(3))) bf16x8*)(kp+512);
  kf[2]=*(const __attribute__((address_space(3))) bf16x8*)(kp+2048); kf[3]=*(const __attribute__((address_space(3))) bf16x8*)(kp+2560);
  kf[4]=*(const __attribute__((address_space(3))) bf16x8*)(kp+4096); kf[5]=*(const __attribute__((address_space(3))) bf16x8*)(kp+4608);
  kf[6]=*(const __attribute__((address_space(3))) bf16x8*)(kp+6144); kf[7]=*(const __attribute__((address_space(3))) bf16x8*)(kp+6656);
}
__device__ __forceinline__ void kload2(bf16x8*kf,lds_cptr kp,int j){ kf[2*j]=*(const __attribute__((address_space(3))) bf16x8*)(kp+j*2048); kf[2*j+1]=*(const __attribute__((address_space(3))) bf16x8*)(kp+j*2048+512); }
__device__ __forceinline__ s16x4 vtr(lds_cptr p){ return __builtin_bit_cast(s16x4,__builtin_amdgcn_ds_read_tr16_b64_v4i16((__attribute__((address_space(3))) v4i16_t*)p)); }
__device__ __forceinline__ float rowmax(const f32x16&p0,const f32x16&p1){
  float a=max3f(p0[0],p0[1],p1[0]),b=max3f(p0[2],p0[3],p1[1]);a=max3f(a,p1[2],p1[3]);
  #pragma unroll
  for(int r=4;r<16;r+=4){a=max3f(a,p0[r],p0[r+1]);b=max3f(b,p0[r+2],p0[r+3]);a=max3f(a,p1[r],p1[r+1]);b=max3f(b,p1[r+2],p1[r+3]);}
  const float m=max2f(a,b);
  auto rr=__builtin_amdgcn_permlane32_swap(__float_as_uint(m),__float_as_uint(m),false,false);
  return max2f(__uint_as_float(rr[0]),__uint_as_float(rr[1]));
}
__device__ __forceinline__ void pv(f32x16*o,int vb,bf16x8 pa0,bf16x8 pa1,bf16x8 pa2,bf16x8 pa3){
  #pragma unroll
  for(int d0=0;d0<2;++d0){s16x4 lo[4],hi[4];
    #pragma unroll
    for(int ks=0;ks<4;++ks){
      asm volatile("ds_read_b64_tr_b16 %0,%1 offset:%c2":"=&v"(lo[ks]):"v"(vb),"i"(d0*4096+ks*1024):"memory");
      asm volatile("ds_read_b64_tr_b16 %0,%1 offset:%c2":"=&v"(hi[ks]):"v"(vb),"i"(d0*4096+ks*1024+512):"memory");}
    asm volatile("s_waitcnt lgkmcnt(0)":::"memory");SBAR();
    #define PK(k) (bf16x8){lo[k][0],lo[k][1],lo[k][2],lo[k][3],hi[k][0],hi[k][1],hi[k][2],hi[k][3]}
    o[d0]=__builtin_amdgcn_mfma_f32_32x32x16_bf16(pa0,PK(0),o[d0],0,0,0);
    o[d0]=__builtin_amdgcn_mfma_f32_32x32x16_bf16(pa1,PK(1),o[d0],0,0,0);
    o[d0]=__builtin_amdgcn_mfma_f32_32x32x16_bf16(pa2,PK(2),o[d0],0,0,0);
    o[d0]=__builtin_amdgcn_mfma_f32_32x32x16_bf16(pa3,PK(3),o[d0],0,0,0);
    #undef PK
  }
}

#ifndef ATTN_STORE16
#define ATTN_STORE16(p,v) (*(u32x4*)(p)=(v))
#endif
template<int THRL> __device__ __forceinline__ void attn_unit(int b,int h,int qb,const bf16*Q,const bf16*__restrict__ K,const bf16*__restrict__ V,bf16*O,const float*__restrict__ cum2,float*ssb,char*shm){
  const int tid=otid(),lane=tid&63,r32=lane&31,hi=lane>>5; const int wid=__builtin_amdgcn_readfirstlane(tid>>6);
  const long rowbase=(long)b*SEQ; const int q0=qb*QB;
  const bf16*Qw=Q+(rowbase+q0+wid*QBLK)*DM+h*D;
  const bf16*Kh=K+rowbase*DM+h*D,*Vh=V+rowbase*DM+h*D;
  const lds_cptr shm3=(lds_cptr)shm;
  const unsigned lds0=(unsigned)(uintptr_t)shm;
  float*wsf=(float*)(shm+LDS_WS)+wid*64;
  const bf16*ksrc=Kh+(long)lane*DM+wid*8;
  const bf16*vsrc=Vh+(long)(16*(wid&3)+(lane>>2))*DM+(wid>>2)*32+(lane&3)*8;
  const unsigned kdst=lds0+LDS_K+wid*1024, vdst=lds0+LDS_V+wid*1024;
  #define DMA_K(t,slot) glds16(ksrc+(long)(t)*KVBLK*DM,(unsigned)__builtin_amdgcn_readfirstlane(kdst+(slot)))
  #define DMA_V(t,slot) glds16(vsrc+(long)(t)*KVBLK*DM,(unsigned)__builtin_amdgcn_readfirstlane(vdst+(slot)))
  const int vb0=(int)(lds0+LDS_V)+((lane>>4)&1)*32+(lane&3)*8+(4*hi+((lane&15)>>2))*64;
  const char*Kbase=shm+LDS_K; bf16x8 kf[8];
  const lds_cptr kp0=shm3+LDS_K+hi*1024+r32*16; const lds_cptr vp0=shm3+LDS_V+((lane>>4)&1)*32+(lane&3)*8+(4*hi+((lane&15)>>2))*64;
  const int NT=(q0+QB)/KVBLK;
  { const float*cumh=cum2+(long)(b*NHEAD+h)*SEQ; const float cref=cumh[q0];
    for(int i=tid;i<q0+QB;i+=NW*64){ const float x=cref-cumh[i]; const unsigned u1=__float_as_uint(x)&0xffff0000u; const float r1=x-__uint_as_float(u1);
      const unsigned u2=__float_as_uint(r1)&0xffff0000u; const float r2=r1-__uint_as_float(u2); const unsigned u3=__float_as_uint(r2)&0xffff0000u;
      u32x2 w; w.x=(u1>>16)|u2; w.y=u3>>16; *(__attribute__((address_space(3))) u32x2*)(shm3+LDS_BIAS+i*8)=w; } }
  const lds_cptr bp0=shm3+LDS_BIAS+r32*8;
  bf16x8 qx; { const u32x4 t=(hi==0)?(u32x4){0x3F803F80u,0x00003F80u,0u,0u}:(u32x4){0u,0u,0u,0u}; qx=__builtin_bit_cast(bf16x8,t); }
  #define BIASLD(t,which) ({ const u32x2 w_=*(const __attribute__((address_space(3))) u32x2*)(bp0+(t)*512+(which)*256); const u32x4 t_=(u32x4){w_.x,w_.y,0u,0u}; __builtin_bit_cast(bf16x8,t_); })
  DMA_K(0,0);DMA_V(0,0);DMA_K(1,SLOTB);
  bf16x8 qr[4];
  #pragma unroll
  for(int d0=0;d0<4;++d0)qr[d0]=*reinterpret_cast<const bf16x8*>(&Qw[(long)r32*DM+d0*16+hi*8]);
  float mhat=0.f,l_reg=0.f;f32x16 o[2];o[0]=f32x16{};o[1]=f32x16{};f32x16 negm=f32x16{};asm volatile("":"+v"(negm));
  const int qrel=wid*QBLK+r32;
  #define CMASK(P0,P1,t) do{int jb_=(t)-(NT-4); if(jb_>=0)cmask(P0,P1,jb_,qrel,hi);}while(0)
  bool resc=false;
  #define START(P0,P1) do{ const float rm=rowmax(P0,P1); resc=false; \
    { const float dl=rm; mhat=fadd_s(mhat,dl); \
      _Pragma("unroll") for(int r=0;r<16;++r){P0[r]=fsub_s(P0[r],dl);P1[r]=fsub_s(P1[r],dl);} \
      _Pragma("unroll") for(int r=0;r<16;++r)negm[r]=-mhat; asm volatile("":"+v"(negm)); } \
    _Pragma("unroll") for(int r=0;r<16;++r)P0[r]=__builtin_amdgcn_exp2f(P0[r]); }while(0)
  #define RESC() do{ if(resc){ asm volatile("s_waitcnt lgkmcnt(0)":::"memory"); \
      _Pragma("unroll") for(int d_=0;d_<2;++d_) _Pragma("unroll") for(int r=0;r<16;++r)o[d_][r]*=wsf[crow(r,hi)]; } }while(0)
  f32x16 pA0,pA1,pB0,pB1;
  int sl_prev=0,sl_cur=0,sl_next=SLOTB;
  #define ROT() do{sl_prev=sl_cur;sl_cur=sl_next;sl_next=(sl_next==(NSLOT-1)*SLOTB)?0:sl_next+SLOTB;}while(0)
  DMA_K(2,2*SLOTB);
  WAIT_BAR(3);
  qkt(pA0,pA1,Kbase,qr,negm,r32,hi,BIASLD(0,0),BIASLD(0,1),qx);asm volatile("s_nop 15\n\ts_nop 7":"+v"(pA0),"+v"(pA1));CMASK(pA0,pA1,0);
  START(pA0,pA1);
  _Pragma("unroll") for(int r=0;r<16;++r)pA1[r]=__builtin_amdgcn_exp2f(pA1[r]);
  WAIT_BAR(0);
  DMA_K(3,0);DMA_V(1,SLOTB);
  ROT();
  kload8(kf,kp0+sl_cur);
  WAIT_BAR(2);
  s16x4 vlo[8],vhi[8]; u32x4 pw0,pw1,pw2,pw3;
  #define PKW(P,B) cvtpk_s(P[B],P[B+1])
  #define PAF(k) __builtin_bit_cast(bf16x8,pw##k)
  #define VFR(i) (bf16x8){vlo[i][0],vlo[i][1],vlo[i][2],vlo[i][3],vhi[i][0],vhi[i][1],vhi[i][2],vhi[i][3]}
  #define PIN(x) asm volatile("":"+v"(x))
  #define MX3(a,b,c) __builtin_fmaxf(__builtin_fmaxf((a),(b)),(c))
  #define GAPA(MF,A0,A1,A2,A3,W0,W1,PW) do{ MF; sacc+=A0; sacc+=A1; sacc+=A2; sacc+=A3; PIN(sacc); W0; W1; PIN(PW); SBAR(); }while(0)
  #define EX(v) __builtin_amdgcn_exp2f(v)
  #define GAPB(MF,X,B) do{ MF; X[B]=EX(X[B]); X[B+1]=EX(X[B+1]); X[B+2]=EX(X[B+2]); X[B+3]=EX(X[B+3]); PIN(X); SBAR(); }while(0)
  #define VRD(i) do{ vlo[i]=vtr(vp_+(((i)>>2)*4096+((i)&3)*1024)); vhi[i]=vtr(vp_+(((i)>>2)*4096+((i)&3)*1024+512)); }while(0)
  #define KRD(G,j) do{ if(G){ kload2(kf,kp0+sl_next,j); SBAR(); } }while(0)
  #define STEP(C0,C1,P0,P1,t,GK,GV,GL) do{ SBAR(); \
    const lds_cptr vp_=vp0+sl_prev; \
    C0=__builtin_amdgcn_mfma_f32_32x32x16_bf16(kbx0,qx,negm,0,0,0); C1=__builtin_amdgcn_mfma_f32_32x32x16_bf16(kbx1,qx,negm,0,0,0); SBAR(); \
    VRD(0); SBAR(); float sacc=(P0[0]+P0[1]); \
    GAPA(C0=__builtin_amdgcn_mfma_f32_32x32x16_bf16(kf[0],qr[0],C0,0,0,0), P0[2],P0[3],P0[4],P0[5],     pw0[0]=PKW(P0,0), pw0[1]=PKW(P0,2), pw0); \
    VRD(4); SBAR(); GAPA(C1=__builtin_amdgcn_mfma_f32_32x32x16_bf16(kf[1],qr[0],C1,0,0,0), P0[6],P0[7],P0[8],P0[9],     pw0[2]=PKW(P0,4), pw0[3]=PKW(P0,6), pw0); \
    VRD(1); SBAR(); GAPA(C0=__builtin_amdgcn_mfma_f32_32x32x16_bf16(kf[2],qr[1],C0,0,0,0),   P0[10],P0[11],P0[12],P0[13], pw1[0]=PKW(P0,8), pw1[1]=PKW(P0,10), pw1); \
    VRD(5); SBAR(); GAPA(C1=__builtin_amdgcn_mfma_f32_32x32x16_bf16(kf[3],qr[1],C1,0,0,0),   P0[14],P0[15],P1[0],P1[1],   pw1[2]=PKW(P0,12),pw1[3]=PKW(P0,14), pw1); \
    VRD(2); SBAR(); GAPA(C0=__builtin_amdgcn_mfma_f32_32x32x16_bf16(kf[4],qr[2],C0,0,0,0),   P1[2],P1[3],P1[4],P1[5],     pw2[0]=PKW(P1,0), pw2[1]=PKW(P1,2), pw2); \
    VRD(6); SBAR(); GAPA(C1=__builtin_amdgcn_mfma_f32_32x32x16_bf16(kf[5],qr[2],C1,0,0,0),   P1[6],P1[7],P1[8],P1[9],     pw2[2]=PKW(P1,4), pw2[3]=PKW(P1,6), pw2); \
    VRD(3); SBAR(); GAPA(C0=__builtin_amdgcn_mfma_f32_32x32x16_bf16(kf[6],qr[3],C0,0,0,0),   P1[10],P1[11],P1[12],P1[13], pw3[0]=PKW(P1,8), pw3[1]=PKW(P1,10), pw3); \
    VRD(7); SBAR(); GAPA(C1=__builtin_amdgcn_mfma_f32_32x32x16_bf16(kf[7],qr[3],C1,0,0,0),   P1[14],P1[15],0.f,0.f,       pw3[2]=PKW(P1,12),pw3[3]=PKW(P1,14), pw3); \
    l_reg+=sacc; \
    if(GK){DMA_K((t)+3,sl_cur);} if(GV){DMA_V((t)+1,sl_next);} \
    CMASK(C0,C1,t); \
    { float a=MX3(C0[0],C0[1],C1[0]),b=MX3(C0[2],C0[3],C1[1]); a=MX3(a,C1[2],C1[3]); \
      _Pragma("unroll") for(int r=4;r<16;r+=4){a=MX3(a,C0[r],C0[r+1]);b=MX3(b,C0[r+2],C0[r+3]);a=MX3(a,C1[r],C1[r+1]);b=MX3(b,C1[r+2],C1[r+3]);} \
      float rm=__builtin_fmaxf(a,b); { auto rr=__builtin_amdgcn_permlane32_swap(__float_as_uint(rm),__float_as_uint(rm),false,false); rm=__builtin_fmaxf(__uint_as_float(rr[0]),__uint_as_float(rr[1])); } \
      resc=false; \
      if(__builtin_expect(__any(rm>(float)THRL),0)){ const float dl=__builtin_fmaxf(rm,0.f); mhat+=dl; \
        _Pragma("unroll") for(int r=0;r<16;++r){C0[r]-=dl;C1[r]-=dl;} \
        _Pragma("unroll") for(int r=0;r<16;++r)negm[r]=-mhat; asm volatile("":"+v"(negm)); \
        const float f=__builtin_amdgcn_exp2f(-dl); l_reg*=f; if(hi==0)wsf[r32]=f; resc=true; } } \
    SBAR(); \
    GAPB(o[0]=__builtin_amdgcn_mfma_f32_32x32x16_bf16(PAF(0),VFR(0),o[0],0,0,0), C0,0); \
    GAPB(o[1]=__builtin_amdgcn_mfma_f32_32x32x16_bf16(PAF(0),VFR(4),o[1],0,0,0), C0,4); \
    KRD(GL,0); GAPB(o[0]=__builtin_amdgcn_mfma_f32_32x32x16_bf16(PAF(1),VFR(1),o[0],0,0,0), C0,8); \
    KRD(GL,1); GAPB(o[1]=__builtin_amdgcn_mfma_f32_32x32x16_bf16(PAF(1),VFR(5),o[1],0,0,0), C0,12); \
    KRD(GL,2); GAPB(o[0]=__builtin_amdgcn_mfma_f32_32x32x16_bf16(PAF(2),VFR(2),o[0],0,0,0), C1,0); \
    KRD(GL,3); GAPB(o[1]=__builtin_amdgcn_mfma_f32_32x32x16_bf16(PAF(2),VFR(6),o[1],0,0,0), C1,4); \
    GAPB(o[0]=__builtin_amdgcn_mfma_f32_32x32x16_bf16(PAF(3),VFR(3),o[0],0,0,0), C1,8); \
    GAPB(o[1]=__builtin_amdgcn_mfma_f32_32x32x16_bf16(PAF(3),VFR(7),o[1],0,0,0), C1,12); \
    if(GL){ kbx0=BIASLD((t)+1,0); kbx1=BIASLD((t)+1,1); } \
    }while(0)
  int t=1; bf16x8 kbx0=BIASLD(1,0),kbx1=BIASLD(1,1);
  #undef CMASK
  #define CMASK(P0,P1,t) do{}while(0)
  for(;t+5<NT;t+=2){
    STEP(pB0,pB1,pA0,pA1,t,true,true,true);     WAIT_BAR(2); RESC(); ROT();
    STEP(pA0,pA1,pB0,pB1,t+1,true,true,true);   WAIT_BAR(2); RESC(); ROT();
  }
  #undef CMASK
  #define CMASK(P0,P1,t) do{int jb_=(t)-(NT-4); if(jb_>=0)cmask(P0,P1,jb_,qrel,hi);}while(0)
  #define ENDW(tt) do{ if((tt)+3<NT){WAIT_BAR(2);} else if((tt)+2<NT){WAIT_BAR(1);} else {WAIT_BAR(0);} }while(0)
  for(;t+1<NT;t+=2){
    STEP(pB0,pB1,pA0,pA1,t,(t+3<NT),(t+1<NT),(t+1<NT));       ENDW(t);   RESC(); ROT();
    STEP(pA0,pA1,pB0,pB1,t+1,(t+4<NT),(t+2<NT),(t+2<NT));     ENDW(t+1); RESC(); ROT();
  }
  STEP(pB0,pB1,pA0,pA1,NT-1,false,false,false); RESC();
  { float sacc=pB0[0]+pB0[1]; _Pragma("unroll") for(int r=2;r<16;++r)sacc+=pB0[r]; _Pragma("unroll") for(int r=0;r<16;++r)sacc+=pB1[r]; l_reg+=sacc;
    pw0=(u32x4){PKW(pB0,0),PKW(pB0,2),PKW(pB0,4),PKW(pB0,6)};pw1=(u32x4){PKW(pB0,8),PKW(pB0,10),PKW(pB0,12),PKW(pB0,14)};pw2=(u32x4){PKW(pB1,0),PKW(pB1,2),PKW(pB1,4),PKW(pB1,6)};pw3=(u32x4){PKW(pB1,8),PKW(pB1,10),PKW(pB1,12),PKW(pB1,14)};
    SBAR(); pv(o,vb0+sl_cur,PAF(0),PAF(1),PAF(2),PAF(3)); }
  #undef PKW
  #undef PAF
  #undef VFR
  #undef PIN
  #undef MX3
  #undef GAPA
  #undef GAPB
  #undef EX
  #undef VRD
  #undef KRD
  #undef STEP
  #undef ENDW
  {auto rr=__builtin_amdgcn_permlane32_swap(__float_as_uint(l_reg),__float_as_uint(l_reg),false,false);l_reg=__uint_as_float(rr[0])+__uint_as_float(rr[1]);}
  if(hi==0)wsf[32+r32]=l_reg;asm volatile("s_waitcnt lgkmcnt(0)":::"memory");
  float rli[16];
  #pragma unroll
  for(int r=0;r<16;++r)rli[r]=__builtin_amdgcn_rcpf(wsf[32+crow(r,hi)]);
  bf16*Ow=O+(rowbase+q0+wid*QBLK)*OPITCH+h*D; float*ssw=ssb+(long)h*(BATCH*SEQ)+rowbase+q0+wid*QBLK;
  { bf16*stg=(bf16*)(shm+LDS_OST)+wid*2048;
    #pragma unroll
    for(int r=0;r<16;++r){const int orow=crow(r,hi);
      #pragma unroll
      for(int d0=0;d0<2;++d0)stg[orow*64+d0*32+r32]=__float2bfloat16(o[d0][r]*rli[r]);}
    asm volatile("s_waitcnt lgkmcnt(0)":::"memory");
    #pragma unroll
    for(int i=0;i<4;++i){const int row=i*8+(lane>>3),ch=lane&7; const u32x4 v=*(const u32x4*)(stg+row*64+ch*8); ATTN_STORE16(Ow+(long)row*OPITCH+ch*8,v);
      float q=0.f;
      #pragma unroll
      for(int e=0;e<4;++e){const float lo=__uint_as_float(v[e]<<16),hi2=__uint_as_float(v[e]&0xffff0000u); q+=lo*lo+hi2*hi2;}
      q+=__shfl_xor(q,1);q+=__shfl_xor(q,2);q+=__shfl_xor(q,4); if(ch==0)ssw[row]=q;} }
  asm volatile("s_waitcnt lgkmcnt(0)\n\ts_barrier":::"memory");
  #undef DMA_K
  #undef DMA_V
  #undef BIASLD
  #undef CMASK
  #undef START
  #undef RESC
  #undef ROT
}
constexpr int ATTN_LDS_BYTES=LDS_BYTES;
struct AttnTensors { const bf16* Q; const bf16* K; const bf16* V; bf16* O; const float* cum2; float* ssb; };
struct AttnUnit { int bh; int qb; };
struct StaticOrder {
  int vcu;
  __device__ __forceinline__ explicit StaticOrder(int grid,int block):vcu((block%8)*(grid/8)+block/8){}
  __device__ __forceinline__ bool next(int i,AttnUnit&u)const{ if(i>=4||vcu>=256)return false; const int s=vcu&3; u.bh=vcu>>2; u.qb=(i==0)?s:(i==1)?7-s:(i==2)?8+s:15-s; return true; }
  __device__ __forceinline__ void a_ready(const AttnUnit&)const{}
  __device__ __forceinline__ void done(const AttnUnit&)const{}
};
template<class Sched,int THRL=8> __device__ __forceinline__ void attn_phase(char*lds,const AttnTensors&T,const Sched&S){
  AttnUnit u;
  for(int i=0;S.next(i,u);++i){ S.a_ready(u); attn_unit<THRL>(u.bh/NHEAD,u.bh%NHEAD,u.qb,T.Q,T.K,T.V,T.O,T.cum2,T.ssb,lds); S.done(u); }
}
#undef SBAR
#undef WAIT_BAR
}
constexpr int NWAVES = 8;
constexpr int BATCH = 8, SEQ = 4096, DM_ = 1024, DFF = 2816, NIN = 2568, DA = 512, HA = 8, HB = 8;
constexpr int M = BATCH * SEQ;
constexpr float EPS = 1e-6f;
constexpr size_t MiB = 1u << 20;
constexpr size_t WS_MOD = 0;
constexpr size_t WS_LOGF = 1 * MiB;
constexpr size_t WS_CUM = 2 * MiB;
constexpr size_t WS_SS = 3 * MiB;
constexpr size_t WS_SSA = 5 * MiB;
constexpr size_t WS_SSB = 6 * MiB;
constexpr size_t WS_WGU0 = 8 * MiB;
constexpr size_t WS_WGU1 = 20 * MiB;
constexpr size_t WS_WD0 = 32 * MiB;
constexpr size_t WS_WD1 = 38 * MiB;
constexpr size_t WS_WIN = 44 * MiB;
constexpr size_t WS_WOUT = 50 * MiB;
constexpr size_t WS_H = 64 * MiB;
constexpr size_t WS_HD = 128 * MiB;
constexpr size_t WS_ACT = 192 * MiB;
constexpr size_t WS_ZG = 192 * MiB;
constexpr size_t WS_Q = 256 * MiB, WS_K = 288 * MiB, WS_V = 320 * MiB;
constexpr size_t WS_Y = 352 * MiB;
constexpr size_t WS_END = 416 * MiB;
static_assert(WS_ACT + (size_t)M * DFF * 2 <= WS_END && WS_Y + (size_t)M * 1024 * 2 <= WS_END, "ws map");
constexpr int LDS_BYTES = 147456;

#define GAS __attribute__((address_space(1)))
#define LAS __attribute__((address_space(3)))
typedef unsigned short bf16;
typedef unsigned v4u __attribute__((ext_vector_type(4)));
typedef unsigned v2u __attribute__((ext_vector_type(2)));
typedef float f32x4 __attribute__((ext_vector_type(4)));
typedef short bf16x8 __attribute__((ext_vector_type(8)));
#define LDS_WAIT() asm volatile("s_waitcnt lgkmcnt(0)" ::: "memory")
__device__ __forceinline__ unsigned f2bf(float f) { unsigned u = __builtin_bit_cast(unsigned, f); return (u + 0x7fffu + ((u >> 16) & 1u)) >> 16; }
__device__ __forceinline__ unsigned pk2(float lo, float hi) { return f2bf(lo) | (f2bf(hi) << 16); }
__device__ __forceinline__ float bf_lo(unsigned w) { return __builtin_bit_cast(float, w << 16); }
__device__ __forceinline__ float bf_hi(unsigned w) { return __builtin_bit_cast(float, w & 0xffff0000u); }
__device__ __forceinline__ float wave_sum(float v) {
#pragma unroll
    for (int o = 1; o < 64; o <<= 1) v += __shfl_xor(v, o);
    return v;
}

struct Params {
    const float *x, *c, *w_ada, *b_ada, *pre_g, *post_g, *w_gate, *w_up, *w_down, *w_in, *ln_g, *ln_b, *sgu_w, *sgu_b, *b_f, *gn_a, *gn_b, *w_out;
    float* out; unsigned char* ws;
};

__device__ __forceinline__ void adaln_item(const Params& p, LAS unsigned char* lds, int cgp, int tid, int lane, int wave) {
    LAS float* sc = (LAS float*)lds;
    LAS float* red = (LAS float*)(lds + 32768);
    for (int idx = tid; idx < 8192; idx += 512) { const int b = idx >> 10, k = idx & 1023; const float v = p.c[idx]; sc[k * 8 + b] = v * pg8::fast_sigmoid(v); }
    __syncthreads();
    float acc[8];
#pragma unroll
    for (int b = 0; b < 8; ++b) acc[b] = 0.f;
    const float* wp = p.w_ada + (size_t)(wave * 128) * 9216 + cgp * 64 + lane;
#pragma unroll 8
    for (int k = 0; k < 128; ++k) { const float wv = wp[(size_t)k * 9216]; const f32x4 s0 = *(const LAS f32x4*)(sc + (wave * 128 + k) * 8), s1 = *(const LAS f32x4*)(sc + (wave * 128 + k) * 8 + 4);
        acc[0] += s0[0] * wv; acc[1] += s0[1] * wv; acc[2] += s0[2] * wv; acc[3] += s0[3] * wv; acc[4] += s1[0] * wv; acc[5] += s1[1] * wv; acc[6] += s1[2] * wv; acc[7] += s1[3] * wv; }
#pragma unroll
    for (int b = 0; b < 8; ++b) red[(wave * 8 + b) * 64 + lane] = acc[b];
    __syncthreads();
    { const int b = wave; float s = 0.f;
#pragma unroll
      for (int w = 0; w < 8; ++w) s += red[(w * 8 + b) * 64 + lane];
      const int j = cgp * 64 + lane; ((float*)(p.ws + WS_MOD))[b * 9216 + j] = s + p.b_ada[j]; }
    __syncthreads();
}
__device__ __forceinline__ void transpose_item(const float* W, int ldw, int k0, int n0, bf16* WT, int K, int drow0, LAS float* scr, int lane) {
#pragma unroll 8
    for (int i = 0; i < 32; ++i) { const int kk = 2 * i + (lane >> 5); scr[kk * 33 + (lane & 31)] = W[(size_t)(k0 + kk) * ldw + n0 + (lane & 31)]; }
    LDS_WAIT(); asm volatile("" ::: "memory");
    const int c = lane & 7;
#pragma unroll
    for (int j = 0; j < 4; ++j) { const int n = (lane >> 3) + 8 * j; const LAS float* s = scr + (8 * c) * 33 + n;
        v4u o; o.x = pk2(s[0 * 33], s[1 * 33]); o.y = pk2(s[2 * 33], s[3 * 33]); o.z = pk2(s[4 * 33], s[5 * 33]); o.w = pk2(s[6 * 33], s[7 * 33]);
        *(GAS v4u*)(WT + (size_t)(drow0 + n) * K + k0 + 8 * c) = o; }
    LDS_WAIT(); asm volatile("" ::: "memory");
}
__device__ __forceinline__ void convert_weights(const Params& p, LAS unsigned char* lds, int gw, int NGW, int lane, int wave) {
    LAS float* scr = (LAS float*)(lds + wave * 16384);
    constexpr int I_GU = 16 * 88, I_D = 44 * 32, I_IN = 16 * 80, I_OUT = 16 * 32;
    constexpr int NITEMS = 6 * I_GU + I_IN + I_OUT;
    static_assert(I_GU == I_D, "items");
    for (int it = gw; it < NITEMS; it += NGW) {
        int r = it;
        if (r < 4 * I_GU) {
            const int which = r / I_GU; r -= which * I_GU; const int f = which >> 1, up = which & 1;
            const int kb = r / 88, nb = r % 88, n0 = nb * 32;
            const float* W = (up ? p.w_up : p.w_gate) + (size_t)f * 1024 * DFF;
            bf16* WT = (bf16*)(p.ws + (f ? WS_WGU1 : WS_WGU0));
            transpose_item(W, DFF, kb * 64, n0, WT, 1024, 256 * (n0 >> 7) + (n0 & 127) + (up ? 128 : 0), scr, lane); continue; }
        r -= 4 * I_GU;
        if (r < 2 * I_D) { const int f = r / I_D; r -= f * I_D; const int kb = r / 32, nb = r % 32;
            transpose_item(p.w_down + (size_t)f * DFF * 1024, 1024, kb * 64, nb * 32, (bf16*)(p.ws + (f ? WS_WD1 : WS_WD0)), DFF, nb * 32, scr, lane); continue; }
        r -= 2 * I_D;
        if (r < I_IN) { const int kb = r / 80, nb = r % 80; transpose_item(p.w_in, NIN, kb * 64, nb * 32, (bf16*)(p.ws + WS_WIN), 1024, nb * 32, scr, lane); continue; }
        r -= I_IN;
        { const int kb = r / 32, nb = r % 32; transpose_item(p.w_out, 1024, kb * 64, nb * 32, (bf16*)(p.ws + WS_WOUT), 1024, nb * 32, scr, lane); }
    }
}

template <int MODE> __device__ __forceinline__ void ew_phase(const Params& p, LAS unsigned char* lds, int gw, int lane, const float* xin, int sub_res, float coef, int sub_next) {
    const int row0 = gw * 16; if (row0 >= M) return;
    const int b = row0 / SEQ;
    const float* mod = (const float*)(p.ws + WS_MOD) + (size_t)b * 9216;
    f32x4 G[4], A[4], S[4];
    if (MODE & 1) {
#pragma unroll
        for (int j = 0; j < 4; ++j) { const int col = 4 * lane + 256 * j; const f32x4 gt = *(const f32x4*)(mod + sub_res * 3072 + 2048 + col), pg = *(const f32x4*)(p.post_g + sub_res * 1024 + col); G[j] = coef * (1.0f + gt) * pg; }
        asm volatile("" : "+v"(G[0]), "+v"(G[1]), "+v"(G[2]), "+v"(G[3]) :: "memory");
    }
    if (MODE & 2) {
#pragma unroll
        for (int j = 0; j < 4; ++j) { const int col = 4 * lane + 256 * j; const f32x4 sh = *(const f32x4*)(mod + sub_next * 3072 + col), scl = *(const f32x4*)(mod + sub_next * 3072 + 1024 + col), pg = *(const f32x4*)(p.pre_g + sub_next * 1024 + col);
            A[j] = pg * (1.0f + scl); S[j] = sh; }
        asm volatile("" : "+v"(A[0]), "+v"(A[1]), "+v"(A[2]), "+v"(A[3]), "+v"(S[0]), "+v"(S[1]), "+v"(S[2]), "+v"(S[3]) :: "memory");
    }
    const LAS f32x4* wfl = (const LAS f32x4*)lds + lane;
    const float* ss = (const float*)(p.ws + WS_SS);
    const bf16* HD = (const bf16*)(p.ws + WS_HD);
    bf16* H = (bf16*)(p.ws + WS_H);
#pragma unroll 1
    for (int rr = 0; rr < 16; ++rr) {
        const int row = row0 + rr;
        f32x4 v[4];
#pragma unroll
        for (int j = 0; j < 4; ++j) v[j] = *(const f32x4*)(xin + (size_t)row * 1024 + 4 * lane + 256 * j);
        if (MODE & 1) {
            float q = 0.f;
#pragma unroll
            for (int t = 0; t < 16; ++t) q += ss[(size_t)t * M + row];
            const float rstd = 1.0f / sqrtf(q * (1.0f / 1024.0f) + EPS);
#pragma unroll
            for (int j = 0; j < 4; ++j) { const v2u hw = *(const v2u*)(HD + (size_t)row * 1024 + 4 * lane + 256 * j);
                const f32x4 hv = (f32x4){bf_lo(hw.x), bf_hi(hw.x), bf_lo(hw.y), bf_hi(hw.y)};
                v[j] = v[j] + G[j] * hv * rstd;
                *(f32x4*)(p.out + (size_t)row * 1024 + 4 * lane + 256 * j) = v[j]; }
        }
        if (MODE & 2) {
            float s2 = 0.f;
#pragma unroll
            for (int j = 0; j < 4; ++j) s2 += (v[j][0] * v[j][0] + v[j][1] * v[j][1]) + (v[j][2] * v[j][2] + v[j][3] * v[j][3]);
            const float r2 = 1.0f / sqrtf(wave_sum(s2) * (1.0f / 1024.0f) + EPS);
            f32x4 hq[4];
#pragma unroll
            for (int j = 0; j < 4; ++j) { hq[j] = v[j] * r2 * A[j] + S[j];
                v2u w; w.x = pk2(hq[j][0], hq[j][1]); w.y = pk2(hq[j][2], hq[j][3]);
                *(v2u*)(H + (size_t)row * 1024 + 4 * lane + 256 * j) = w; }
            if (MODE & 4) {
                f32x4 d0 = (f32x4){0.f, 0.f, 0.f, 0.f}, d1 = d0;
#pragma unroll
                for (int j = 0; j < 4; ++j)
#pragma unroll
                    for (int e = 0; e < 4; ++e) { d0 += hq[j][e] * wfl[((j * 4 + e) * 2 + 0) * 64]; d1 += hq[j][e] * wfl[((j * 4 + e) * 2 + 1) * 64]; }
                float dd[8] = {d0[0], d0[1], d0[2], d0[3], d1[0], d1[1], d1[2], d1[3]};
                float mine = 0.f;
#pragma unroll
                for (int hh = 0; hh < 8; ++hh) { const float t = wave_sum(dd[hh]); if (lane == hh) mine = t; }
                if (lane < 8) { const float z = mine + p.b_f[lane];
                    const float ls = (z < 0.f ? z : 0.f) - log1pf(expf(-fabsf(z)));
                    ((float*)(p.ws + WS_LOGF))[((size_t)(b * 8 + lane)) * SEQ + (row - b * SEQ)] = ls; }
            }
        }
    }
}
__device__ __forceinline__ void ew_fill_wf(const Params& p, LAS unsigned char* lds, int tid) {
    for (int idx = tid; idx < 2048; idx += NWAVES * 64) { const int l = idx & 63, half = (idx >> 6) & 1, e = (idx >> 7) & 3, j = idx >> 9;
        ((LAS f32x4*)lds)[idx] = *(const f32x4*)(p.w_in + (size_t)(4 * l + 256 * j + e) * NIN + 2560 + 4 * half); }
    __syncthreads();
}
__device__ __forceinline__ void scan_seq(const Params& p, int seq, int lane) {
    const float* src = (const float*)(p.ws + WS_LOGF) + (size_t)seq * SEQ + lane * 64;
    float* dst = (float*)(p.ws + WS_CUM) + (size_t)seq * SEQ + lane * 64;
    f32x4 v[16]; float run = 0.f;
#pragma unroll
    for (int i = 0; i < 16; ++i) { v[i] = *(const f32x4*)(src + 4 * i);
        run += v[i][0]; v[i][0] = run; run += v[i][1]; v[i][1] = run; run += v[i][2]; v[i][2] = run; run += v[i][3]; v[i][3] = run; }
    float incl = run;
#pragma unroll
    for (int o = 1; o < 64; o <<= 1) { const float t = __shfl_up(incl, o); if (lane >= o) incl += t; }
    const float excl = incl - run;
#pragma unroll
    for (int i = 0; i < 16; ++i) *(f32x4*)(dst + 4 * i) = (v[i] + excl) * 1.4426950408889634f;
}
constexpr int SGU_PITCH = 1044;
__device__ __forceinline__ void sgu_unit(const Params& p, LAS unsigned char* lds, int unit, int lane, int wave) {
    const int R0 = unit * 128;
    const bf16* ZG = (const bf16*)(p.ws + WS_ZG);
    bf16* Y = (bf16*)(p.ws + WS_Y);
    float* ssa = (float*)(p.ws + WS_SSA);
    {
        const f32x4 g0 = *(const f32x4*)(p.ln_g + 8 * lane), g1 = *(const f32x4*)(p.ln_g + 8 * lane + 4), b0 = *(const f32x4*)(p.ln_b + 8 * lane), b1 = *(const f32x4*)(p.ln_b + 8 * lane + 4);
        for (int rr = 0; rr < 16; ++rr) { const int r = wave * 16 + rr;
            const v4u w = *(const v4u*)(ZG + (size_t)(R0 + r) * 1024 + 512 + 8 * lane);
            f32x4 a = (f32x4){bf_lo(w.x), bf_hi(w.x), bf_lo(w.y), bf_hi(w.y)}, c = (f32x4){bf_lo(w.z), bf_hi(w.z), bf_lo(w.w), bf_hi(w.w)};
            const float mean = wave_sum((a[0] + a[1]) + (a[2] + a[3]) + (c[0] + c[1]) + (c[2] + c[3])) * (1.0f / 512.0f);
            a = a - mean; c = c - mean;
            const float var = wave_sum((a[0] * a[0] + a[1] * a[1]) + (a[2] * a[2] + a[3] * a[3]) + (c[0] * c[0] + c[1] * c[1]) + (c[2] * c[2] + c[3] * c[3])) * (1.0f / 512.0f);
            const float rstd = 1.0f / sqrtf(var + EPS);
            a = a * rstd * g0 + b0; c = c * rstd * g1 + b1;
            LAS unsigned* d = (LAS unsigned*)(lds + r * SGU_PITCH + 16 * lane);
            d[0] = pk2(a[0], a[1]); d[1] = pk2(a[2], a[3]); d[2] = pk2(c[0], c[1]); d[3] = pk2(c[2], c[3]); }
    }
    __syncthreads();
    const int fr = lane & 15, fq = lane >> 4;
    const int i = wave * 16 + fr;
    const int nks = wave < 4 ? 2 : 4;
    for (int h = 0; h < HA; ++h) {
        f32x4 acc[4];
#pragma unroll
        for (int nt = 0; nt < 4; ++nt) acc[nt] = (f32x4){0.f, 0.f, 0.f, 0.f};
        const float* Wr = p.sgu_w + (size_t)h * 16384 + (size_t)i * 128 + 8 * fq;
        for (int ks = 0; ks < nks; ++ks) {
            const f32x4 w0 = *(const f32x4*)(Wr + 32 * ks), w1 = *(const f32x4*)(Wr + 32 * ks + 4);
            v4u wu; wu.x = pk2(w0[0], w0[1]); wu.y = pk2(w0[2], w0[3]); wu.z = pk2(w1[0], w1[1]); wu.w = pk2(w1[2], w1[3]);
            const bf16x8 wfrag = __builtin_bit_cast(bf16x8, wu);
            const LAS unsigned short* vb = (const LAS unsigned short*)(lds + (32 * ks + 8 * fq) * SGU_PITCH + (64 * h + fr) * 2);
#pragma unroll
            for (int nt = 0; nt < 4; ++nt) { bf16x8 vf;
#pragma unroll
                for (int e = 0; e < 8; ++e) vf[e] = (short)vb[e * (SGU_PITCH / 2) + 16 * nt];
                acc[nt] = __builtin_amdgcn_mfma_f32_16x16x32_bf16(vf, wfrag, acc[nt], 0, 0, 0); }
        }
        const float bs = p.sgu_b[h * 128 + i];
        const size_t rowoff = (size_t)(R0 + i) * 1024; float q = 0.f;
#pragma unroll
        for (int nt = 0; nt < 4; ++nt) { const int c = 64 * h + 16 * nt + 4 * fq;
            const v2u uw = *(const v2u*)(ZG + rowoff + c);
            const f32x4 uv = (f32x4){bf_lo(uw.x), bf_hi(uw.x), bf_lo(uw.y), bf_hi(uw.y)};
            const f32x4 y = uv * (acc[nt] + bs);
            v2u o; o.x = pk2(y[0], y[1]); o.y = pk2(y[2], y[3]);
            const f32x4 yr = (f32x4){bf_lo(o.x), bf_hi(o.x), bf_lo(o.y), bf_hi(o.y)};
            q += (yr[0] * yr[0] + yr[1] * yr[1]) + (yr[2] * yr[2] + yr[3] * yr[3]);
            *(v2u*)(Y + rowoff + c) = o; }
        q += __shfl_xor(q, 16); q += __shfl_xor(q, 32);
        if (fq == 0) ssa[(size_t)h * M + R0 + i] = q;
    }
    __syncthreads();
}
__device__ __forceinline__ void ynorm_phase(const Params& p, int gw, int lane) {
    const int row0 = gw * 16; if (row0 >= M) return;
    const f32x4 ga0 = *(const f32x4*)(p.gn_a + 8 * lane), ga1 = *(const f32x4*)(p.gn_a + 8 * lane + 4), gb0 = *(const f32x4*)(p.gn_b + 8 * lane), gb1 = *(const f32x4*)(p.gn_b + 8 * lane + 4);
    const float* ssa = (const float*)(p.ws + WS_SSA); const float* ssb = (const float*)(p.ws + WS_SSB);
    bf16* Y = (bf16*)(p.ws + WS_Y);
    for (int rr = 0; rr < 16; ++rr) { const int row = row0 + rr;
        float qa = 0.f, qb = 0.f;
#pragma unroll
        for (int h = 0; h < 8; ++h) { qa += ssa[(size_t)h * M + row]; qb += ssb[(size_t)h * M + row]; }
        const float ra = 1.0f / sqrtf(qa * (1.0f / 512.0f) + EPS), rb = 1.0f / sqrtf(qb * (1.0f / 512.0f) + EPS);
        v4u* pa = (v4u*)(Y + (size_t)row * 1024 + 8 * lane); v4u* pb = (v4u*)(Y + (size_t)row * 1024 + 512 + 8 * lane);
        const v4u wa = *pa, wb = *pb; v4u oa, ob;
        oa.x = pk2(bf_lo(wa.x) * ra * ga0[0], bf_hi(wa.x) * ra * ga0[1]); oa.y = pk2(bf_lo(wa.y) * ra * ga0[2], bf_hi(wa.y) * ra * ga0[3]);
        oa.z = pk2(bf_lo(wa.z) * ra * ga1[0], bf_hi(wa.z) * ra * ga1[1]); oa.w = pk2(bf_lo(wa.w) * ra * ga1[2], bf_hi(wa.w) * ra * ga1[3]);
        ob.x = pk2(bf_lo(wb.x) * rb * gb0[0], bf_hi(wb.x) * rb * gb0[1]); ob.y = pk2(bf_lo(wb.y) * rb * gb0[2], bf_hi(wb.y) * rb * gb0[3]);
        ob.z = pk2(bf_lo(wb.z) * rb * gb1[0], bf_hi(wb.z) * rb * gb1[1]); ob.w = pk2(bf_lo(wb.w) * rb * gb1[2], bf_hi(wb.w) * rb * gb1[3]);
        *pa = oa; *pb = ob; }
}

__global__ void __launch_bounds__(NWAVES * 64, 2) mega_fwd(Params p) {
    extern __shared__ __attribute__((aligned(16))) unsigned char lds_raw[];
    cg::grid_group grid = cg::this_grid();
    LAS unsigned char* lds = (LAS unsigned char*)lds_raw;
    const int G = gridDim.x, bx = blockIdx.x, NGW = G * NWAVES;
#define LANEVARS const int tid = otid(), lane = tid & 63, wave = __builtin_amdgcn_readfirstlane(tid >> 6), gw = bx * NWAVES + wave; (void)tid; (void)lane; (void)wave; (void)gw
    bf16* H = (bf16*)(p.ws + WS_H); bf16* HD = (bf16*)(p.ws + WS_HD); bf16* ACT = (bf16*)(p.ws + WS_ACT);
    float* SS = (float*)(p.ws + WS_SS);

    { LANEVARS; for (int it = bx; it < 144; it += G) adaln_item(p, lds, it, tid, lane, wave);
      convert_weights(p, lds, gw, NGW, lane, wave); }
    grid.sync();
    { LANEVARS; for (int g = gw; g * 16 < M; g += NGW) ew_phase<2>(p, lds, g, lane, p.x, 0, 0.f, 0); }
    grid.sync();
    { pg8::Gemm g{H, (const bf16*)(p.ws + WS_WGU0), M, 2 * DFF, 1024}; pg8::StaticOrder S; S.init(M, 2 * DFF, G, bx);
      pg8::EpiSwiGLU E{ACT, DFF}; pg8::gemm_phase<pg8::EpiSwiGLU, pg8::StaticOrder, true, true>(lds, g, S, E); }
    grid.sync();
    { pg8::Gemm g{ACT, (const bf16*)(p.ws + WS_WD0), M, 1024, DFF}; pg8::StaticOrder S; S.init(M, 1024, G, bx);
      pg8::EpiBf16Ss E{HD, 1024, SS, M}; pg8::gemm_phase<pg8::EpiBf16Ss, pg8::StaticOrder, true, true>(lds, g, S, E); }
    grid.sync();
    { LANEVARS; ew_fill_wf(p, lds, tid); for (int g = gw; g * 16 < M; g += NGW) ew_phase<7>(p, lds, g, lane, p.x, 0, 0.5f, 1); }
    grid.sync();
    { LANEVARS; if (wave == 0) for (int s = bx; s < BATCH * HB; s += G) scan_seq(p, s, lane); }
    { pg8::Gemm g{H, (const bf16*)(p.ws + WS_WIN), M, 2560, 1024}; pg8::StaticOrder S; S.init(M, 2560, G, bx);
      static_assert(WS_K - WS_Q == WS_V - WS_K, "qkv stride");
      pg8::EpiMixIn E{(bf16*)(p.ws + WS_ZG), (bf16*)(p.ws + WS_Q), (WS_K - WS_Q) / 2, attn_body::C2};
      pg8::gemm_phase<pg8::EpiMixIn, pg8::StaticOrder, true, true>(lds, g, S, E); }
    grid.sync();
    { LANEVARS; for (int u = bx; u < M / 128; u += G) sgu_unit(p, lds, u, lane, wave); }
    { const attn_body::AttnTensors AT{(const attn_body::bf16*)(p.ws + WS_Q), (const attn_body::bf16*)(p.ws + WS_K), (const attn_body::bf16*)(p.ws + WS_V),
                                      (attn_body::bf16*)(p.ws + WS_Y) + 512, (const float*)(p.ws + WS_CUM), (float*)(p.ws + WS_SSB)};
      const attn_body::StaticOrder S(G, bx);
      attn_body::attn_phase<attn_body::StaticOrder>((char*)lds_raw, AT, S); }
    grid.sync();
    { LANEVARS; for (int g = gw; g * 16 < M; g += NGW) ynorm_phase(p, g, lane); }
    grid.sync();
    { pg8::Gemm g{(const bf16*)(p.ws + WS_Y), (const bf16*)(p.ws + WS_WOUT), M, 1024, 1024}; pg8::StaticOrder S; S.init(M, 1024, G, bx);
      pg8::EpiBf16Ss E{HD, 1024, SS, M}; pg8::gemm_phase<pg8::EpiBf16Ss, pg8::StaticOrder, true, true>(lds, g, S, E); }
    grid.sync();
    { LANEVARS; for (int g = gw; g * 16 < M; g += NGW) ew_phase<3>(p, lds, g, lane, p.out, 1, 1.0f, 2); }
    grid.sync();
    { pg8::Gemm g{H, (const bf16*)(p.ws + WS_WGU1), M, 2 * DFF, 1024}; pg8::StaticOrder S; S.init(M, 2 * DFF, G, bx);
      pg8::EpiSwiGLU E{ACT, DFF}; pg8::gemm_phase<pg8::EpiSwiGLU, pg8::StaticOrder, true, true>(lds, g, S, E); }
    grid.sync();
    { pg8::Gemm g{ACT, (const bf16*)(p.ws + WS_WD1), M, 1024, DFF}; pg8::StaticOrder S; S.init(M, 1024, G, bx);
      pg8::EpiBf16Ss E{HD, 1024, SS, M}; pg8::gemm_phase<pg8::EpiBf16Ss, pg8::StaticOrder, true, true>(lds, g, S, E); }
    grid.sync();
    { LANEVARS; for (int g = gw; g * 16 < M; g += NGW) ew_phase<1>(p, lds, g, lane, p.out, 2, 0.5f, 0); }
}

extern "C" void kernel_launch(void* const* d_in, const int* in_sizes, int n_in, void* d_out, int out_size, void* d_ws, size_t ws_size, hipStream_t stream) {
    static int grid = 0;
    if (grid == 0) {
        if (n_in != 18 || out_size != M * 1024 || ws_size < WS_END) { fprintf(stderr, "kernel_launch: unexpected problem shape (n_in %d out %d ws %zu)\n", n_in, out_size, ws_size); grid = -1; return; }
        int dev = 0, cus = 0, per_cu = 0;
        (void)hipGetDevice(&dev); (void)hipDeviceGetAttribute(&cus, hipDeviceAttributeMultiprocessorCount, dev);
        if (hipFuncSetAttribute((const void*)mega_fwd, hipFuncAttributeMaxDynamicSharedMemorySize, LDS_BYTES) != hipSuccess) { fprintf(stderr, "kernel_launch: hipFuncSetAttribute failed\n"); grid = -1; return; }
        if (hipOccupancyMaxActiveBlocksPerMultiprocessor(&per_cu, (const void*)mega_fwd, NWAVES * 64, LDS_BYTES) != hipSuccess || per_cu < 1) { fprintf(stderr, "kernel_launch: occupancy query says %d\n", per_cu); per_cu = 1; }
        (void)hipGetLastError();
        grid = cus * 1;
        if (grid <= 0) grid = 256;
    }
    if (grid < 0) return;
    Params p{};
    p.x = (const float*)d_in[0]; p.c = (const float*)d_in[1]; p.w_ada = (const float*)d_in[2]; p.b_ada = (const float*)d_in[3]; p.pre_g = (const float*)d_in[4]; p.post_g = (const float*)d_in[5];
    p.w_gate = (const float*)d_in[6]; p.w_up = (const float*)d_in[7]; p.w_down = (const float*)d_in[8]; p.w_in = (const float*)d_in[9]; p.ln_g = (const float*)d_in[10]; p.ln_b = (const float*)d_in[11];
    p.sgu_w = (const float*)d_in[12]; p.sgu_b = (const float*)d_in[13]; p.b_f = (const float*)d_in[14]; p.gn_a = (const float*)d_in[15]; p.gn_b = (const float*)d_in[16]; p.w_out = (const float*)d_in[17];
    p.out = (float*)d_out; p.ws = (unsigned char*)d_ws;
    void* args[] = {&p};
    hipError_t e = hipLaunchCooperativeKernel((const void*)mega_fwd, dim3(grid), dim3(NWAVES * 64), args, LDS_BYTES, stream);
    if (e != hipSuccess) fprintf(stderr, "kernel_launch: cooperative launch failed: %s (grid %d)\n", hipGetErrorString(e), grid);
}
```

```cpp
#include <hip/hip_runtime.h>
#include <hip/hip_cooperative_groups.h>
#include <hip/hip_bf16.h>
#include <cstdio>
#include <cstdint>
#include <cmath>
namespace cg = cooperative_groups;
__device__ __forceinline__ int otid() { int t = threadIdx.x; asm volatile("" : "+v"(t)); return t; }
namespace pg8 {
#define PG8_LAS __attribute__((address_space(3)))
typedef unsigned short bf16_t;
typedef short bf16x8 __attribute__((ext_vector_type(8)));
typedef float f32x4 __attribute__((ext_vector_type(4)));
typedef unsigned u32x4 __attribute__((ext_vector_type(4)));
constexpr int BM = 256, BK = 64, HALF = 128, HTB = HALF * BK * 2  , STAGE_BYTES = 8 * HTB, NXCD = 8, WGM = 8;

__host__ __device__ __forceinline__ int lds_byte(int r, int c) { const int st = (r >> 4) * 2 + (c >> 5), rr = r & 15, cc = c & 31, ob = rr * 64 + cc * 2; return st * 1024 + (ob ^ (((ob >> 9) & 1) << 5)); }
__host__ __device__ __forceinline__ void stage_rc(int b, int& R, int& C) { const int st = b / 1024, sb = b % 1024, swz = sb ^ (((sb >> 9) & 1) << 5); R = (st >> 1) * 16 + swz / 64; C = (st & 1) * 32 + (swz % 64) / 2; }
__host__ __device__ __forceinline__ int perm32(int rho) { const int n = rho >> 4, i = rho & 15; return 8 * (i >> 2) + 4 * n + (i & 3); }

struct Unit { int pm, pn; };
struct Gemm { const bf16_t* A; const bf16_t* Bt; int M, N, K; };

struct StaticOrder {
    int nM, nN, nwg, G, c;
    __host__ __device__ void init(int M, int N, int G_, int c_) { nM = M / BM; nN = N / BM; nwg = nM * nN; G = G_; c = c_; }
    __host__ __device__ bool next(int i, Unit& u) const {
        const long L = (long)i * G + c; if (L >= nwg) return false;
        int wgid = (int)L; { const int q = nwg / NXCD, r = nwg % NXCD, xcd = wgid % NXCD, off = wgid / NXCD; wgid = (xcd < r ? xcd * (q + 1) : r * (q + 1) + (xcd - r) * q) + off; }
        const int nig = WGM * nN, gid = wgid / nig, fm = gid * WGM, gsz = (nM - fm) < WGM ? (nM - fm) : WGM;
        u.pm = fm + ((wgid % nig) % gsz); u.pn = (wgid % nig) / gsz; return true;
    }
    __device__ __forceinline__ void a_ready(const Unit&) const {}
    __device__ __forceinline__ void done(const Unit&) const {}
};

__device__ __forceinline__ unsigned cvt_pk_bf16(float lo, float hi) { unsigned r; asm volatile("v_cvt_pk_bf16_f32 %0, %1, %2" : "=v"(r) : "v"(lo), "v"(hi)); return r; }
typedef float f32x2 __attribute__((ext_vector_type(2)));
__device__ __forceinline__ float fast_sigmoid(float t) { return __builtin_amdgcn_rcpf(1.0f + __builtin_amdgcn_exp2f(-1.4426950408889634f * t)); }
struct EpiSwiGLU {
    static constexpr bool PERM = true, AFTER_DRAIN = false;
    bf16_t* O; int ldc;
    __device__ __forceinline__ void operator()(const f32x4 (&acc)[2][2][4][2], const Unit& u, int wr, int wc, int fr, int fq) const {
        const int row0 = u.pm * BM + wr * 64 + fr; const int col0 = u.pn * HALF + wc * 32 + 8 * fq;
#pragma unroll
        for (int ai = 0; ai < 2; ++ai)
#pragma unroll
            for (int m = 0; m < 4; ++m) { bf16_t* rowp = O + (size_t)(row0 + ai * HALF + m * 16) * ldc + col0;
                float o[8];
#pragma unroll
                for (int n = 0; n < 2; ++n)
#pragma unroll
                    for (int e = 0; e < 4; ++e) { const float g = acc[ai][0][m][n][e], up = acc[ai][1][m][n][e]; o[n * 4 + e] = g * fast_sigmoid(g) * up; }
                u32x4 w; w.x = cvt_pk_bf16(o[0], o[1]); w.y = cvt_pk_bf16(o[2], o[3]); w.z = cvt_pk_bf16(o[4], o[5]); w.w = cvt_pk_bf16(o[6], o[7]);
                *(u32x4*)rowp = w; }
    }
};
struct EpiBf16Ss {
    static constexpr bool PERM = true, AFTER_DRAIN = false;
    bf16_t* O; int ldc; float* ss; int M;
    __device__ __forceinline__ void operator()(const f32x4 (&acc)[2][2][4][2], const Unit& u, int wr, int wc, int fr, int fq) const {
        const int row0 = u.pm * BM + wr * 64 + fr; const int col0 = u.pn * BM + wc * 32 + 8 * fq;
        float* ssp = ss + (size_t)(u.pn * 4 + wc) * M;
#pragma unroll
        for (int ai = 0; ai < 2; ++ai)
#pragma unroll
            for (int m = 0; m < 4; ++m) { const int row = row0 + ai * HALF + m * 16; bf16_t* rowp = O + (size_t)row * ldc + col0; float q = 0.f;
#pragma unroll
                for (int bj = 0; bj < 2; ++bj) { const f32x4 v0 = acc[ai][bj][m][0], v1 = acc[ai][bj][m][1];
                    q += (v0[0] * v0[0] + v0[1] * v0[1]) + (v0[2] * v0[2] + v0[3] * v0[3]) + (v1[0] * v1[0] + v1[1] * v1[1]) + (v1[2] * v1[2] + v1[3] * v1[3]);
                    u32x4 w; w.x = cvt_pk_bf16(v0[0], v0[1]); w.y = cvt_pk_bf16(v0[2], v0[3]); w.z = cvt_pk_bf16(v1[0], v1[1]); w.w = cvt_pk_bf16(v1[2], v1[3]);
                    *(u32x4*)(rowp + bj * HALF) = w; }
                q += __shfl_xor(q, 16); q += __shfl_xor(q, 32);
                if (fq == 0) ssp[row] = q; }
    }
};
struct EpiMixIn {
    static constexpr bool PERM = true, AFTER_DRAIN = false;
    bf16_t* ZG; bf16_t* Q; size_t qkv_stride; float qscale;
    __device__ __forceinline__ void operator()(const f32x4 (&acc)[2][2][4][2], const Unit& u, int wr, int wc, int fr, int fq) const {
        const int row0 = u.pm * BM + wr * 64 + fr;
        bf16_t* base; int ldc, colt; float sc = 1.f; const bool gelu = u.pn < 4;
        if (u.pn < 4) { base = ZG; ldc = 1024; colt = u.pn * BM; }
        else { const int t = (u.pn - 4) >> 1; base = Q + (size_t)t * qkv_stride; ldc = 512; colt = ((u.pn - 4) & 1) * BM; if (t == 0) sc = qscale; }
        const int col0 = colt + wc * 32 + 8 * fq;
#pragma unroll
        for (int ai = 0; ai < 2; ++ai)
#pragma unroll
            for (int m = 0; m < 4; ++m) { bf16_t* rowp = base + (size_t)(row0 + ai * HALF + m * 16) * ldc + col0;
#pragma unroll
                for (int bj = 0; bj < 2; ++bj) { float o[8];
#pragma unroll
                    for (int n = 0; n < 2; ++n)
#pragma unroll
                        for (int e = 0; e < 4; ++e) { float x = acc[ai][bj][m][n][e];
                            if (gelu) { const float t = 1.5957691216057308f * (x + 0.044715f * x * x * x); x = x * fast_sigmoid(t); } else x *= sc;
                            o[n * 4 + e] = x; }
                    u32x4 w; w.x = cvt_pk_bf16(o[0], o[1]); w.y = cvt_pk_bf16(o[2], o[3]); w.z = cvt_pk_bf16(o[4], o[5]); w.w = cvt_pk_bf16(o[6], o[7]);
                    *(u32x4*)(rowp + bj * HALF) = w; } }
    }
};

template <class Epi, class Sched, bool ALIGN_EPI = false, bool SP2 = false>
__device__ __forceinline__ void gemm_phase(PG8_LAS unsigned char* lds, const Gemm g, const Sched& S, const Epi& E) {
    const int tid = otid(), wid = __builtin_amdgcn_readfirstlane(tid >> 6), lane = tid & 63, wr = wid >> 2, wc = wid & 3, fr = lane & 15, fq = lane >> 4;
    const int K = g.K, nt = K / BK;
    unsigned voffA[2], voffB[2];
#pragma unroll
    for (int i = 0; i < 2; ++i) { int R, C; stage_rc(tid * 16 + i * 8192, R, C); const int Rb = Epi::PERM ? ((R & ~31) + perm32(R & 31)) : R;
        voffA[i] = (unsigned)(R * K + C) * 2u; voffB[i] = (unsigned)(Rb * K + C) * 2u; }
    const size_t kstep = (size_t)(BK * 2);
    const size_t hstep = (size_t)HALF * K * 2;
    const size_t tstep = 2 * hstep;
    const unsigned ldsw = (unsigned)wid * 1024u;
    const int aoff = lds_byte(wr * 64 + fr, fq * 8), boff = lds_byte(wc * 32 + fr, fq * 8);
#define PG8_SA(b, h) (((b) * 2 + (h)) * HTB)
#define PG8_SB(b, h) ((4 + (b) * 2 + (h)) * HTB)
#define PG8_STAGE(bufoff, gbase, voff) do { _Pragma("unroll") for (int _i = 0; _i < 2; ++_i) \
        __builtin_amdgcn_global_load_lds((const unsigned*)((const char*)(gbase) + (voff)[_i]), (PG8_LAS unsigned*)(lds + (bufoff) + ldsw + _i * 8192), 16, 0, 0); } while (0)
#define PG8_LDA(dst, b, h) do { _Pragma("unroll") for (int m = 0; m < 4; ++m) _Pragma("unroll") for (int k = 0; k < 2; ++k) dst[m][k] = *(const PG8_LAS bf16x8*)(lds + PG8_SA(b, h) + aoff + m * 2048 + k * 1024); } while (0)
#define PG8_LDB(dst, b, h) do { _Pragma("unroll") for (int n = 0; n < 2; ++n) _Pragma("unroll") for (int k = 0; k < 2; ++k) dst[n][k] = *(const PG8_LAS bf16x8*)(lds + PG8_SB(b, h) + boff + n * 2048 + k * 1024); } while (0)
#define PG8_MMA(ai, bj, At, Bt) do { __builtin_amdgcn_s_setprio(1); _Pragma("unroll") for (int m = 0; m < 4; ++m) _Pragma("unroll") for (int n = 0; n < 2; ++n) _Pragma("unroll") for (int k = 0; k < 2; ++k) \
        acc[ai][bj][m][n] = __builtin_amdgcn_mfma_f32_16x16x32_bf16(Bt[n][k], At[m][k], acc[ai][bj][m][n], 0, 0, 0); __builtin_amdgcn_s_setprio(0); } while (0)
#define PG8_WAIT_V(n) asm volatile("s_waitcnt vmcnt(" #n ")" ::: "memory")
#define PG8_WAIT_L(n) asm volatile("s_waitcnt lgkmcnt(" #n ")" ::: "memory")
#define PG8_BAR __builtin_amdgcn_s_barrier()
#define PG8_SCHED __builtin_amdgcn_sched_barrier(0)
    Unit cur, nxt; int ui = 0;
    if (!S.next(0, cur)) return;
    f32x4 acc[2][2][4][2];
#pragma unroll
    for (int a = 0; a < 2; ++a)
#pragma unroll
        for (int b = 0; b < 2; ++b)
#pragma unroll
            for (int m = 0; m < 4; ++m)
#pragma unroll
                for (int n = 0; n < 2; ++n) acc[a][b][m][n] = (f32x4){0.f, 0.f, 0.f, 0.f};
    bf16x8 At[4][2], B0[2][2], B1[2][2];
    const char* cA = (const char*)g.A + (size_t)cur.pm * tstep; const char* cB = (const char*)g.Bt + (size_t)cur.pn * tstep;
    S.a_ready(cur);
    if constexpr (SP2) {
        PG8_STAGE(PG8_SB(0, 0), cB, voffB); PG8_STAGE(PG8_SB(0, 1), cB + hstep, voffB); PG8_STAGE(PG8_SA(0, 0), cA, voffA); PG8_STAGE(PG8_SA(0, 1), cA + hstep, voffA);
        if (wr == 1) PG8_BAR;
        PG8_WAIT_V(2); PG8_BAR;
        PG8_STAGE(PG8_SB(1, 0), cB + kstep, voffB); PG8_STAGE(PG8_SA(1, 0), cA + kstep, voffA); PG8_STAGE(PG8_SB(1, 1), cB + hstep + kstep, voffB);
        PG8_WAIT_V(6); PG8_BAR;
    } else {
        PG8_STAGE(PG8_SB(0, 0), cB, voffB); PG8_STAGE(PG8_SA(0, 0), cA, voffA); PG8_STAGE(PG8_SB(0, 1), cB + hstep, voffB); PG8_STAGE(PG8_SA(0, 1), cA + hstep, voffA);
        if (wr == 1) PG8_BAR;
        PG8_WAIT_V(4); PG8_BAR;
        PG8_STAGE(PG8_SB(1, 0), cB + kstep, voffB); PG8_STAGE(PG8_SA(1, 0), cA + kstep, voffA); PG8_STAGE(PG8_SB(1, 1), cB + hstep + kstep, voffB);
        PG8_WAIT_V(6); PG8_BAR;
    }
    for (;;) {
        const bool has_next = S.next(ui + 1, nxt);
        const char* nA = has_next ? (const char*)g.A + (size_t)nxt.pm * tstep : cA; const char* nB = has_next ? (const char*)g.Bt + (size_t)nxt.pn * tstep : cB;
        for (int t = 0; t < nt; t += 2) {
            const bool last = (t == nt - 2);
            const char* a1 = cA + (size_t)(t + 1) * kstep;
            const char* a2 = last ? nA : cA + (size_t)(t + 2) * kstep; const char* b2 = last ? nB : cB + (size_t)(t + 2) * kstep;
            const char* a3 = a2 + kstep; const char* b3 = b2 + kstep;
            if (last && has_next) S.a_ready(nxt);
            if constexpr (SP2) {
            PG8_LDB(B0, 0, 0); PG8_LDB(B1, 0, 1); PG8_SCHED; PG8_LDA(At, 0, 0); PG8_STAGE(PG8_SA(1, 1), a1 + hstep, voffA);
            PG8_WAIT_V(8); PG8_WAIT_L(0); PG8_BAR; PG8_MMA(0, 0, At, B0); PG8_MMA(0, 1, At, B1); PG8_BAR; PG8_SCHED;
            PG8_LDA(At, 0, 1); PG8_STAGE(PG8_SB(0, 0), b2, voffB); PG8_STAGE(PG8_SB(0, 1), b2 + hstep, voffB); PG8_STAGE(PG8_SA(0, 0), a2, voffA);
            PG8_WAIT_V(8); PG8_WAIT_L(0); PG8_BAR; PG8_MMA(1, 0, At, B0); PG8_MMA(1, 1, At, B1); PG8_BAR; PG8_SCHED;
            PG8_LDB(B0, 1, 0); PG8_LDB(B1, 1, 1); PG8_SCHED; PG8_LDA(At, 1, 0); PG8_STAGE(PG8_SA(0, 1), a2 + hstep, voffA);
            PG8_WAIT_V(8); PG8_WAIT_L(0); PG8_BAR; PG8_MMA(0, 0, At, B0); PG8_MMA(0, 1, At, B1); PG8_BAR; PG8_SCHED;
            PG8_LDA(At, 1, 1); PG8_STAGE(PG8_SB(1, 0), b3, voffB); PG8_STAGE(PG8_SB(1, 1), b3 + hstep, voffB); PG8_STAGE(PG8_SA(1, 0), a3, voffA);
            PG8_WAIT_V(8); PG8_WAIT_L(0); PG8_BAR; PG8_MMA(1, 0, At, B0); PG8_MMA(1, 1, At, B1); PG8_BAR; PG8_SCHED;
            } else {
            PG8_LDB(B0, 0, 0); PG8_SCHED; PG8_LDA(At, 0, 0); PG8_STAGE(PG8_SA(1, 1), a1 + hstep, voffA);
            PG8_WAIT_L(8); PG8_BAR; PG8_WAIT_L(0); PG8_MMA(0, 0, At, B0); PG8_BAR; PG8_SCHED;
            PG8_LDB(B1, 0, 1); PG8_STAGE(PG8_SB(0, 0), b2, voffB);
            PG8_BAR; PG8_WAIT_L(0); PG8_MMA(0, 1, At, B1); PG8_BAR;
            PG8_LDA(At, 0, 1); PG8_STAGE(PG8_SA(0, 0), a2, voffA);
            PG8_BAR; PG8_WAIT_L(0); PG8_MMA(1, 0, At, B0); PG8_BAR; PG8_SCHED;
            PG8_STAGE(PG8_SB(0, 1), b2 + hstep, voffB);
            PG8_WAIT_V(6); PG8_BAR; PG8_MMA(1, 1, At, B1); PG8_BAR;
            PG8_LDB(B0, 1, 0); PG8_SCHED; PG8_LDA(At, 1, 0); PG8_STAGE(PG8_SA(0, 1), a2 + hstep, voffA);
            PG8_WAIT_L(8); PG8_BAR; PG8_WAIT_L(0); PG8_MMA(0, 0, At, B0); PG8_BAR; PG8_SCHED;
            PG8_LDB(B1, 1, 1); PG8_STAGE(PG8_SB(1, 0), b3, voffB);
            PG8_BAR; PG8_WAIT_L(0); PG8_MMA(0, 1, At, B1); PG8_BAR;
            PG8_LDA(At, 1, 1); PG8_STAGE(PG8_SA(1, 0), a3, voffA);
            PG8_BAR; PG8_WAIT_L(0); PG8_MMA(1, 0, At, B0); PG8_BAR; PG8_SCHED;
            PG8_STAGE(PG8_SB(1, 1), b3 + hstep, voffB);
            PG8_WAIT_V(6); PG8_BAR; PG8_MMA(1, 1, At, B1); PG8_BAR;
            }
        }
        if constexpr (ALIGN_EPI) { if (wr == 0) PG8_BAR; }
        if constexpr (!Epi::AFTER_DRAIN) { E(acc, cur, wr, wc, fr, fq); S.done(cur); }
        if (!has_next) break;
#pragma unroll
        for (int a = 0; a < 2; ++a)
#pragma unroll
            for (int b = 0; b < 2; ++b)
#pragma unroll
                for (int m = 0; m < 4; ++m)
#pragma unroll
                    for (int n = 0; n < 2; ++n) acc[a][b][m][n] = (f32x4){0.f, 0.f, 0.f, 0.f};
        cur = nxt; cA = nA; cB = nB; ++ui;
        if constexpr (ALIGN_EPI) { if (wr == 1) PG8_BAR; }
    }
    PG8_WAIT_V(0);
    if constexpr (!ALIGN_EPI) { if (wr == 0) PG8_BAR; }
    PG8_BAR;
    if constexpr (Epi::AFTER_DRAIN) { E.fused(acc, cur, wr, wc, fr, fq, lds, wid, lane); S.done(cur); }
#undef PG8_SA
#undef PG8_SB
#undef PG8_STAGE
#undef PG8_LDA
#undef PG8_LDB
#undef PG8_MMA
#undef PG8_WAIT_V
#undef PG8_WAIT_L
#undef PG8_BAR
#undef PG8_SCHED
}
}

#ifndef PG8_SP2
#define PG8_SP2 true
#endif
#ifndef PG8_ALIGN
#define PG8_ALIGN true
#endif
#include <hip/hip_bf16.h>
#include <cmath>
namespace attn_body {
using bf16=__hip_bfloat16;
using bf16x8=__attribute__((ext_vector_type(8)))short;
using s16x4=__attribute__((ext_vector_type(4)))short;
using f32x16=__attribute__((ext_vector_type(16)))float;
using u32x4=__attribute__((ext_vector_type(4)))unsigned;
using u32x2=__attribute__((ext_vector_type(2)))unsigned;
constexpr int BATCH=8,NHEAD=8,SEQ=4096,D=64,DM=NHEAD*D,OPITCH=1024;
constexpr int NW=8,QBLK=32,QB=QBLK*NW,KVBLK=64,NQB=SEQ/QB;
constexpr int ATTN_PITCH=DM, ATTN_UNIT_ROWS=QB;
__device__ __forceinline__ int crow(int r,int hi){return (r&3)+8*(r>>2)+4*hi;}
#define SBAR() __builtin_amdgcn_sched_barrier(0)
__device__ __forceinline__ void cmask(f32x16&p0,f32x16&p1,int jb,int qrel,int hi){
  const float NEG=-INFINITY; int kb=64*jb+4*hi;
  #pragma unroll
  for(int r=0;r<16;++r){int kv=kb+(r&3)+8*(r>>2); if(kv>qrel)p0[r]=NEG; if(kv+32>qrel)p1[r]=NEG;}
}

constexpr int NSLOT=3, SLOTB=8192;
constexpr int LDS_K=0, LDS_V=NSLOT*SLOTB, LDS_WS=2*NSLOT*SLOTB, LDS_OST=LDS_WS+NW*64*4, LDS_BIAS=LDS_OST+NW*4096, LDS_BYTES=LDS_BIAS+SEQ*8;
constexpr float C2=0.125f*1.4426950408889634f;
__device__ __forceinline__ void glds16(const void*gsrc,unsigned lds_dst){unsigned keep;
  asm volatile("s_mov_b32 %0, m0\n\ts_mov_b32 m0, %2\n\ts_nop 0\n\tglobal_load_lds_dwordx4 %1, off\n\ts_mov_b32 m0, %0":"=&s"(keep):"v"(gsrc),"s"(lds_dst):"memory");}
__device__ __forceinline__ float max3f(float a,float b,float c){float r;asm("v_max3_f32 %0, %1, %2, %3":"=v"(r):"v"(a),"v"(b),"v"(c));return r;}
__device__ __forceinline__ float max2f(float a,float b){float r;asm("v_max_f32_e32 %0, %1, %2":"=v"(r):"v"(a),"v"(b));return r;}
__device__ __forceinline__ float fadd_s(float a,float b){float r;asm("v_add_f32_e32 %0, %1, %2":"=v"(r):"v"(a),"v"(b));return r;}
__device__ __forceinline__ float fsub_s(float a,float b){float r;asm("v_sub_f32_e32 %0, %1, %2":"=v"(r):"v"(a),"v"(b));return r;}
typedef float f32x2_t __attribute__((ext_vector_type(2))); typedef __bf16 bf16x2_t __attribute__((ext_vector_type(2)));
__device__ __forceinline__ unsigned cvtpk_s(float lo,float hi){f32x2_t v={lo,hi};bf16x2_t b=__builtin_convertvector(v,bf16x2_t);return __builtin_bit_cast(unsigned,b);}
#define WAIT_BAR(N) asm volatile("s_waitcnt vmcnt(" #N ") lgkmcnt(0)\n\ts_barrier":::"memory")

__device__ __forceinline__ void qkt(f32x16&p0,f32x16&p1,const char*Kslot,const bf16x8*qr,const f32x16&negm,int r32,int hi,bf16x8 kx0,bf16x8 kx1,bf16x8 qx){
  const char*kb=Kslot+hi*1024+r32*16;
  p0=__builtin_amdgcn_mfma_f32_32x32x16_bf16(kx0,qx,negm,0,0,0);p1=__builtin_amdgcn_mfma_f32_32x32x16_bf16(kx1,qx,negm,0,0,0);
  #pragma unroll
  for(int d0=0;d0<4;++d0){
    const bf16x8 b0=*reinterpret_cast<const bf16x8*>(kb+d0*2048);
    const bf16x8 b1=*reinterpret_cast<const bf16x8*>(kb+d0*2048+512);
    p0=__builtin_amdgcn_mfma_f32_32x32x16_bf16(b0,qr[d0],p0,0,0,0);p1=__builtin_amdgcn_mfma_f32_32x32x16_bf16(b1,qr[d0],p1,0,0,0);}
}
typedef __attribute__((address_space(3))) const char* lds_cptr;
typedef short v4i16_t __attribute__((ext_vector_type(4)));
__device__ __forceinline__ void kload8(bf16x8*kf,lds_cptr kp){
  kf[0]=*(const __attribute__((address_space(3))) bf16x8*)(kp);      kf[1]=*(const __attribute__((address_space(3))) bf16x8*)(kp+512);
  kf[2]=*(const __attribute__((address_space(3))) bf16x8*)(kp+2048); kf[3]=*(const __attribute__((address_space(3))) bf16x8*)(kp+2560);
  kf[4]=*(const __attribute__((address_space(3))) bf16x8*)(kp+4096); kf[5]=*(const __attribute__((address_space(3))) bf16x8*)(kp+4608);
  kf[6]=*(const __attribute__((address_space(3))) bf16x8*)(kp+6144); kf[7]=*(const __attribute__((address_space(3))) bf16x8*)(kp+6656);
}
__device__ __forceinline__ void kload2(bf16x8*kf,lds_cptr kp,int j){ kf[2*j]=*(const __attribute__((address_space(3))) bf16x8*)(kp+j*2048); kf[2*j+1]=*(const __attribute__((address_space(3))) bf16x8*)(kp+j*2048+512); }
__device__ __forceinline__ s16x4 vtr(lds_cptr p){ return __builtin_bit_cast(s16x4,__builtin_amdgcn_ds_read_tr16_b64_v4i16((__attribute__((address_space(3))) v4i16_t*)p)); }
__device__ __forceinline__ float rowmax(const f32x16&p0,const f32x16&p1){
  float a=max3f(p0[0],p0[1],p1[0]),b=max3f(p0[2],p0[3],p1[1]);a=max3f(a,p1[2],p1[3]);
  #pragma unroll
  for(int r=4;r<16;r+=4){a=max3f(a,p0[r],p0[r+1]);b=max3f(b,p0[r+2],p0[r+3]);a=max3f(a,p1[r],p1[r+1]);b=max3f(b,p1[r+2],p1[r+3]);}
  const float m=max2f(a,b);
  auto rr=__builtin_amdgcn_permlane32_swap(__float_as_uint(m),__float_as_uint(m),false,false);
  return max2f(__uint_as_float(rr[0]),__uint_as_float(rr[1]));
}
__device__ __forceinline__ void pv(f32x16*o,int vb,bf16x8 pa0,bf16x8 pa1,bf16x8 pa2,bf16x8 pa3){
  #pragma unroll
  for(int d0=0;d0<2;++d0){s16x4 lo[4],hi[4];
    #pragma unroll
    for(int ks=0;ks<4;++ks){
      asm volatile("ds_read_b64_tr_b16 %0,%1 offset:%c2":"=&v"(lo[ks]):"v"(vb),"i"(d0*4096+ks*1024):"memory");
      asm volatile("ds_read_b64_tr_b16 %0,%1 offset:%c2":"=&v"(hi[ks]):"v"(vb),"i"(d0*4096+ks*1024+512):"memory");}
    asm volatile("s_waitcnt lgkmcnt(0)":::"memory");SBAR();
    #define PK(k) (bf16x8){lo[k][0],lo[k][1],lo[k][2],lo[k][3],hi[k][0],hi[k][1],hi[k][2],hi[k][3]}
    o[d0]=__builtin_amdgcn_mfma_f32_32x32x16_bf16(pa0,PK(0),o[d0],0,0,0);
    o[d0]=__builtin_amdgcn_mfma_f32_32x32x16_bf16(pa1,PK(1),o[d0],0,0,0);
    o[d0]=__builtin_amdgcn_mfma_f32_32x32x16_bf16(pa2,PK(2),o[d0],0,0,0);
    o[d0]=__builtin_amdgcn_mfma_f32_32x32x16_bf16(pa3,PK(3),o[d0],0,0,0);
    #undef PK
  }
}

#ifndef ATTN_STORE16
#define ATTN_STORE16(p,v) (*(u32x4*)(p)=(v))
#endif
template<int THRL> __device__ __forceinline__ void attn_unit(int b,int h,int qb,const bf16*Q,const bf16*__restrict__ K,const bf16*__restrict__ V,bf16*O,const float*__restrict__ cum2,float*ssb,char*shm){
  const int tid=otid(),lane=tid&63,r32=lane&31,hi=lane>>5; const int wid=__builtin_amdgcn_readfirstlane(tid>>6);
  const long rowbase=(long)b*SEQ; const int q0=qb*QB;
  const bf16*Qw=Q+(rowbase+q0+wid*QBLK)*DM+h*D;
  const bf16*Kh=K+rowbase*DM+h*D,*Vh=V+rowbase*DM+h*D;
  const lds_cptr shm3=(lds_cptr)shm;
  const unsigned lds0=(unsigned)(uintptr_t)shm;
  float*wsf=(float*)(shm+LDS_WS)+wid*64;
  const bf16*ksrc=Kh+(long)lane*DM+wid*8;
  const bf16*vsrc=Vh+(long)(16*(wid&3)+(lane>>2))*DM+(wid>>2)*32+(lane&3)*8;
  const unsigned kdst=lds0+LDS_K+wid*1024, vdst=lds0+LDS_V+wid*1024;
  #define DMA_K(t,slot) glds16(ksrc+(long)(t)*KVBLK*DM,(unsigned)__builtin_amdgcn_readfirstlane(kdst+(slot)))
  #define DMA_V(t,slot) glds16(vsrc+(long)(t)*KVBLK*DM,(unsigned)__builtin_amdgcn_readfirstlane(vdst+(slot)))
  const int vb0=(int)(lds0+LDS_V)+((lane>>4)&1)*32+(lane&3)*8+(4*hi+((lane&15)>>2))*64;
  const char*Kbase=shm+LDS_K; bf16x8 kf[8];
  const lds_cptr kp0=shm3+LDS_K+hi*1024+r32*16; const lds_cptr vp0=shm3+LDS_V+((lane>>4)&1)*32+(lane&3)*8+(4*hi+((lane&15)>>2))*64;
  const int NT=(q0+QB)/KVBLK;
  { const float*cumh=cum2+(long)(b*NHEAD+h)*SEQ; const float cref=cumh[q0];
    for(int i=tid;i<q0+QB;i+=NW*64){ const float x=cref-cumh[i]; const unsigned u1=__float_as_uint(x)&0xffff0000u; const float r1=x-__uint_as_float(u1);
      const unsigned u2=__float_as_uint(r1)&0xffff0000u; const float r2=r1-__uint_as_float(u2); const unsigned u3=__float_as_uint(r2)&0xffff0000u;
      u32x2 w; w.x=(u1>>16)|u2; w.y=u3>>16; *(__attribute__((address_space(3))) u32x2*)(shm3+LDS_BIAS+i*8)=w; } }
  const lds_cptr bp0=shm3+LDS_BIAS+r32*8;
  bf16x8 qx; { const u32x4 t=(hi==0)?(u32x4){0x3F803F80u,0x00003F80u,0u,0u}:(u32x4){0u,0u,0u,0u}; qx=__builtin_bit_cast(bf16x8,t); }
  #define BIASLD(t,which) ({ const u32x2 w_=*(const __attribute__((address_space(3))) u32x2*)(bp0+(t)*512+(which)*256); const u32x4 t_=(u32x4){w_.x,w_.y,0u,0u}; __builtin_bit_cast(bf16x8,t_); })
  DMA_K(0,0);DMA_V(0,0);DMA_K(1,SLOTB);
  bf16x8 qr[4];
  #pragma unroll
  for(int d0=0;d0<4;++d0)qr[d0]=*reinterpret_cast<const bf16x8*>(&Qw[(long)r32*DM+d0*16+hi*8]);
  float mhat=0.f,l_reg=0.f;f32x16 o[2];o[0]=f32x16{};o[1]=f32x16{};f32x16 negm=f32x16{};asm volatile("":"+v"(negm));
  const int qrel=wid*QBLK+r32;
  #define CMASK(P0,P1,t) do{int jb_=(t)-(NT-4); if(jb_>=0)cmask(P0,P1,jb_,qrel,hi);}while(0)
  bool resc=false;
  #define START(P0,P1) do{ const float rm=rowmax(P0,P1); resc=false; \
    { const float dl=rm; mhat=fadd_s(mhat,dl); \
      _Pragma("unroll") for(int r=0;r<16;++r){P0[r]=fsub_s(P0[r],dl);P1[r]=fsub_s(P1[r],dl);} \
      _Pragma("unroll") for(int r=0;r<16;++r)negm[r]=-mhat; asm volatile("":"+v"(negm)); } \
    _Pragma("unroll") for(int r=0;r<16;++r)P0[r]=__builtin_amdgcn_exp2f(P0[r]); }while(0)
  #define RESC() do{ if(resc){ asm volatile("s_waitcnt lgkmcnt(0)":::"memory"); \
      _Pragma("unroll") for(int d_=0;d_<2;++d_) _Pragma("unroll") for(int r=0;r<16;++r)o[d_][r]*=wsf[crow(r,hi)]; } }while(0)
  f32x16 pA0,pA1,pB0,pB1;
  int sl_prev=0,sl_cur=0,sl_next=SLOTB;
  #define ROT() do{sl_prev=sl_cur;sl_cur=sl_next;sl_next=(sl_next==(NSLOT-1)*SLOTB)?0:sl_next+SLOTB;}while(0)
  DMA_K(2,2*SLOTB);
  WAIT_BAR(3);
  qkt(pA0,pA1,Kbase,qr,negm,r32,hi,BIASLD(0,0),BIASLD(0,1),qx);asm volatile("s_nop 15\n\ts_nop 7":"+v"(pA0),"+v"(pA1));CMASK(pA0,pA1,0);
  START(pA0,pA1);
  _Pragma("unroll") for(int r=0;r<16;++r)pA1[r]=__builtin_amdgcn_exp2f(pA1[r]);
  WAIT_BAR(0);
  DMA_K(3,0);DMA_V(1,SLOTB);
  ROT();
  kload8(kf,kp0+sl_cur);
  WAIT_BAR(2);
  s16x4 vlo[8],vhi[8]; u32x4 pw0,pw1,pw2,pw3;
  #define PKW(P,B) cvtpk_s(P[B],P[B+1])
  #define PAF(k) __builtin_bit_cast(bf16x8,pw##k)
  #define VFR(i) (bf16x8){vlo[i][0],vlo[i][1],vlo[i][2],vlo[i][3],vhi[i][0],vhi[i][1],vhi[i][2],vhi[i][3]}
  #define PIN(x) asm volatile("":"+v"(x))
  #define MX3(a,b,c) __builtin_fmaxf(__builtin_fmaxf((a),(b)),(c))
  #define GAPA(MF,A0,A1,A2,A3,W0,W1,PW) do{ MF; sacc+=A0; sacc+=A1; sacc+=A2; sacc+=A3; PIN(sacc); W0; W1; PIN(PW); SBAR(); }while(0)
  #define EX(v) __builtin_amdgcn_exp2f(v)
  #define GAPB(MF,X,B) do{ MF; X[B]=EX(X[B]); X[B+1]=EX(X[B+1]); X[B+2]=EX(X[B+2]); X[B+3]=EX(X[B+3]); PIN(X); SBAR(); }while(0)
  #define VRD(i) do{ vlo[i]=vtr(vp_+(((i)>>2)*4096+((i)&3)*1024)); vhi[i]=vtr(vp_+(((i)>>2)*4096+((i)&3)*1024+512)); }while(0)
  #define KRD(G,j) do{ if(G){ kload2(kf,kp0+sl_next,j); SBAR(); } }while(0)
  #define STEP(C0,C1,P0,P1,t,GK,GV,GL) do{ SBAR(); \
    const lds_cptr vp_=vp0+sl_prev; \
    C0=__builtin_amdgcn_mfma_f32_32x32x16_bf16(kbx0,qx,negm,0,0,0); C1=__builtin_amdgcn_mfma_f32_32x32x16_bf16(kbx1,qx,negm,0,0,0); SBAR(); \
    VRD(0); SBAR(); float sacc=(P0[0]+P0[1]); \
    GAPA(C0=__builtin_amdgcn_mfma_f32_32x32x16_bf16(kf[0],qr[0],C0,0,0,0), P0[2],P0[3],P0[4],P0[5],     pw0[0]=PKW(P0,0), pw0[1]=PKW(P0,2), pw0); \
    VRD(4); SBAR(); GAPA(C1=__builtin_amdgcn_mfma_f32_32x32x16_bf16(kf[1],qr[0],C1,0,0,0), P0[6],P0[7],P0[8],P0[9],     pw0[2]=PKW(P0,4), pw0[3]=PKW(P0,6), pw0); \
    VRD(1); SBAR(); GAPA(C0=__builtin_amdgcn_mfma_f32_32x32x16_bf16(kf[2],qr[1],C0,0,0,0),   P0[10],P0[11],P0[12],P0[13], pw1[0]=PKW(P0,8), pw1[1]=PKW(P0,10), pw1); \
    VRD(5); SBAR(); GAPA(C1=__builtin_amdgcn_mfma_f32_32x32x16_bf16(kf[3],qr[1],C1,0,0,0),   P0[14],P0[15],P1[0],P1[1],   pw1[2]=PKW(P0,12),pw1[3]=PKW(P0,14), pw1); \
    VRD(2); SBAR(); GAPA(C0=__builtin_amdgcn_mfma_f32_32x32x16_bf16(kf[4],qr[2],C0,0,0,0),   P1[2],P1[3],P1[4],P1[5],     pw2[0]=PKW(P1,0), pw2[1]=PKW(P1,2), pw2); \
    VRD(6); SBAR(); GAPA(C1=__builtin_amdgcn_mfma_f32_32x32x16_bf16(kf[5],qr[2],C1,0,0,0),   P1[6],P1[7],P1[8],P1[9],     pw2[2]=PKW(P1,4), pw2[3]=PKW(P1,6), pw2); \
    VRD(3); SBAR(); GAPA(C0=__builtin_amdgcn_mfma_f32_32x32x16_bf16(kf[6],qr[3],C0,0,0,0),   P1[10],P1[11],P1[12],P1[13], pw3[0]=PKW(P1,8), pw3[1]=PKW(P1,10), pw3); \
    VRD(7); SBAR(); GAPA(C1=__builtin_amdgcn_mfma_f32_32x32x16_bf16(kf[7],qr[3],C1,0,0,0),   P1[14],P1[15],0.f,0.f,       pw3[2]=PKW(P1,12),pw3[3]=PKW(P1,14), pw3); \
    l_reg+=sacc; \
    if(GK){DMA_K((t)+3,sl_cur);} if(GV){DMA_V((t)+1,sl_next);} \
    CMASK(C0,C1,t); \
    { float a=MX3(C0[0],C0[1],C1[0]),b=MX3(C0[2],C0[3],C1[1]); a=MX3(a,C1[2],C1[3]); \
      _Pragma("unroll") for(int r=4;r<16;r+=4){a=MX3(a,C0[r],C0[r+1]);b=MX3(b,C0[r+2],C0[r+3]);a=MX3(a,C1[r],C1[r+1]);b=MX3(b,C1[r+2],C1[r+3]);} \
      float rm=__builtin_fmaxf(a,b); { auto rr=__builtin_amdgcn_permlane32_swap(__float_as_uint(rm),__float_as_uint(rm),false,false); rm=__builtin_fmaxf(__uint_as_float(rr[0]),__uint_as_float(rr[1])); } \
      resc=false; \
      if(__builtin_expect(__any(rm>(float)THRL),0)){ const float dl=__builtin_fmaxf(rm,0.f); mhat+=dl; \
        _Pragma("unroll") for(int r=0;r<16;++r){C0[r]-=dl;C1[r]-=dl;} \
        _Pragma("unroll") for(int r=0;r<16;++r)negm[r]=-mhat; asm volatile("":"+v"(negm)); \
        const float f=__builtin_amdgcn_exp2f(-dl); l_reg*=f; if(hi==0)wsf[r32]=f; resc=true; } } \
    SBAR(); \
    GAPB(o[0]=__builtin_amdgcn_mfma_f32_32x32x16_bf16(PAF(0),VFR(0),o[0],0,0,0), C0,0); \
    GAPB(o[1]=__builtin_amdgcn_mfma_f32_32x32x16_bf16(PAF(0),VFR(4),o[1],0,0,0), C0,4); \
    KRD(GL,0); GAPB(o[0]=__builtin_amdgcn_mfma_f32_32x32x16_bf16(PAF(1),VFR(1),o[0],0,0,0), C0,8); \
    KRD(GL,1); GAPB(o[1]=__builtin_amdgcn_mfma_f32_32x32x16_bf16(PAF(1),VFR(5),o[1],0,0,0), C0,12); \
    KRD(GL,2); GAPB(o[0]=__builtin_amdgcn_mfma_f32_32x32x16_bf16(PAF(2),VFR(2),o[0],0,0,0), C1,0); \
    KRD(GL,3); GAPB(o[1]=__builtin_amdgcn_mfma_f32_32x32x16_bf16(PAF(2),VFR(6),o[1],0,0,0), C1,4); \
    GAPB(o[0]=__builtin_amdgcn_mfma_f32_32x32x16_bf16(PAF(3),VFR(3),o[0],0,0,0), C1,8); \
    GAPB(o[1]=__builtin_amdgcn_mfma_f32_32x32x16_bf16(PAF(3),VFR(7),o[1],0,0,0), C1,12); \
    if(GL){ kbx0=BIASLD((t)+1,0); kbx1=BIASLD((t)+1,1); } \
    }while(0)
  int t=1; bf16x8 kbx0=BIASLD(1,0),kbx1=BIASLD(1,1);
  #undef CMASK
  #define CMASK(P0,P1,t) do{}while(0)
  for(;t+5<NT;t+=2){
    STEP(pB0,pB1,pA0,pA1,t,true,true,true);     WAIT_BAR(2); RESC(); ROT();
    STEP(pA0,pA1,pB0,pB1,t+1,true,true,true);   WAIT_BAR(2); RESC(); ROT();
  }
  #undef CMASK
  #define CMASK(P0,P1,t) do{int jb_=(t)-(NT-4); if(jb_>=0)cmask(P0,P1,jb_,qrel,hi);}while(0)
  #define ENDW(tt) do{ if((tt)+3<NT){WAIT_BAR(2);} else if((tt)+2<NT){WAIT_BAR(1);} else {WAIT_BAR(0);} }while(0)
  for(;t+1<NT;t+=2){
    STEP(pB0,pB1,pA0,pA1,t,(t+3<NT),(t+1<NT),(t+1<NT));       ENDW(t);   RESC(); ROT();
    STEP(pA0,pA1,pB0,pB1,t+1,(t+4<NT),(t+2<NT),(t+2<NT));     ENDW(t+1); RESC(); ROT();
  }
  STEP(pB0,pB1,pA0,pA1,NT-1,false,false,false); RESC();
  { float sacc=pB0[0]+pB0[1]; _Pragma("unroll") for(int r=2;r<16;++r)sacc+=pB0[r]; _Pragma("unroll") for(int r=0;r<16;++r)sacc+=pB1[r]; l_reg+=sacc;
    pw0=(u32x4){PKW(pB0,0),PKW(pB0,2),PKW(pB0,4),PKW(pB0,6)};pw1=(u32x4){PKW(pB0,8),PKW(pB0,10),PKW(pB0,12),PKW(pB0,14)};pw2=(u32x4){PKW(pB1,0),PKW(pB1,2),PKW(pB1,4),PKW(pB1,6)};pw3=(u32x4){PKW(pB1,8),PKW(pB1,10),PKW(pB1,12),PKW(pB1,14)};
    SBAR(); pv(o,vb0+sl_cur,PAF(0),PAF(1),PAF(2),PAF(3)); }
  #undef PKW
  #undef PAF
  #undef VFR
  #undef PIN
  #undef MX3
  #undef GAPA
  #undef GAPB
  #undef EX
  #undef VRD
  #undef KRD
  #undef STEP
  #undef ENDW
  {auto rr=__builtin_amdgcn_permlane32_swap(__float_as_uint(l_reg),__float_as_uint(l_reg),false,false);l_reg=__uint_as_float(rr[0])+__uint_as_float(rr[1]);}
  if(hi==0)wsf[32+r32]=l_reg;asm volatile("s_waitcnt lgkmcnt(0)":::"memory");
  float rli[16];
  #pragma unroll
  for(int r=0;r<16;++r)rli[r]=__builtin_amdgcn_rcpf(wsf[32+crow(r,hi)]);
  bf16*Ow=O+(rowbase+q0+wid*QBLK)*OPITCH+h*D; float*ssw=ssb+(long)h*(BATCH*SEQ)+rowbase+q0+wid*QBLK;
  { bf16*stg=(bf16*)(shm+LDS_OST)+wid*2048;
    #pragma unroll
    for(int r=0;r<16;++r){const int orow=crow(r,hi);
      #pragma unroll
      for(int d0=0;d0<2;++d0)stg[orow*64+d0*32+r32]=__float2bfloat16(o[d0][r]*rli[r]);}
    asm volatile("s_waitcnt lgkmcnt(0)":::"memory");
    #pragma unroll
    for(int i=0;i<4;++i){const int row=i*8+(lane>>3),ch=lane&7; const u32x4 v=*(const u32x4*)(stg+row*64+ch*8); ATTN_STORE16(Ow+(long)row*OPITCH+ch*8,v);
      float q=0.f;
      #pragma unroll
      for(int e=0;e<4;++e){const float lo=__uint_as_float(v[e]<<16),hi2=__uint_as_float(v[e]&0xffff0000u); q+=lo*lo+hi2*hi2;}
      q+=__shfl_xor(q,1);q+=__shfl_xor(q,2);q+=__shfl_xor(q,4); if(ch==0)ssw[row]=q;} }
  asm volatile("s_waitcnt lgkmcnt(0)\n\ts_barrier":::"memory");
  #undef DMA_K
  #undef DMA_V
  #undef BIASLD
  #undef CMASK
  #undef START
  #undef RESC
  #undef ROT
}
constexpr int ATTN_LDS_BYTES=LDS_BYTES;
struct AttnTensors { const bf16* Q; const bf16* K; const bf16* V; bf16* O; const float* cum2; float* ssb; };
struct AttnUnit { int bh; int qb; };
struct StaticOrder {
  int vcu;
  __device__ __forceinline__ explicit StaticOrder(int grid,int block):vcu((block%8)*(grid/8)+block/8){}
  __device__ __forceinline__ bool next(int i,AttnUnit&u)const{ if(i>=4||vcu>=256)return false; const int s=vcu&3; u.bh=vcu>>2; u.qb=(i==0)?s:(i==1)?7-s:(i==2)?8+s:15-s; return true; }
  __device__ __forceinline__ void a_ready(const AttnUnit&)const{}
  __device__ __forceinline__ void done(const AttnUnit&)const{}
};
template<class Sched,int THRL=8> __device__ __forceinline__ void attn_phase(char*lds,const AttnTensors&T,const Sched&S){
  AttnUnit u;
  for(int i=0;S.next(i,u);++i){ S.a_ready(u); attn_unit<THRL>(u.bh/NHEAD,u.bh%NHEAD,u.qb,T.Q,T.K,T.V,T.O,T.cum2,T.ssb,lds); S.done(u); }
}
#undef SBAR
#undef WAIT_BAR
}
constexpr int NWAVES = 8;
constexpr int BATCH = 8, SEQ = 4096, DM_ = 1024, DFF = 2816, NIN = 2568, DA = 512, HA = 8, HB = 8;
constexpr int M = BATCH * SEQ;
constexpr float EPS = 1e-6f;
constexpr size_t MiB = 1u << 20;
constexpr size_t WS_MOD = 0;
constexpr size_t WS_LOGF = 1 * MiB;
constexpr size_t WS_CUM = 2 * MiB;
constexpr size_t WS_SS = 3 * MiB;
constexpr size_t WS_SSA = 5 * MiB;
constexpr size_t WS_SSB = 6 * MiB;
constexpr size_t WS_WGU0 = 8 * MiB;
constexpr size_t WS_WGU1 = 20 * MiB;
constexpr size_t WS_WD0 = 32 * MiB;
constexpr size_t WS_WD1 = 38 * MiB;
constexpr size_t WS_WIN = 44 * MiB;
constexpr size_t WS_WOUT = 50 * MiB;
constexpr size_t WS_H = 64 * MiB;
constexpr size_t WS_HD = 128 * MiB;
constexpr size_t WS_ACT = 192 * MiB;
constexpr size_t WS_ZG = 192 * MiB;
constexpr size_t WS_Q = 256 * MiB, WS_K = 288 * MiB, WS_V = 320 * MiB;
constexpr size_t WS_Y = 352 * MiB;
constexpr size_t WS_END = 416 * MiB;
static_assert(WS_ACT + (size_t)M * DFF * 2 <= WS_END && WS_Y + (size_t)M * 1024 * 2 <= WS_END, "ws map");
constexpr int LDS_BYTES = 147456;
constexpr int LDS_BARST = LDS_BYTES - 64;
constexpr size_t WS_CTL = 7 * MiB, CTL_BYTES = 16384;

#define GAS __attribute__((address_space(1)))
#define LAS __attribute__((address_space(3)))
typedef unsigned short bf16;
typedef unsigned v4u __attribute__((ext_vector_type(4)));
typedef unsigned v2u __attribute__((ext_vector_type(2)));
typedef float f32x4 __attribute__((ext_vector_type(4)));
typedef short bf16x8 __attribute__((ext_vector_type(8)));
#define LDS_WAIT() asm volatile("s_waitcnt lgkmcnt(0)" ::: "memory")
__device__ __forceinline__ unsigned f2bf(float f) { unsigned u = __builtin_bit_cast(unsigned, f); return (u + 0x7fffu + ((u >> 16) & 1u)) >> 16; }
__device__ __forceinline__ unsigned pk2(float lo, float hi) { return f2bf(lo) | (f2bf(hi) << 16); }
__device__ __forceinline__ float bf_lo(unsigned w) { return __builtin_bit_cast(float, w << 16); }
__device__ __forceinline__ float bf_hi(unsigned w) { return __builtin_bit_cast(float, w & 0xffff0000u); }
__device__ __forceinline__ float wave_sum(float v) {
#pragma unroll
    for (int o = 1; o < 64; o <<= 1) v += __shfl_xor(v, o);
    return v;
}

#define XB_TMO      128
#define XB_XCNT(j)  (256  + 64 * (j))
#define XB_XSUB(j)  (1280 + 64 * (j))
#define XB_XGEN(j)  (2304 + 64 * (j))
#define XB_TOP      3328
#define XB_TOPGEN   3392
#define XCD_BAR_WORDS 3456
#define XB_SPIN_CAP (1u << 18)

__device__ __forceinline__ unsigned xb_ld(unsigned* p)              { return __hip_atomic_load(p, __ATOMIC_RELAXED, __HIP_MEMORY_SCOPE_AGENT); }
__device__ __forceinline__ unsigned xb_add(unsigned* p, unsigned v) { return __hip_atomic_fetch_add(p, v, __ATOMIC_RELAXED, __HIP_MEMORY_SCOPE_AGENT); }
__device__ __forceinline__ unsigned xb_xcc_id() { return (unsigned)__builtin_amdgcn_s_getreg((3 << 11) | 20) & 0xFu; }
#define XB_SPIN(cond, bar) do { unsigned _sp = 0; while (cond) { __builtin_amdgcn_s_sleep(1); \
    if ((++_sp & 255u) == 0u) { if (xb_ld(&(bar)[XB_TMO])) break; if (_sp > XB_SPIN_CAP) { atomicAdd(&(bar)[XB_TMO], 1u); break; } } } } while (0)

struct XcdBarrier {
    unsigned* bar; unsigned x;
    volatile LAS unsigned* st;
};

__device__ __forceinline__ XcdBarrier xcd_barrier_post(unsigned* bar, volatile LAS unsigned* st) {
    XcdBarrier b; b.bar = bar; b.x = xb_xcc_id(); b.st = st;
    if (threadIdx.x == 0) (void)xb_add(&bar[XB_XCNT(b.x)], 1u);
    return b;
}
__device__ __forceinline__ void xcd_barrier_complete(unsigned* bar, unsigned x, unsigned& nloc, unsigned& nx) {
    const unsigned G = gridDim.x * gridDim.y * gridDim.z;
    unsigned sum, cnt, mine, sp = 0u;
    for (;;) {
        sum = 0u; cnt = 0u; mine = 0u;
#pragma unroll
        for (unsigned j = 0; j < 16; ++j) { const unsigned c = xb_ld(&bar[XB_XCNT(j)]); sum += c; cnt += (c > 0u) ? 1u : 0u; mine = (j == x) ? c : mine; }
        if (sum == G) break;
        __builtin_amdgcn_s_sleep(1);
        if ((++sp & 255u) == 0u) { if (xb_ld(&bar[XB_TMO])) break; if (sp > XB_SPIN_CAP) { atomicAdd(&bar[XB_TMO], 1u); break; } }
    }
    nloc = mine > 0u ? mine : 1u; nx = cnt > 0u ? cnt : 1u;
}

__device__ __forceinline__ void xcd_barrier(const XcdBarrier& b) {
    asm volatile("s_waitcnt vmcnt(0)" ::: "memory");
    __syncthreads();
    if (threadIdx.x == 0) {
        unsigned* bar = b.bar;
        __builtin_amdgcn_s_waitcnt(0);
        unsigned nloc = b.st[0], nx = b.st[1];
        if (nloc == 0u) { xcd_barrier_complete(bar, b.x, nloc, nx); b.st[0] = nloc; b.st[1] = nx; }
        const unsigned old = xb_add(&bar[XB_XSUB(b.x)], 1u);
        const unsigned gen = old / nloc;
        if (old + 1u == (gen + 1u) * nloc) {
            __builtin_amdgcn_fence(__ATOMIC_RELEASE, "agent");
            asm volatile("s_waitcnt vmcnt(0)" ::: "memory");
            const unsigned og = xb_add(&bar[XB_TOP], 1u);
            const unsigned tg = og / nx;
            if (og + 1u == (tg + 1u) * nx) xb_add(&bar[XB_TOPGEN], 1u);
            else XB_SPIN(xb_ld(&bar[XB_TOPGEN]) == tg, bar);
            __builtin_amdgcn_fence(__ATOMIC_ACQUIRE, "agent");
            xb_add(&bar[XB_XGEN(b.x)], 1u);
            asm volatile("s_waitcnt vmcnt(0)" ::: "memory");
        } else {
            XB_SPIN(xb_ld(&bar[XB_XGEN(b.x)]) == gen, bar);
            __builtin_amdgcn_fence(__ATOMIC_ACQUIRE, "agent");
            asm volatile("s_waitcnt vmcnt(0)" ::: "memory");
        }
    }
    __syncthreads();
}

struct Params {
    const float *x, *c, *w_ada, *b_ada, *pre_g, *post_g, *w_gate, *w_up, *w_down, *w_in, *ln_g, *ln_b, *sgu_w, *sgu_b, *b_f, *gn_a, *gn_b, *w_out;
    float* out; unsigned char* ws;
};

__device__ __forceinline__ void adaln_item(const Params& p, LAS unsigned char* lds, int cgp, int tid, int lane, int wave) {
    LAS float* sc = (LAS float*)lds;
    LAS float* red = (LAS float*)(lds + 32768);
    for (int idx = tid; idx < 8192; idx += 512) { const int b = idx >> 10, k = idx & 1023; const float v = p.c[idx]; sc[k * 8 + b] = v * pg8::fast_sigmoid(v); }
    __syncthreads();
    float acc[8];
#pragma unroll
    for (int b = 0; b < 8; ++b) acc[b] = 0.f;
    const float* wp = p.w_ada + (size_t)(wave * 128) * 9216 + cgp * 64 + lane;
#pragma unroll 8
    for (int k = 0; k < 128; ++k) { const float wv = wp[(size_t)k * 9216]; const f32x4 s0 = *(const LAS f32x4*)(sc + (wave * 128 + k) * 8), s1 = *(const LAS f32x4*)(sc + (wave * 128 + k) * 8 + 4);
        acc[0] += s0[0] * wv; acc[1] += s0[1] * wv; acc[2] += s0[2] * wv; acc[3] += s0[3] * wv; acc[4] += s1[0] * wv; acc[5] += s1[1] * wv; acc[6] += s1[2] * wv; acc[7] += s1[3] * wv; }
#pragma unroll
    for (int b = 0; b < 8; ++b) red[(wave * 8 + b) * 64 + lane] = acc[b];
    __syncthreads();
    { const int b = wave; float s = 0.f;
#pragma unroll
      for (int w = 0; w < 8; ++w) s += red[(w * 8 + b) * 64 + lane];
      const int j = cgp * 64 + lane; ((float*)(p.ws + WS_MOD))[b * 9216 + j] = s + p.b_ada[j]; }
    __syncthreads();
}
__device__ __forceinline__ void transpose_item(const float* W, int ldw, int k0, int n0, bf16* WT, int K, int drow0, LAS float* scr, int lane) {
#pragma unroll 8
    for (int i = 0; i < 32; ++i) { const int kk = 2 * i + (lane >> 5); scr[kk * 33 + (lane & 31)] = W[(size_t)(k0 + kk) * ldw + n0 + (lane & 31)]; }
    LDS_WAIT(); asm volatile("" ::: "memory");
    const int c = lane & 7;
#pragma unroll
    for (int j = 0; j < 4; ++j) { const int n = (lane >> 3) + 8 * j; const LAS float* s = scr + (8 * c) * 33 + n;
        v4u o; o.x = pk2(s[0 * 33], s[1 * 33]); o.y = pk2(s[2 * 33], s[3 * 33]); o.z = pk2(s[4 * 33], s[5 * 33]); o.w = pk2(s[6 * 33], s[7 * 33]);
        *(GAS v4u*)(WT + (size_t)(drow0 + n) * K + k0 + 8 * c) = o; }
    LDS_WAIT(); asm volatile("" ::: "memory");
}
__device__ __forceinline__ void convert_weights(const Params& p, LAS unsigned char* lds, int gw, int NGW, int lane, int wave) {
    LAS float* scr = (LAS float*)(lds + wave * 16384);
    constexpr int I_GU = 16 * 88, I_D = 44 * 32, I_IN = 16 * 80, I_OUT = 16 * 32;
    constexpr int NITEMS = 6 * I_GU + I_IN + I_OUT;
    static_assert(I_GU == I_D, "items");
    for (int it = gw; it < NITEMS; it += NGW) {
        int r = it;
        if (r < 4 * I_GU) {
            const int which = r / I_GU; r -= which * I_GU; const int f = which >> 1, up = which & 1;
            const int kb = r / 88, nb = r % 88, n0 = nb * 32;
            const float* W = (up ? p.w_up : p.w_gate) + (size_t)f * 1024 * DFF;
            bf16* WT = (bf16*)(p.ws + (f ? WS_WGU1 : WS_WGU0));
            transpose_item(W, DFF, kb * 64, n0, WT, 1024, 256 * (n0 >> 7) + (n0 & 127) + (up ? 128 : 0), scr, lane); continue; }
        r -= 4 * I_GU;
        if (r < 2 * I_D) { const int f = r / I_D; r -= f * I_D; const int kb = r / 32, nb = r % 32;
            transpose_item(p.w_down + (size_t)f * DFF * 1024, 1024, kb * 64, nb * 32, (bf16*)(p.ws + (f ? WS_WD1 : WS_WD0)), DFF, nb * 32, scr, lane); continue; }
        r -= 2 * I_D;
        if (r < I_IN) { const int kb = r / 80, nb = r % 80; transpose_item(p.w_in, NIN, kb * 64, nb * 32, (bf16*)(p.ws + WS_WIN), 1024, nb * 32, scr, lane); continue; }
        r -= I_IN;
        { const int kb = r / 32, nb = r % 32; transpose_item(p.w_out, 1024, kb * 64, nb * 32, (bf16*)(p.ws + WS_WOUT), 1024, nb * 32, scr, lane); }
    }
}

template <int MODE> __device__ __forceinline__ void ew_phase(const Params& p, LAS unsigned char* lds, int gw, int lane, const float* xin, int sub_res, float coef, int sub_next) {
    const int row0 = gw * 16; if (row0 >= M) return;
    const int b = row0 / SEQ;
    const float* mod = (const float*)(p.ws + WS_MOD) + (size_t)b * 9216;
    f32x4 G[4], A[4], S[4];
    if (MODE & 1) {
#pragma unroll
        for (int j = 0; j < 4; ++j) { const int col = 4 * lane + 256 * j; const f32x4 gt = *(const f32x4*)(mod + sub_res * 3072 + 2048 + col), pg = *(const f32x4*)(p.post_g + sub_res * 1024 + col); G[j] = coef * (1.0f + gt) * pg; }
        asm volatile("" : "+v"(G[0]), "+v"(G[1]), "+v"(G[2]), "+v"(G[3]) :: "memory");
    }
    if (MODE & 2) {
#pragma unroll
        for (int j = 0; j < 4; ++j) { const int col = 4 * lane + 256 * j; const f32x4 sh = *(const f32x4*)(mod + sub_next * 3072 + col), scl = *(const f32x4*)(mod + sub_next * 3072 + 1024 + col), pg = *(const f32x4*)(p.pre_g + sub_next * 1024 + col);
            A[j] = pg * (1.0f + scl); S[j] = sh; }
        asm volatile("" : "+v"(A[0]), "+v"(A[1]), "+v"(A[2]), "+v"(A[3]), "+v"(S[0]), "+v"(S[1]), "+v"(S[2]), "+v"(S[3]) :: "memory");
    }
    const LAS f32x4* wfl = (const LAS f32x4*)lds + lane;
    const float* ss = (const float*)(p.ws + WS_SS);
    const bf16* HD = (const bf16*)(p.ws + WS_HD);
    bf16* H = (bf16*)(p.ws + WS_H);
#pragma unroll 1
    for (int rr = 0; rr < 16; ++rr) {
        const int row = row0 + rr;
        f32x4 v[4];
#pragma unroll
        for (int j = 0; j < 4; ++j) v[j] = *(const f32x4*)(xin + (size_t)row * 1024 + 4 * lane + 256 * j);
        if (MODE & 1) {
            float q = 0.f;
#pragma unroll
            for (int t = 0; t < 16; ++t) q += ss[(size_t)t * M + row];
            const float rstd = 1.0f / sqrtf(q * (1.0f / 1024.0f) + EPS);
#pragma unroll
            for (int j = 0; j < 4; ++j) { const v2u hw = *(const v2u*)(HD + (size_t)row * 1024 + 4 * lane + 256 * j);
                const f32x4 hv = (f32x4){bf_lo(hw.x), bf_hi(hw.x), bf_lo(hw.y), bf_hi(hw.y)};
                v[j] = v[j] + G[j] * hv * rstd;
                *(f32x4*)(p.out + (size_t)row * 1024 + 4 * lane + 256 * j) = v[j]; }
        }
        if (MODE & 2) {
            float s2 = 0.f;
#pragma unroll
            for (int j = 0; j < 4; ++j) s2 += (v[j][0] * v[j][0] + v[j][1] * v[j][1]) + (v[j][2] * v[j][2] + v[j][3] * v[j][3]);
            const float r2 = 1.0f / sqrtf(wave_sum(s2) * (1.0f / 1024.0f) + EPS);
            f32x4 hq[4];
#pragma unroll
            for (int j = 0; j < 4; ++j) { hq[j] = v[j] * r2 * A[j] + S[j];
                v2u w; w.x = pk2(hq[j][0], hq[j][1]); w.y = pk2(hq[j][2], hq[j][3]);
                *(v2u*)(H + (size_t)row * 1024 + 4 * lane + 256 * j) = w; }
            if (MODE & 4) {
                f32x4 d0 = (f32x4){0.f, 0.f, 0.f, 0.f}, d1 = d0;
#pragma unroll
                for (int j = 0; j < 4; ++j)
#pragma unroll
                    for (int e = 0; e < 4; ++e) { d0 += hq[j][e] * wfl[((j * 4 + e) * 2 + 0) * 64]; d1 += hq[j][e] * wfl[((j * 4 + e) * 2 + 1) * 64]; }
                float dd[8] = {d0[0], d0[1], d0[2], d0[3], d1[0], d1[1], d1[2], d1[3]};
                float mine = 0.f;
#pragma unroll
                for (int hh = 0; hh < 8; ++hh) { const float t = wave_sum(dd[hh]); if (lane == hh) mine = t; }
                if (lane < 8) { const float z = mine + p.b_f[lane];
                    const float ls = (z < 0.f ? z : 0.f) - log1pf(expf(-fabsf(z)));
                    ((float*)(p.ws + WS_LOGF))[((size_t)(b * 8 + lane)) * SEQ + (row - b * SEQ)] = ls; }
            }
        }
    }
}
__device__ __forceinline__ void ew_fill_wf(const Params& p, LAS unsigned char* lds, int tid) {
    for (int idx = tid; idx < 2048; idx += NWAVES * 64) { const int l = idx & 63, half = (idx >> 6) & 1, e = (idx >> 7) & 3, j = idx >> 9;
        ((LAS f32x4*)lds)[idx] = *(const f32x4*)(p.w_in + (size_t)(4 * l + 256 * j + e) * NIN + 2560 + 4 * half); }
    __syncthreads();
}
__device__ __forceinline__ void scan_seq(const Params& p, int seq, int lane) {
    const float* src = (const float*)(p.ws + WS_LOGF) + (size_t)seq * SEQ + lane * 64;
    float* dst = (float*)(p.ws + WS_CUM) + (size_t)seq * SEQ + lane * 64;
    f32x4 v[16]; float run = 0.f;
#pragma unroll
    for (int i = 0; i < 16; ++i) { v[i] = *(const f32x4*)(src + 4 * i);
        run += v[i][0]; v[i][0] = run; run += v[i][1]; v[i][1] = run; run += v[i][2]; v[i][2] = run; run += v[i][3]; v[i][3] = run; }
    float incl = run;
#pragma unroll
    for (int o = 1; o < 64; o <<= 1) { const float t = __shfl_up(incl, o); if (lane >= o) incl += t; }
    const float excl = incl - run;
#pragma unroll
    for (int i = 0; i < 16; ++i) *(f32x4*)(dst + 4 * i) = (v[i] + excl) * 1.4426950408889634f;
}
constexpr int SGU_PITCH = 1044;
__device__ __forceinline__ void sgu_unit(const Params& p, LAS unsigned char* lds, int unit, int lane, int wave) {
    const int R0 = unit * 128;
    const bf16* ZG = (const bf16*)(p.ws + WS_ZG);
    bf16* Y = (bf16*)(p.ws + WS_Y);
    float* ssa = (float*)(p.ws + WS_SSA);
    {
        const f32x4 g0 = *(const f32x4*)(p.ln_g + 8 * lane), g1 = *(const f32x4*)(p.ln_g + 8 * lane + 4), b0 = *(const f32x4*)(p.ln_b + 8 * lane), b1 = *(const f32x4*)(p.ln_b + 8 * lane + 4);
        for (int rr = 0; rr < 16; ++rr) { const int r = wave * 16 + rr;
            const v4u w = *(const v4u*)(ZG + (size_t)(R0 + r) * 1024 + 512 + 8 * lane);
            f32x4 a = (f32x4){bf_lo(w.x), bf_hi(w.x), bf_lo(w.y), bf_hi(w.y)}, c = (f32x4){bf_lo(w.z), bf_hi(w.z), bf_lo(w.w), bf_hi(w.w)};
            const float mean = wave_sum((a[0] + a[1]) + (a[2] + a[3]) + (c[0] + c[1]) + (c[2] + c[3])) * (1.0f / 512.0f);
            a = a - mean; c = c - mean;
            const float var = wave_sum((a[0] * a[0] + a[1] * a[1]) + (a[2] * a[2] + a[3] * a[3]) + (c[0] * c[0] + c[1] * c[1]) + (c[2] * c[2] + c[3] * c[3])) * (1.0f / 512.0f);
            const float rstd = 1.0f / sqrtf(var + EPS);
            a = a * rstd * g0 + b0; c = c * rstd * g1 + b1;
            LAS unsigned* d = (LAS unsigned*)(lds + r * SGU_PITCH + 16 * lane);
            d[0] = pk2(a[0], a[1]); d[1] = pk2(a[2], a[3]); d[2] = pk2(c[0], c[1]); d[3] = pk2(c[2], c[3]); }
    }
    __syncthreads();
    const int fr = lane & 15, fq = lane >> 4;
    const int i = wave * 16 + fr;
    const int nks = wave < 4 ? 2 : 4;
    for (int h = 0; h < HA; ++h) {
        f32x4 acc[4];
#pragma unroll
        for (int nt = 0; nt < 4; ++nt) acc[nt] = (f32x4){0.f, 0.f, 0.f, 0.f};
        const float* Wr = p.sgu_w + (size_t)h * 16384 + (size_t)i * 128 + 8 * fq;
        for (int ks = 0; ks < nks; ++ks) {
            const f32x4 w0 = *(const f32x4*)(Wr + 32 * ks), w1 = *(const f32x4*)(Wr + 32 * ks + 4);
            v4u wu; wu.x = pk2(w0[0], w0[1]); wu.y = pk2(w0[2], w0[3]); wu.z = pk2(w1[0], w1[1]); wu.w = pk2(w1[2], w1[3]);
            const bf16x8 wfrag = __builtin_bit_cast(bf16x8, wu);
            const LAS unsigned short* vb = (const LAS unsigned short*)(lds + (32 * ks + 8 * fq) * SGU_PITCH + (64 * h + fr) * 2);
#pragma unroll
            for (int nt = 0; nt < 4; ++nt) { bf16x8 vf;
#pragma unroll
                for (int e = 0; e < 8; ++e) vf[e] = (short)vb[e * (SGU_PITCH / 2) + 16 * nt];
                acc[nt] = __builtin_amdgcn_mfma_f32_16x16x32_bf16(vf, wfrag, acc[nt], 0, 0, 0); }
        }
        const float bs = p.sgu_b[h * 128 + i];
        const size_t rowoff = (size_t)(R0 + i) * 1024; float q = 0.f;
#pragma unroll
        for (int nt = 0; nt < 4; ++nt) { const int c = 64 * h + 16 * nt + 4 * fq;
            const v2u uw = *(const v2u*)(ZG + rowoff + c);
            const f32x4 uv = (f32x4){bf_lo(uw.x), bf_hi(uw.x), bf_lo(uw.y), bf_hi(uw.y)};
            const f32x4 y = uv * (acc[nt] + bs);
            v2u o; o.x = pk2(y[0], y[1]); o.y = pk2(y[2], y[3]);
            const f32x4 yr = (f32x4){bf_lo(o.x), bf_hi(o.x), bf_lo(o.y), bf_hi(o.y)};
            q += (yr[0] * yr[0] + yr[1] * yr[1]) + (yr[2] * yr[2] + yr[3] * yr[3]);
            *(v2u*)(Y + rowoff + c) = o; }
        q += __shfl_xor(q, 16); q += __shfl_xor(q, 32);
        if (fq == 0) ssa[(size_t)h * M + R0 + i] = q;
    }
    __syncthreads();
}
__device__ __forceinline__ void ynorm_phase(const Params& p, int gw, int lane) {
    const int row0 = gw * 16; if (row0 >= M) return;
    const f32x4 ga0 = *(const f32x4*)(p.gn_a + 8 * lane), ga1 = *(const f32x4*)(p.gn_a + 8 * lane + 4), gb0 = *(const f32x4*)(p.gn_b + 8 * lane), gb1 = *(const f32x4*)(p.gn_b + 8 * lane + 4);
    const float* ssa = (const float*)(p.ws + WS_SSA); const float* ssb = (const float*)(p.ws + WS_SSB);
    bf16* Y = (bf16*)(p.ws + WS_Y);
    for (int rr = 0; rr < 16; ++rr) { const int row = row0 + rr;
        float qa = 0.f, qb = 0.f;
#pragma unroll
        for (int h = 0; h < 8; ++h) { qa += ssa[(size_t)h * M + row]; qb += ssb[(size_t)h * M + row]; }
        const float ra = 1.0f / sqrtf(qa * (1.0f / 512.0f) + EPS), rb = 1.0f / sqrtf(qb * (1.0f / 512.0f) + EPS);
        v4u* pa = (v4u*)(Y + (size_t)row * 1024 + 8 * lane); v4u* pb = (v4u*)(Y + (size_t)row * 1024 + 512 + 8 * lane);
        const v4u wa = *pa, wb = *pb; v4u oa, ob;
        oa.x = pk2(bf_lo(wa.x) * ra * ga0[0], bf_hi(wa.x) * ra * ga0[1]); oa.y = pk2(bf_lo(wa.y) * ra * ga0[2], bf_hi(wa.y) * ra * ga0[3]);
        oa.z = pk2(bf_lo(wa.z) * ra * ga1[0], bf_hi(wa.z) * ra * ga1[1]); oa.w = pk2(bf_lo(wa.w) * ra * ga1[2], bf_hi(wa.w) * ra * ga1[3]);
        ob.x = pk2(bf_lo(wb.x) * rb * gb0[0], bf_hi(wb.x) * rb * gb0[1]); ob.y = pk2(bf_lo(wb.y) * rb * gb0[2], bf_hi(wb.y) * rb * gb0[3]);
        ob.z = pk2(bf_lo(wb.z) * rb * gb1[0], bf_hi(wb.z) * rb * gb1[1]); ob.w = pk2(bf_lo(wb.w) * rb * gb1[2], bf_hi(wb.w) * rb * gb1[3]);
        *pa = oa; *pb = ob; }
}

#ifndef PROBE
#define PROBE 0
#endif
#define REPS(cond) for (int rep_ = 0; rep_ < ((cond) ? 2 : 1); ++rep_)
__global__ void __launch_bounds__(NWAVES * 64, 2) mega_fwd(Params p) {
    extern __shared__ __attribute__((aligned(16))) unsigned char lds_raw[];
    cg::grid_group grid = cg::this_grid();
    LAS unsigned char* lds = (LAS unsigned char*)lds_raw;
    if (threadIdx.x < 16) ((LAS unsigned*)(lds + LDS_BARST))[threadIdx.x] = 0u;
    __syncthreads();
    const XcdBarrier bar = xcd_barrier_post((unsigned*)(p.ws + WS_CTL), (volatile LAS unsigned*)(lds + LDS_BARST));
    if (p.ws == nullptr) grid.sync();
#define GRID_SYNC() xcd_barrier(bar)
    const int G = gridDim.x, bx = blockIdx.x, NGW = G * NWAVES;
#define LANEVARS const int tid = otid(), lane = tid & 63, wave = __builtin_amdgcn_readfirstlane(tid >> 6), gw = bx * NWAVES + wave; (void)tid; (void)lane; (void)wave; (void)gw
    bf16* H = (bf16*)(p.ws + WS_H); bf16* HD = (bf16*)(p.ws + WS_HD); bf16* ACT = (bf16*)(p.ws + WS_ACT);
    float* SS = (float*)(p.ws + WS_SS);

    REPS(PROBE == 3) { LANEVARS; for (int it = bx; it < 144; it += G) adaln_item(p, lds, it, tid, lane, wave);
      convert_weights(p, lds, gw, NGW, lane, wave); }
    if (PROBE == 1) for (int i = 0; i < 12; ++i) GRID_SYNC();
    GRID_SYNC();
    REPS(PROBE == 3) { LANEVARS; for (int g = gw; g * 16 < M; g += NGW) ew_phase<2>(p, lds, g, lane, p.x, 0, 0.f, 0); }
    GRID_SYNC();
    REPS(PROBE == 4) { pg8::Gemm g{H, (const bf16*)(p.ws + WS_WGU0), M, 2 * DFF, 1024}; pg8::StaticOrder S; S.init(M, 2 * DFF, G, bx);
      pg8::EpiSwiGLU E{ACT, DFF}; pg8::gemm_phase<pg8::EpiSwiGLU, pg8::StaticOrder, true, true>(lds, g, S, E); }
    GRID_SYNC();
    REPS(PROBE == 4) { pg8::Gemm g{ACT, (const bf16*)(p.ws + WS_WD0), M, 1024, DFF}; pg8::StaticOrder S; S.init(M, 1024, G, bx);
      pg8::EpiBf16Ss E{HD, 1024, SS, M}; pg8::gemm_phase<pg8::EpiBf16Ss, pg8::StaticOrder, true, true>(lds, g, S, E); }
    GRID_SYNC();
    REPS(PROBE == 3) { LANEVARS; ew_fill_wf(p, lds, tid); for (int g = gw; g * 16 < M; g += NGW) ew_phase<7>(p, lds, g, lane, p.x, 0, 0.5f, 1); }
    GRID_SYNC();
    { LANEVARS; if (wave == 0) for (int s = bx; s < BATCH * HB; s += G) scan_seq(p, s, lane); }
    REPS(PROBE == 4) { pg8::Gemm g{H, (const bf16*)(p.ws + WS_WIN), M, 2560, 1024}; pg8::StaticOrder S; S.init(M, 2560, G, bx);
      static_assert(WS_K - WS_Q == WS_V - WS_K, "qkv stride");
      pg8::EpiMixIn E{(bf16*)(p.ws + WS_ZG), (bf16*)(p.ws + WS_Q), (WS_K - WS_Q) / 2, attn_body::C2};
      pg8::gemm_phase<pg8::EpiMixIn, pg8::StaticOrder, true, true>(lds, g, S, E); }
    GRID_SYNC();
    REPS(PROBE == 2) {
    { LANEVARS; for (int u = bx; u < M / 128; u += G) sgu_unit(p, lds, u, lane, wave); }
    { const attn_body::AttnTensors AT{(const attn_body::bf16*)(p.ws + WS_Q), (const attn_body::bf16*)(p.ws + WS_K), (const attn_body::bf16*)(p.ws + WS_V),
                                      (attn_body::bf16*)(p.ws + WS_Y) + 512, (const float*)(p.ws + WS_CUM), (float*)(p.ws + WS_SSB)};
      const attn_body::StaticOrder S(G, bx);
      attn_body::attn_phase<attn_body::StaticOrder>((char*)lds_raw, AT, S); }
    }
    GRID_SYNC();
    { LANEVARS; for (int g = gw; g * 16 < M; g += NGW) ynorm_phase(p, g, lane); }
    GRID_SYNC();
    REPS(PROBE == 4) { pg8::Gemm g{(const bf16*)(p.ws + WS_Y), (const bf16*)(p.ws + WS_WOUT), M, 1024, 1024}; pg8::StaticOrder S; S.init(M, 1024, G, bx);
      pg8::EpiBf16Ss E{HD, 1024, SS, M}; pg8::gemm_phase<pg8::EpiBf16Ss, pg8::StaticOrder, true, true>(lds, g, S, E); }
    GRID_SYNC();
    { LANEVARS; for (int g = gw; g * 16 < M; g += NGW) ew_phase<3>(p, lds, g, lane, p.out, 1, 1.0f, 2); }
    GRID_SYNC();
    REPS(PROBE == 4) { pg8::Gemm g{H, (const bf16*)(p.ws + WS_WGU1), M, 2 * DFF, 1024}; pg8::StaticOrder S; S.init(M, 2 * DFF, G, bx);
      pg8::EpiSwiGLU E{ACT, DFF}; pg8::gemm_phase<pg8::EpiSwiGLU, pg8::StaticOrder, true, true>(lds, g, S, E); }
    GRID_SYNC();
    REPS(PROBE == 4) { pg8::Gemm g{ACT, (const bf16*)(p.ws + WS_WD1), M, 1024, DFF}; pg8::StaticOrder S; S.init(M, 1024, G, bx);
      pg8::EpiBf16Ss E{HD, 1024, SS, M}; pg8::gemm_phase<pg8::EpiBf16Ss, pg8::StaticOrder, true, true>(lds, g, S, E); }
    GRID_SYNC();
    { LANEVARS; for (int g = gw; g * 16 < M; g += NGW) ew_phase<1>(p, lds, g, lane, p.out, 2, 0.5f, 0); }
}

extern "C" void kernel_launch(void* const* d_in, const int* in_sizes, int n_in, void* d_out, int out_size, void* d_ws, size_t ws_size, hipStream_t stream) {
    static int grid = 0;
    if (grid == 0) {
        if (n_in != 18 || out_size != M * 1024 || ws_size < WS_END) { fprintf(stderr, "kernel_launch: unexpected problem shape (n_in %d out %d ws %zu)\n", n_in, out_size, ws_size); grid = -1; return; }
        int dev = 0, cus = 0, per_cu = 0;
        (void)hipGetDevice(&dev); (void)hipDeviceGetAttribute(&cus, hipDeviceAttributeMultiprocessorCount, dev);
        if (hipFuncSetAttribute((const void*)mega_fwd, hipFuncAttributeMaxDynamicSharedMemorySize, LDS_BYTES) != hipSuccess) { fprintf(stderr, "kernel_launch: hipFuncSetAttribute failed\n"); grid = -1; return; }
        if (hipOccupancyMaxActiveBlocksPerMultiprocessor(&per_cu, (const void*)mega_fwd, NWAVES * 64, LDS_BYTES) != hipSuccess || per_cu < 1) { fprintf(stderr, "kernel_launch: occupancy query says %d\n", per_cu); per_cu = 1; }
        (void)hipGetLastError();
        grid = cus * 1;
        if (grid <= 0) grid = 256;
    }
    if (grid < 0) return;
    if (hipMemsetAsync((char*)d_ws + WS_CTL, 0, CTL_BYTES, stream) != hipSuccess) { fprintf(stderr, "kernel_launch: memset failed\n"); return; }
    Params p{};
    p.x = (const float*)d_in[0]; p.c = (const float*)d_in[1]; p.w_ada = (const float*)d_in[2]; p.b_ada = (const float*)d_in[3]; p.pre_g = (const float*)d_in[4]; p.post_g = (const float*)d_in[5];
    p.w_gate = (const float*)d_in[6]; p.w_up = (const float*)d_in[7]; p.w_down = (const float*)d_in[8]; p.w_in = (const float*)d_in[9]; p.ln_g = (const float*)d_in[10]; p.ln_b = (const float*)d_in[11];
    p.sgu_w = (const float*)d_in[12]; p.sgu_b = (const float*)d_in[13]; p.b_f = (const float*)d_in[14]; p.gn_a = (const float*)d_in[15]; p.gn_b = (const float*)d_in[16]; p.w_out = (const float*)d_in[17];
    p.out = (float*)d_out; p.ws = (unsigned char*)d_ws;
    void* args[] = {&p};
    hipError_t e = hipLaunchCooperativeKernel((const void*)mega_fwd, dim3(grid), dim3(NWAVES * 64), args, LDS_BYTES, stream);
    if (e != hipSuccess) fprintf(stderr, "kernel_launch: cooperative launch failed: %s (grid %d)\n", hipGetErrorString(e), grid);
}
```

```cpp
#include <hip/hip_runtime.h>
#include <hip/hip_cooperative_groups.h>
#include <hip/hip_bf16.h>
#include <cstdio>
#include <cstdint>
#include <cmath>
namespace cg = cooperative_groups;
__device__ __forceinline__ int otid() { int t = threadIdx.x; asm volatile("" : "+v"(t)); return t; }
namespace pg8 {
#define PG8_LAS __attribute__((address_space(3)))
typedef unsigned short bf16_t;
typedef short bf16x8 __attribute__((ext_vector_type(8)));
typedef float f32x4 __attribute__((ext_vector_type(4)));
typedef unsigned u32x4 __attribute__((ext_vector_type(4)));
constexpr int BM = 256, BK = 64, HALF = 128, HTB = HALF * BK * 2  , STAGE_BYTES = 8 * HTB, NXCD = 8, WGM = 8;

__host__ __device__ __forceinline__ int lds_byte(int r, int c) { const int st = (r >> 4) * 2 + (c >> 5), rr = r & 15, cc = c & 31, ob = rr * 64 + cc * 2; return st * 1024 + (ob ^ (((ob >> 9) & 1) << 5)); }
__host__ __device__ __forceinline__ void stage_rc(int b, int& R, int& C) { const int st = b / 1024, sb = b % 1024, swz = sb ^ (((sb >> 9) & 1) << 5); R = (st >> 1) * 16 + swz / 64; C = (st & 1) * 32 + (swz % 64) / 2; }
__host__ __device__ __forceinline__ int perm32(int rho) { const int n = rho >> 4, i = rho & 15; return 8 * (i >> 2) + 4 * n + (i & 3); }

struct Unit { int pm, pn; };
struct Gemm { const bf16_t* A; const bf16_t* Bt; int M, N, K; };

struct StaticOrder {
    int nM, nN, nwg, G, c;
    __host__ __device__ void init(int M, int N, int G_, int c_) { nM = M / BM; nN = N / BM; nwg = nM * nN; G = G_; c = c_; }
    __host__ __device__ bool next(int i, Unit& u) const {
        const long L = (long)i * G + c; if (L >= nwg) return false;
        int wgid = (int)L; { const int q = nwg / NXCD, r = nwg % NXCD, xcd = wgid % NXCD, off = wgid / NXCD; wgid = (xcd < r ? xcd * (q + 1) : r * (q + 1) + (xcd - r) * q) + off; }
        const int nig = WGM * nN, gid = wgid / nig, fm = gid * WGM, gsz = (nM - fm) < WGM ? (nM - fm) : WGM;
        u.pm = fm + ((wgid % nig) % gsz); u.pn = (wgid % nig) / gsz; return true;
    }
    __device__ __forceinline__ void a_ready(const Unit&) const {}
    __device__ __forceinline__ void done(const Unit&) const {}
};

__device__ __forceinline__ unsigned cvt_pk_bf16(float lo, float hi) { unsigned r; asm volatile("v_cvt_pk_bf16_f32 %0, %1, %2" : "=v"(r) : "v"(lo), "v"(hi)); return r; }
typedef float f32x2 __attribute__((ext_vector_type(2)));
__device__ __forceinline__ float fast_sigmoid(float t) { return __builtin_amdgcn_rcpf(1.0f + __builtin_amdgcn_exp2f(-1.4426950408889634f * t)); }
struct EpiSwiGLU {
    static constexpr bool PERM = true, AFTER_DRAIN = false;
    bf16_t* O; int ldc;
    __device__ __forceinline__ void operator()(const f32x4 (&acc)[2][2][4][2], const Unit& u, int wr, int wc, int fr, int fq) const {
        const int row0 = u.pm * BM + wr * 64 + fr; const int col0 = u.pn * HALF + wc * 32 + 8 * fq;
#pragma unroll
        for (int ai = 0; ai < 2; ++ai)
#pragma unroll
            for (int m = 0; m < 4; ++m) { bf16_t* rowp = O + (size_t)(row0 + ai * HALF + m * 16) * ldc + col0;
                float o[8];
#pragma unroll
                for (int n = 0; n < 2; ++n)
#pragma unroll
                    for (int e = 0; e < 4; ++e) { const float g = acc[ai][0][m][n][e], up = acc[ai][1][m][n][e]; o[n * 4 + e] = g * fast_sigmoid(g) * up; }
                u32x4 w; w.x = cvt_pk_bf16(o[0], o[1]); w.y = cvt_pk_bf16(o[2], o[3]); w.z = cvt_pk_bf16(o[4], o[5]); w.w = cvt_pk_bf16(o[6], o[7]);
                *(u32x4*)rowp = w; }
    }
};
struct EpiBf16Ss {
    static constexpr bool PERM = true, AFTER_DRAIN = false;
    bf16_t* O; int ldc; float* ss; int M;
    __device__ __forceinline__ void operator()(const f32x4 (&acc)[2][2][4][2], const Unit& u, int wr, int wc, int fr, int fq) const {
        const int row0 = u.pm * BM + wr * 64 + fr; const int col0 = u.pn * BM + wc * 32 + 8 * fq;
        float* ssp = ss + (size_t)(u.pn * 4 + wc) * M;
#pragma unroll
        for (int ai = 0; ai < 2; ++ai)
#pragma unroll
            for (int m = 0; m < 4; ++m) { const int row = row0 + ai * HALF + m * 16; bf16_t* rowp = O + (size_t)row * ldc + col0; float q = 0.f;
#pragma unroll
                for (int bj = 0; bj < 2; ++bj) { const f32x4 v0 = acc[ai][bj][m][0], v1 = acc[ai][bj][m][1];
                    q += (v0[0] * v0[0] + v0[1] * v0[1]) + (v0[2] * v0[2] + v0[3] * v0[3]) + (v1[0] * v1[0] + v1[1] * v1[1]) + (v1[2] * v1[2] + v1[3] * v1[3]);
                    u32x4 w; w.x = cvt_pk_bf16(v0[0], v0[1]); w.y = cvt_pk_bf16(v0[2], v0[3]); w.z = cvt_pk_bf16(v1[0], v1[1]); w.w = cvt_pk_bf16(v1[2], v1[3]);
                    *(u32x4*)(rowp + bj * HALF) = w; }
                q += __shfl_xor(q, 16); q += __shfl_xor(q, 32);
                if (fq == 0) ssp[row] = q; }
    }
};
struct EpiMixIn {
    static constexpr bool PERM = true, AFTER_DRAIN = false;
    bf16_t* ZG; bf16_t* Q; size_t qkv_stride; float qscale;
    __device__ __forceinline__ void operator()(const f32x4 (&acc)[2][2][4][2], const Unit& u, int wr, int wc, int fr, int fq) const {
        const int row0 = u.pm * BM + wr * 64 + fr;
        bf16_t* base; int ldc, colt; float sc = 1.f; const bool gelu = u.pn < 4;
        if (u.pn < 4) { base = ZG; ldc = 1024; colt = u.pn * BM; }
        else { const int t = (u.pn - 4) >> 1; base = Q + (size_t)t * qkv_stride; ldc = 512; colt = ((u.pn - 4) & 1) * BM; if (t == 0) sc = qscale; }
        const int col0 = colt + wc * 32 + 8 * fq;
#pragma unroll
        for (int ai = 0; ai < 2; ++ai)
#pragma unroll
            for (int m = 0; m < 4; ++m) { bf16_t* rowp = base + (size_t)(row0 + ai * HALF + m * 16) * ldc + col0;
#pragma unroll
                for (int bj = 0; bj < 2; ++bj) { float o[8];
#pragma unroll
                    for (int n = 0; n < 2; ++n)
#pragma unroll
                        for (int e = 0; e < 4; ++e) { float x = acc[ai][bj][m][n][e];
                            if (gelu) { const float t = 1.5957691216057308f * (x + 0.044715f * x * x * x); x = x * fast_sigmoid(t); } else x *= sc;
                            o[n * 4 + e] = x; }
                    u32x4 w; w.x = cvt_pk_bf16(o[0], o[1]); w.y = cvt_pk_bf16(o[2], o[3]); w.z = cvt_pk_bf16(o[4], o[5]); w.w = cvt_pk_bf16(o[6], o[7]);
                    *(u32x4*)(rowp + bj * HALF) = w; } }
    }
};

template <class Epi, class Sched, bool ALIGN_EPI = false, bool SP2 = false>
__device__ __forceinline__ void gemm_phase(PG8_LAS unsigned char* lds, const Gemm g, const Sched& S, const Epi& E) {
    const int tid = otid(), wid = __builtin_amdgcn_readfirstlane(tid >> 6), lane = tid & 63, wr = wid >> 2, wc = wid & 3, fr = lane & 15, fq = lane >> 4;
    const int K = g.K, nt = K / BK;
    unsigned voffA[2], voffB[2];
#pragma unroll
    for (int i = 0; i < 2; ++i) { int R, C; stage_rc(tid * 16 + i * 8192, R, C); const int Rb = Epi::PERM ? ((R & ~31) + perm32(R & 31)) : R;
        voffA[i] = (unsigned)(R * K + C) * 2u; voffB[i] = (unsigned)(Rb * K + C) * 2u; }
    const size_t kstep = (size_t)(BK * 2);
    const size_t hstep = (size_t)HALF * K * 2;
    const size_t tstep = 2 * hstep;
    const unsigned ldsw = (unsigned)wid * 1024u;
    const int aoff = lds_byte(wr * 64 + fr, fq * 8), boff = lds_byte(wc * 32 + fr, fq * 8);
#define PG8_SA(b, h) (((b) * 2 + (h)) * HTB)
#define PG8_SB(b, h) ((4 + (b) * 2 + (h)) * HTB)
#define PG8_STAGE(bufoff, gbase, voff) do { _Pragma("unroll") for (int _i = 0; _i < 2; ++_i) \
        __builtin_amdgcn_global_load_lds((const unsigned*)((const char*)(gbase) + (voff)[_i]), (PG8_LAS unsigned*)(lds + (bufoff) + ldsw + _i * 8192), 16, 0, 0); } while (0)
#define PG8_LDA(dst, b, h) do { _Pragma("unroll") for (int m = 0; m < 4; ++m) _Pragma("unroll") for (int k = 0; k < 2; ++k) dst[m][k] = *(const PG8_LAS bf16x8*)(lds + PG8_SA(b, h) + aoff + m * 2048 + k * 1024); } while (0)
#define PG8_LDB(dst, b, h) do { _Pragma("unroll") for (int n = 0; n < 2; ++n) _Pragma("unroll") for (int k = 0; k < 2; ++k) dst[n][k] = *(const PG8_LAS bf16x8*)(lds + PG8_SB(b, h) + boff + n * 2048 + k * 1024); } while (0)
#define PG8_MMA(ai, bj, At, Bt) do { __builtin_amdgcn_s_setprio(1); _Pragma("unroll") for (int m = 0; m < 4; ++m) _Pragma("unroll") for (int n = 0; n < 2; ++n) _Pragma("unroll") for (int k = 0; k < 2; ++k) \
        acc[ai][bj][m][n] = __builtin_amdgcn_mfma_f32_16x16x32_bf16(Bt[n][k], At[m][k], acc[ai][bj][m][n], 0, 0, 0); __builtin_amdgcn_s_setprio(0); } while (0)
#define PG8_WAIT_V(n) asm volatile("s_waitcnt vmcnt(" #n ")" ::: "memory")
#define PG8_WAIT_L(n) asm volatile("s_waitcnt lgkmcnt(" #n ")" ::: "memory")
#define PG8_BAR __builtin_amdgcn_s_barrier()
#define PG8_SCHED __builtin_amdgcn_sched_barrier(0)
    Unit cur, nxt; int ui = 0;
    if (!S.next(0, cur)) return;
    f32x4 acc[2][2][4][2];
#pragma unroll
    for (int a = 0; a < 2; ++a)
#pragma unroll
        for (int b = 0; b < 2; ++b)
#pragma unroll
            for (int m = 0; m < 4; ++m)
#pragma unroll
                for (int n = 0; n < 2; ++n) acc[a][b][m][n] = (f32x4){0.f, 0.f, 0.f, 0.f};
    bf16x8 At[4][2], B0[2][2], B1[2][2];
    const char* cA = (const char*)g.A + (size_t)cur.pm * tstep; const char* cB = (const char*)g.Bt + (size_t)cur.pn * tstep;
    S.a_ready(cur);
    if constexpr (SP2) {
        PG8_STAGE(PG8_SB(0, 0), cB, voffB); PG8_STAGE(PG8_SB(0, 1), cB + hstep, voffB); PG8_STAGE(PG8_SA(0, 0), cA, voffA); PG8_STAGE(PG8_SA(0, 1), cA + hstep, voffA);
        if (wr == 1) PG8_BAR;
        PG8_WAIT_V(2); PG8_BAR;
        PG8_STAGE(PG8_SB(1, 0), cB + kstep, voffB); PG8_STAGE(PG8_SA(1, 0), cA + kstep, voffA); PG8_STAGE(PG8_SB(1, 1), cB + hstep + kstep, voffB);
        PG8_WAIT_V(6); PG8_BAR;
    } else {
        PG8_STAGE(PG8_SB(0, 0), cB, voffB); PG8_STAGE(PG8_SA(0, 0), cA, voffA); PG8_STAGE(PG8_SB(0, 1), cB + hstep, voffB); PG8_STAGE(PG8_SA(0, 1), cA + hstep, voffA);
        if (wr == 1) PG8_BAR;
        PG8_WAIT_V(4); PG8_BAR;
        PG8_STAGE(PG8_SB(1, 0), cB + kstep, voffB); PG8_STAGE(PG8_SA(1, 0), cA + kstep, voffA); PG8_STAGE(PG8_SB(1, 1), cB + hstep + kstep, voffB);
        PG8_WAIT_V(6); PG8_BAR;
    }
    for (;;) {
        const bool has_next = S.next(ui + 1, nxt);
        const char* nA = has_next ? (const char*)g.A + (size_t)nxt.pm * tstep : cA; const char* nB = has_next ? (const char*)g.Bt + (size_t)nxt.pn * tstep : cB;
        for (int t = 0; t < nt; t += 2) {
            const bool last = (t == nt - 2);
            const char* a1 = cA + (size_t)(t + 1) * kstep;
            const char* a2 = last ? nA : cA + (size_t)(t + 2) * kstep; const char* b2 = last ? nB : cB + (size_t)(t + 2) * kstep;
            const char* a3 = a2 + kstep; const char* b3 = b2 + kstep;
            if (last && has_next) S.a_ready(nxt);
            if constexpr (SP2) {
            PG8_LDB(B0, 0, 0); PG8_LDB(B1, 0, 1); PG8_SCHED; PG8_LDA(At, 0, 0); PG8_STAGE(PG8_SA(1, 1), a1 + hstep, voffA);
            PG8_WAIT_V(8); PG8_WAIT_L(0); PG8_BAR; PG8_MMA(0, 0, At, B0); PG8_MMA(0, 1, At, B1); PG8_BAR; PG8_SCHED;
            PG8_LDA(At, 0, 1); PG8_STAGE(PG8_SB(0, 0), b2, voffB); PG8_STAGE(PG8_SB(0, 1), b2 + hstep, voffB); PG8_STAGE(PG8_SA(0, 0), a2, voffA);
            PG8_WAIT_V(8); PG8_WAIT_L(0); PG8_BAR; PG8_MMA(1, 0, At, B0); PG8_MMA(1, 1, At, B1); PG8_BAR; PG8_SCHED;
            PG8_LDB(B0, 1, 0); PG8_LDB(B1, 1, 1); PG8_SCHED; PG8_LDA(At, 1, 0); PG8_STAGE(PG8_SA(0, 1), a2 + hstep, voffA);
            PG8_WAIT_V(8); PG8_WAIT_L(0); PG8_BAR; PG8_MMA(0, 0, At, B0); PG8_MMA(0, 1, At, B1); PG8_BAR; PG8_SCHED;
            PG8_LDA(At, 1, 1); PG8_STAGE(PG8_SB(1, 0), b3, voffB); PG8_STAGE(PG8_SB(1, 1), b3 + hstep, voffB); PG8_STAGE(PG8_SA(1, 0), a3, voffA);
            PG8_WAIT_V(8); PG8_WAIT_L(0); PG8_BAR; PG8_MMA(1, 0, At, B0); PG8_MMA(1, 1, At, B1); PG8_BAR; PG8_SCHED;
            } else {
            PG8_LDB(B0, 0, 0); PG8_SCHED; PG8_LDA(At, 0, 0); PG8_STAGE(PG8_SA(1, 1), a1 + hstep, voffA);
            PG8_WAIT_L(8); PG8_BAR; PG8_WAIT_L(0); PG8_MMA(0, 0, At, B0); PG8_BAR; PG8_SCHED;
            PG8_LDB(B1, 0, 1); PG8_STAGE(PG8_SB(0, 0), b2, voffB);
            PG8_BAR; PG8_WAIT_L(0); PG8_MMA(0, 1, At, B1); PG8_BAR;
            PG8_LDA(At, 0, 1); PG8_STAGE(PG8_SA(0, 0), a2, voffA);
            PG8_BAR; PG8_WAIT_L(0); PG8_MMA(1, 0, At, B0); PG8_BAR; PG8_SCHED;
            PG8_STAGE(PG8_SB(0, 1), b2 + hstep, voffB);
            PG8_WAIT_V(6); PG8_BAR; PG8_MMA(1, 1, At, B1); PG8_BAR;
            PG8_LDB(B0, 1, 0); PG8_SCHED; PG8_LDA(At, 1, 0); PG8_STAGE(PG8_SA(0, 1), a2 + hstep, voffA);
            PG8_WAIT_L(8); PG8_BAR; PG8_WAIT_L(0); PG8_MMA(0, 0, At, B0); PG8_BAR; PG8_SCHED;
            PG8_LDB(B1, 1, 1); PG8_STAGE(PG8_SB(1, 0), b3, voffB);
            PG8_BAR; PG8_WAIT_L(0); PG8_MMA(0, 1, At, B1); PG8_BAR;
            PG8_LDA(At, 1, 1); PG8_STAGE(PG8_SA(1, 0), a3, voffA);
            PG8_BAR; PG8_WAIT_L(0); PG8_MMA(1, 0, At, B0); PG8_BAR; PG8_SCHED;
            PG8_STAGE(PG8_SB(1, 1), b3 + hstep, voffB);
            PG8_WAIT_V(6); PG8_BAR; PG8_MMA(1, 1, At, B1); PG8_BAR;
            }
        }
        if constexpr (ALIGN_EPI) { if (wr == 0) PG8_BAR; }
        if constexpr (!Epi::AFTER_DRAIN) { E(acc, cur, wr, wc, fr, fq); S.done(cur); }
        if (!has_next) break;
#pragma unroll
        for (int a = 0; a < 2; ++a)
#pragma unroll
            for (int b = 0; b < 2; ++b)
#pragma unroll
                for (int m = 0; m < 4; ++m)
#pragma unroll
                    for (int n = 0; n < 2; ++n) acc[a][b][m][n] = (f32x4){0.f, 0.f, 0.f, 0.f};
        cur = nxt; cA = nA; cB = nB; ++ui;
        if constexpr (ALIGN_EPI) { if (wr == 1) PG8_BAR; }
    }
    PG8_WAIT_V(0);
    if constexpr (!ALIGN_EPI) { if (wr == 0) PG8_BAR; }
    PG8_BAR;
    if constexpr (Epi::AFTER_DRAIN) { E.fused(acc, cur, wr, wc, fr, fq, lds, wid, lane); S.done(cur); }
#undef PG8_SA
#undef PG8_SB
#undef PG8_STAGE
#undef PG8_LDA
#undef PG8_LDB
#undef PG8_MMA
#undef PG8_WAIT_V
#undef PG8_WAIT_L
#undef PG8_BAR
#undef PG8_SCHED
}
}

#ifndef PG8_SP2
#define PG8_SP2 true
#endif
#ifndef PG8_ALIGN
#define PG8_ALIGN true
#endif
#include <hip/hip_bf16.h>
#include <cmath>
namespace attn_body {
using bf16=__hip_bfloat16;
using bf16x8=__attribute__((ext_vector_type(8)))short;
using s16x4=__attribute__((ext_vector_type(4)))short;
using f32x16=__attribute__((ext_vector_type(16)))float;
using u32x4=__attribute__((ext_vector_type(4)))unsigned;
using u32x2=__attribute__((ext_vector_type(2)))unsigned;
using f32x4v=__attribute__((ext_vector_type(4)))float;
constexpr int BATCH=8,NHEAD=8,SEQ=4096,D=64,DM=NHEAD*D,OPITCH=1024;
constexpr int NW=8,QBLK=32,QB=QBLK*NW,KVBLK=64,NQB=SEQ/QB;
constexpr int ATTN_PITCH=DM, ATTN_UNIT_ROWS=QB;
__device__ __forceinline__ int crow(int r,int hi){return (r&3)+8*(r>>2)+4*hi;}
#define SBAR() __builtin_amdgcn_sched_barrier(0)
__device__ __forceinline__ void cmask(f32x16&p0,f32x16&p1,int jb,int qrel,int hi){
  const float NEG=-INFINITY; int kb=64*jb+4*hi;
  #pragma unroll
  for(int r=0;r<16;++r){int kv=kb+(r&3)+8*(r>>2); if(kv>qrel)p0[r]=NEG; if(kv+32>qrel)p1[r]=NEG;}
}

constexpr int NSLOT=3, SLOTB=8192;
constexpr int LDS_K=0, LDS_V=NSLOT*SLOTB, LDS_WS=2*NSLOT*SLOTB, LDS_OST=LDS_WS+NW*64*4, LDS_BIAS=LDS_OST+NW*4096, LDS_CUM=LDS_BIAS+SEQ*8, LDS_RED=LDS_CUM+SEQ*4, LDS_BYTES=LDS_RED+512;
constexpr float C2=0.125f*1.4426950408889634f;
__device__ __forceinline__ void glds16(const void*gsrc,unsigned lds_dst){unsigned keep;
  asm volatile("s_mov_b32 %0, m0\n\ts_mov_b32 m0, %2\n\ts_nop 0\n\tglobal_load_lds_dwordx4 %1, off\n\ts_mov_b32 m0, %0":"=&s"(keep):"v"(gsrc),"s"(lds_dst):"memory");}
__device__ __forceinline__ float max3f(float a,float b,float c){float r;asm("v_max3_f32 %0, %1, %2, %3":"=v"(r):"v"(a),"v"(b),"v"(c));return r;}
__device__ __forceinline__ float max2f(float a,float b){float r;asm("v_max_f32_e32 %0, %1, %2":"=v"(r):"v"(a),"v"(b));return r;}
__device__ __forceinline__ float fadd_s(float a,float b){float r;asm("v_add_f32_e32 %0, %1, %2":"=v"(r):"v"(a),"v"(b));return r;}
__device__ __forceinline__ float fsub_s(float a,float b){float r;asm("v_sub_f32_e32 %0, %1, %2":"=v"(r):"v"(a),"v"(b));return r;}
typedef float f32x2_t __attribute__((ext_vector_type(2))); typedef __bf16 bf16x2_t __attribute__((ext_vector_type(2)));
__device__ __forceinline__ unsigned cvtpk_s(float lo,float hi){f32x2_t v={lo,hi};bf16x2_t b=__builtin_convertvector(v,bf16x2_t);return __builtin_bit_cast(unsigned,b);}
#define WAIT_BAR(N) asm volatile("s_waitcnt vmcnt(" #N ") lgkmcnt(0)\n\ts_barrier":::"memory")

__device__ __forceinline__ void qkt(f32x16&p0,f32x16&p1,const char*Kslot,const bf16x8*qr,const f32x16&negm,int r32,int hi,bf16x8 kx0,bf16x8 kx1,bf16x8 qx){
  const char*kb=Kslot+hi*1024+r32*16;
  p0=__builtin_amdgcn_mfma_f32_32x32x16_bf16(kx0,qx,negm,0,0,0);p1=__builtin_amdgcn_mfma_f32_32x32x16_bf16(kx1,qx,negm,0,0,0);
  #pragma unroll
  for(int d0=0;d0<4;++d0){
    const bf16x8 b0=*reinterpret_cast<const bf16x8*>(kb+d0*2048);
    const bf16x8 b1=*reinterpret_cast<const bf16x8*>(kb+d0*2048+512);
    p0=__builtin_amdgcn_mfma_f32_32x32x16_bf16(b0,qr[d0],p0,0,0,0);p1=__builtin_amdgcn_mfma_f32_32x32x16_bf16(b1,qr[d0],p1,0,0,0);}
}
typedef __attribute__((address_space(3))) const char* lds_cptr;
typedef short v4i16_t __attribute__((ext_vector_type(4)));
__device__ __forceinline__ void kload8(bf16x8*kf,lds_cptr kp){
  kf[0]=*(const __attribute__((address_space(3))) bf16x8*)(kp);      kf[1]=*(const __attribute__((address_space(3))) bf16x8*)(kp+512);
  kf[2]=*(const __attribute__((address_space(3))) bf16x8*)(kp+2048); kf[3]=*(const __attribute__((address_space(3))) bf16x8*)(kp+2560);
  kf[4]=*(const __attribute__((address_space(3))) bf16x8*)(kp+4096); kf[5]=*(const __attribute__((address_space(3))) bf16x8*)(kp+4608);
  kf[6]=*(const __attribute__((address_space(3))) bf16x8*)(kp+6144); kf[7]=*(const __attribute__((address_space(3))) bf16x8*)(kp+6656);
}
__device__ __forceinline__ void kload2(bf16x8*kf,lds_cptr kp,int j){ kf[2*j]=*(const __attribute__((address_space(3))) bf16x8*)(kp+j*2048); kf[2*j+1]=*(const __attribute__((address_space(3))) bf16x8*)(kp+j*2048+512); }
__device__ __forceinline__ s16x4 vtr(lds_cptr p){ return __builtin_bit_cast(s16x4,__builtin_amdgcn_ds_read_tr16_b64_v4i16((__attribute__((address_space(3))) v4i16_t*)p)); }
__device__ __forceinline__ float rowmax(const f32x16&p0,const f32x16&p1){
  float a=max3f(p0[0],p0[1],p1[0]),b=max3f(p0[2],p0[3],p1[1]);a=max3f(a,p1[2],p1[3]);
  #pragma unroll
  for(int r=4;r<16;r+=4){a=max3f(a,p0[r],p0[r+1]);b=max3f(b,p0[r+2],p0[r+3]);a=max3f(a,p1[r],p1[r+1]);b=max3f(b,p1[r+2],p1[r+3]);}
  const float m=max2f(a,b);
  auto rr=__builtin_amdgcn_permlane32_swap(__float_as_uint(m),__float_as_uint(m),false,false);
  return max2f(__uint_as_float(rr[0]),__uint_as_float(rr[1]));
}
__device__ __forceinline__ void pv(f32x16*o,int vb,bf16x8 pa0,bf16x8 pa1,bf16x8 pa2,bf16x8 pa3){
  #pragma unroll
  for(int d0=0;d0<2;++d0){s16x4 lo[4],hi[4];
    #pragma unroll
    for(int ks=0;ks<4;++ks){
      asm volatile("ds_read_b64_tr_b16 %0,%1 offset:%c2":"=&v"(lo[ks]):"v"(vb),"i"(d0*4096+ks*1024):"memory");
      asm volatile("ds_read_b64_tr_b16 %0,%1 offset:%c2":"=&v"(hi[ks]):"v"(vb),"i"(d0*4096+ks*1024+512):"memory");}
    asm volatile("s_waitcnt lgkmcnt(0)":::"memory");SBAR();
    #define PK(k) (bf16x8){lo[k][0],lo[k][1],lo[k][2],lo[k][3],hi[k][0],hi[k][1],hi[k][2],hi[k][3]}
    o[d0]=__builtin_amdgcn_mfma_f32_32x32x16_bf16(pa0,PK(0),o[d0],0,0,0);
    o[d0]=__builtin_amdgcn_mfma_f32_32x32x16_bf16(pa1,PK(1),o[d0],0,0,0);
    o[d0]=__builtin_amdgcn_mfma_f32_32x32x16_bf16(pa2,PK(2),o[d0],0,0,0);
    o[d0]=__builtin_amdgcn_mfma_f32_32x32x16_bf16(pa3,PK(3),o[d0],0,0,0);
    #undef PK
  }
}

#ifndef ATTN_STORE16
#define ATTN_STORE16(p,v) (*(u32x4*)(p)=(v))
#endif
template<int THRL> __device__ __forceinline__ void attn_unit(int b,int h,int qb,const bf16*Q,const bf16*__restrict__ K,const bf16*__restrict__ V,bf16*O,float bound,int ui,float*ssb,char*shm){
  const int tid=otid(),lane=tid&63,r32=lane&31,hi=lane>>5; const int wid=__builtin_amdgcn_readfirstlane(tid>>6);
  const long rowbase=(long)b*SEQ; const int q0=qb*QB;
  const bf16*Qw=Q+(rowbase+q0+wid*QBLK)*DM+h*D;
  const bf16*Kh=K+rowbase*DM+h*D,*Vh=V+rowbase*DM+h*D;
  const lds_cptr shm3=(lds_cptr)shm;
  const unsigned lds0=(unsigned)(uintptr_t)shm;
  float*wsf=(float*)(shm+LDS_WS)+wid*64;
  const bf16*ksrc0=Kh+(long)lane*DM+wid*8;
  const bf16*vsrc0=Vh+(long)(16*(wid&3)+(lane>>2))*DM+(wid>>2)*32+(lane&3)*8;
  const unsigned kdst=lds0+LDS_K+wid*1024, vdst=lds0+LDS_V+wid*1024;
  #define DMA_K(t,slot) glds16(ksrc+(long)(t)*KVBLK*DM,(unsigned)__builtin_amdgcn_readfirstlane(kdst+(slot)))
  #define DMA_V(t,slot) glds16(vsrc+(long)(t)*KVBLK*DM,(unsigned)__builtin_amdgcn_readfirstlane(vdst+(slot)))
  const int vb0=(int)(lds0+LDS_V)+((lane>>4)&1)*32+(lane&3)*8+(4*hi+((lane&15)>>2))*64;
  const char*Kbase=shm+LDS_K; bf16x8 kf[8];
  const lds_cptr kp0=shm3+LDS_K+hi*1024+r32*16; const lds_cptr vp0=shm3+LDS_V+((lane>>4)&1)*32+(lane&3)*8+(4*hi+((lane&15)>>2))*64;
  int NT=(q0+QB)/KVBLK;
  int ts;
  { const __attribute__((address_space(3))) float*cumL=(const __attribute__((address_space(3))) float*)(shm3+LDS_CUM); __attribute__((address_space(3))) float*red=(__attribute__((address_space(3))) float*)(shm3+LDS_RED);
    const float cref=cumL[q0]; int cnt=0;
    for(int i=tid;i<q0+QB;i+=NW*64){ const float x=cref-cumL[i]; cnt+=(x<=-bound)?1:0; const unsigned u1=__float_as_uint(x)&0xffff0000u; const float r1=x-__uint_as_float(u1);
      const unsigned u2=__float_as_uint(r1)&0xffff0000u; const float r2=r1-__uint_as_float(u2); const unsigned u3=__float_as_uint(r2)&0xffff0000u;
      u32x2 w; w.x=(u1>>16)|u2; w.y=u3>>16; *(__attribute__((address_space(3))) u32x2*)(shm3+LDS_BIAS+i*8)=w; }
    #pragma unroll
    for(int o=1;o<64;o<<=1)cnt+=__shfl_xor(cnt,o);
    if(lane==0)red[64+ui*8+wid]=(float)cnt;
    asm volatile("s_waitcnt lgkmcnt(0)\n\ts_barrier":::"memory");
    float tot=0.f;
    #pragma unroll
    for(int w=0;w<NW;++w)tot+=red[64+ui*8+w];
    ts=((int)tot>>6)&~1; if(ts>NT-4)ts=NT-4;
    ts=__builtin_amdgcn_readfirstlane(ts); }
  const bf16*ksrc=ksrc0+(long)ts*KVBLK*DM; const bf16*vsrc=vsrc0+(long)ts*KVBLK*DM; NT-=ts;
  const lds_cptr bp0=shm3+LDS_BIAS+r32*8+ts*512;
  bf16x8 qx; { const u32x4 t=(hi==0)?(u32x4){0x3F803F80u,0x00003F80u,0u,0u}:(u32x4){0u,0u,0u,0u}; qx=__builtin_bit_cast(bf16x8,t); }
  #define BIASLD(t,which) ({ const u32x2 w_=*(const __attribute__((address_space(3))) u32x2*)(bp0+(t)*512+(which)*256); const u32x4 t_=(u32x4){w_.x,w_.y,0u,0u}; __builtin_bit_cast(bf16x8,t_); })
  DMA_K(0,0);DMA_V(0,0);DMA_K(1,SLOTB);
  bf16x8 qr[4];
  #pragma unroll
  for(int d0=0;d0<4;++d0)qr[d0]=*reinterpret_cast<const bf16x8*>(&Qw[(long)r32*DM+d0*16+hi*8]);
  float mhat=0.f,l_reg=0.f;f32x16 o[2];o[0]=f32x16{};o[1]=f32x16{};f32x16 negm=f32x16{};asm volatile("":"+v"(negm));
  const int qrel=wid*QBLK+r32;
  #define CMASK(P0,P1,t) do{int jb_=(t)-(NT-4); if(jb_>=0)cmask(P0,P1,jb_,qrel,hi);}while(0)
  bool resc=false;
  #define START(P0,P1) do{ const float rm=rowmax(P0,P1); resc=false; \
    { const float dl=rm; mhat=fadd_s(mhat,dl); \
      _Pragma("unroll") for(int r=0;r<16;++r){P0[r]=fsub_s(P0[r],dl);P1[r]=fsub_s(P1[r],dl);} \
      _Pragma("unroll") for(int r=0;r<16;++r)negm[r]=-mhat; asm volatile("":"+v"(negm)); } \
    _Pragma("unroll") for(int r=0;r<16;++r)P0[r]=__builtin_amdgcn_exp2f(P0[r]); }while(0)
  #define RESC() do{ if(resc){ asm volatile("s_waitcnt lgkmcnt(0)":::"memory"); \
      _Pragma("unroll") for(int d_=0;d_<2;++d_) _Pragma("unroll") for(int r=0;r<16;++r)o[d_][r]*=wsf[crow(r,hi)]; } }while(0)
  f32x16 pA0,pA1,pB0,pB1;
  int sl_prev=0,sl_cur=0,sl_next=SLOTB;
  #define ROT() do{sl_prev=sl_cur;sl_cur=sl_next;sl_next=(sl_next==(NSLOT-1)*SLOTB)?0:sl_next+SLOTB;}while(0)
  DMA_K(2,2*SLOTB);
  WAIT_BAR(3);
  qkt(pA0,pA1,Kbase,qr,negm,r32,hi,BIASLD(0,0),BIASLD(0,1),qx);asm volatile("s_nop 15\n\ts_nop 7":"+v"(pA0),"+v"(pA1));CMASK(pA0,pA1,0);
  START(pA0,pA1);
  _Pragma("unroll") for(int r=0;r<16;++r)pA1[r]=__builtin_amdgcn_exp2f(pA1[r]);
  WAIT_BAR(0);
  DMA_K(3,0);DMA_V(1,SLOTB);
  ROT();
  kload8(kf,kp0+sl_cur);
  WAIT_BAR(2);
  s16x4 vlo[8],vhi[8]; u32x4 pw0,pw1,pw2,pw3;
  #define PKW(P,B) cvtpk_s(P[B],P[B+1])
  #define PAF(k) __builtin_bit_cast(bf16x8,pw##k)
  #define VFR(i) (bf16x8){vlo[i][0],vlo[i][1],vlo[i][2],vlo[i][3],vhi[i][0],vhi[i][1],vhi[i][2],vhi[i][3]}
  #define PIN(x) asm volatile("":"+v"(x))
  #define MX3(a,b,c) __builtin_fmaxf(__builtin_fmaxf((a),(b)),(c))
  #define GAPA(MF,A0,A1,A2,A3,W0,W1,PW) do{ MF; sacc+=A0; sacc+=A1; sacc+=A2; sacc+=A3; PIN(sacc); W0; W1; PIN(PW); SBAR(); }while(0)
  #define EX(v) __builtin_amdgcn_exp2f(v)
  #define GAPB(MF,X,B) do{ MF; X[B]=EX(X[B]); X[B+1]=EX(X[B+1]); X[B+2]=EX(X[B+2]); X[B+3]=EX(X[B+3]); PIN(X); SBAR(); }while(0)
  #define VRD(i) do{ vlo[i]=vtr(vp_+(((i)>>2)*4096+((i)&3)*1024)); vhi[i]=vtr(vp_+(((i)>>2)*4096+((i)&3)*1024+512)); }while(0)
  #define KRD(G,j) do{ if(G){ kload2(kf,kp0+sl_next,j); SBAR(); } }while(0)
  #define STEP(C0,C1,P0,P1,t,GK,GV,GL) do{ SBAR(); \
    const lds_cptr vp_=vp0+sl_prev; \
    C0=__builtin_amdgcn_mfma_f32_32x32x16_bf16(kbx0,qx,negm,0,0,0); C1=__builtin_amdgcn_mfma_f32_32x32x16_bf16(kbx1,qx,negm,0,0,0); SBAR(); \
    VRD(0); SBAR(); float sacc=(P0[0]+P0[1]); \
    GAPA(C0=__builtin_amdgcn_mfma_f32_32x32x16_bf16(kf[0],qr[0],C0,0,0,0), P0[2],P0[3],P0[4],P0[5],     pw0[0]=PKW(P0,0), pw0[1]=PKW(P0,2), pw0); \
    VRD(4); SBAR(); GAPA(C1=__builtin_amdgcn_mfma_f32_32x32x16_bf16(kf[1],qr[0],C1,0,0,0), P0[6],P0[7],P0[8],P0[9],     pw0[2]=PKW(P0,4), pw0[3]=PKW(P0,6), pw0); \
    VRD(1); SBAR(); GAPA(C0=__builtin_amdgcn_mfma_f32_32x32x16_bf16(kf[2],qr[1],C0,0,0,0),   P0[10],P0[11],P0[12],P0[13], pw1[0]=PKW(P0,8), pw1[1]=PKW(P0,10), pw1); \
    VRD(5); SBAR(); GAPA(C1=__builtin_amdgcn_mfma_f32_32x32x16_bf16(kf[3],qr[1],C1,0,0,0),   P0[14],P0[15],P1[0],P1[1],   pw1[2]=PKW(P0,12),pw1[3]=PKW(P0,14), pw1); \
    VRD(2); SBAR(); GAPA(C0=__builtin_amdgcn_mfma_f32_32x32x16_bf16(kf[4],qr[2],C0,0,0,0),   P1[2],P1[3],P1[4],P1[5],     pw2[0]=PKW(P1,0), pw2[1]=PKW(P1,2), pw2); \
    VRD(6); SBAR(); GAPA(C1=__builtin_amdgcn_mfma_f32_32x32x16_bf16(kf[5],qr[2],C1,0,0,0),   P1[6],P1[7],P1[8],P1[9],     pw2[2]=PKW(P1,4), pw2[3]=PKW(P1,6), pw2); \
    VRD(3); SBAR(); GAPA(C0=__builtin_amdgcn_mfma_f32_32x32x16_bf16(kf[6],qr[3],C0,0,0,0),   P1[10],P1[11],P1[12],P1[13], pw3[0]=PKW(P1,8), pw3[1]=PKW(P1,10), pw3); \
    VRD(7); SBAR(); GAPA(C1=__builtin_amdgcn_mfma_f32_32x32x16_bf16(kf[7],qr[3],C1,0,0,0),   P1[14],P1[15],0.f,0.f,       pw3[2]=PKW(P1,12),pw3[3]=PKW(P1,14), pw3); \
    l_reg+=sacc; \
    if(GK){DMA_K((t)+3,sl_cur);} if(GV){DMA_V((t)+1,sl_next);} \
    CMASK(C0,C1,t); \
    { float a=MX3(C0[0],C0[1],C1[0]),b=MX3(C0[2],C0[3],C1[1]); a=MX3(a,C1[2],C1[3]); \
      _Pragma("unroll") for(int r=4;r<16;r+=4){a=MX3(a,C0[r],C0[r+1]);b=MX3(b,C0[r+2],C0[r+3]);a=MX3(a,C1[r],C1[r+1]);b=MX3(b,C1[r+2],C1[r+3]);} \
      float rm=__builtin_fmaxf(a,b); { auto rr=__builtin_amdgcn_permlane32_swap(__float_as_uint(rm),__float_as_uint(rm),false,false); rm=__builtin_fmaxf(__uint_as_float(rr[0]),__uint_as_float(rr[1])); } \
      resc=false; \
      if(__builtin_expect(__any(rm>(float)THRL),0)){ const float dl=__builtin_fmaxf(rm,0.f); mhat+=dl; \
        _Pragma("unroll") for(int r=0;r<16;++r){C0[r]-=dl;C1[r]-=dl;} \
        _Pragma("unroll") for(int r=0;r<16;++r)negm[r]=-mhat; asm volatile("":"+v"(negm)); \
        const float f=__builtin_amdgcn_exp2f(-dl); l_reg*=f; if(hi==0)wsf[r32]=f; resc=true; } } \
    SBAR(); \
    GAPB(o[0]=__builtin_amdgcn_mfma_f32_32x32x16_bf16(PAF(0),VFR(0),o[0],0,0,0), C0,0); \
    GAPB(o[1]=__builtin_amdgcn_mfma_f32_32x32x16_bf16(PAF(0),VFR(4),o[1],0,0,0), C0,4); \
    KRD(GL,0); GAPB(o[0]=__builtin_amdgcn_mfma_f32_32x32x16_bf16(PAF(1),VFR(1),o[0],0,0,0), C0,8); \
    KRD(GL,1); GAPB(o[1]=__builtin_amdgcn_mfma_f32_32x32x16_bf16(PAF(1),VFR(5),o[1],0,0,0), C0,12); \
    KRD(GL,2); GAPB(o[0]=__builtin_amdgcn_mfma_f32_32x32x16_bf16(PAF(2),VFR(2),o[0],0,0,0), C1,0); \
    KRD(GL,3); GAPB(o[1]=__builtin_amdgcn_mfma_f32_32x32x16_bf16(PAF(2),VFR(6),o[1],0,0,0), C1,4); \
    GAPB(o[0]=__builtin_amdgcn_mfma_f32_32x32x16_bf16(PAF(3),VFR(3),o[0],0,0,0), C1,8); \
    GAPB(o[1]=__builtin_amdgcn_mfma_f32_32x32x16_bf16(PAF(3),VFR(7),o[1],0,0,0), C1,12); \
    if(GL){ kbx0=BIASLD((t)+1,0); kbx1=BIASLD((t)+1,1); } \
    }while(0)
  int t=1; bf16x8 kbx0=BIASLD(1,0),kbx1=BIASLD(1,1);
  #undef CMASK
  #define CMASK(P0,P1,t) do{}while(0)
  for(;t+5<NT;t+=2){
    STEP(pB0,pB1,pA0,pA1,t,true,true,true);     WAIT_BAR(2); RESC(); ROT();
    STEP(pA0,pA1,pB0,pB1,t+1,true,true,true);   WAIT_BAR(2); RESC(); ROT();
  }
  #undef CMASK
  #define CMASK(P0,P1,t) do{int jb_=(t)-(NT-4); if(jb_>=0)cmask(P0,P1,jb_,qrel,hi);}while(0)
  #define ENDW(tt) do{ if((tt)+3<NT){WAIT_BAR(2);} else if((tt)+2<NT){WAIT_BAR(1);} else {WAIT_BAR(0);} }while(0)
  for(;t+1<NT;t+=2){
    STEP(pB0,pB1,pA0,pA1,t,(t+3<NT),(t+1<NT),(t+1<NT));       ENDW(t);   RESC(); ROT();
    STEP(pA0,pA1,pB0,pB1,t+1,(t+4<NT),(t+2<NT),(t+2<NT));     ENDW(t+1); RESC(); ROT();
  }
  STEP(pB0,pB1,pA0,pA1,NT-1,false,false,false); RESC();
  { float sacc=pB0[0]+pB0[1]; _Pragma("unroll") for(int r=2;r<16;++r)sacc+=pB0[r]; _Pragma("unroll") for(int r=0;r<16;++r)sacc+=pB1[r]; l_reg+=sacc;
    pw0=(u32x4){PKW(pB0,0),PKW(pB0,2),PKW(pB0,4),PKW(pB0,6)};pw1=(u32x4){PKW(pB0,8),PKW(pB0,10),PKW(pB0,12),PKW(pB0,14)};pw2=(u32x4){PKW(pB1,0),PKW(pB1,2),PKW(pB1,4),PKW(pB1,6)};pw3=(u32x4){PKW(pB1,8),PKW(pB1,10),PKW(pB1,12),PKW(pB1,14)};
    SBAR(); pv(o,vb0+sl_cur,PAF(0),PAF(1),PAF(2),PAF(3)); }
  #undef PKW
  #undef PAF
  #undef VFR
  #undef PIN
  #undef MX3
  #undef GAPA
  #undef GAPB
  #undef EX
  #undef VRD
  #undef KRD
  #undef STEP
  #undef ENDW
  {auto rr=__builtin_amdgcn_permlane32_swap(__float_as_uint(l_reg),__float_as_uint(l_reg),false,false);l_reg=__uint_as_float(rr[0])+__uint_as_float(rr[1]);}
  if(hi==0)wsf[32+r32]=l_reg;asm volatile("s_waitcnt lgkmcnt(0)":::"memory");
  float rli[16];
  #pragma unroll
  for(int r=0;r<16;++r)rli[r]=__builtin_amdgcn_rcpf(wsf[32+crow(r,hi)]);
  bf16*Ow=O+(rowbase+q0+wid*QBLK)*OPITCH+h*D; float*ssw=ssb+(long)h*(BATCH*SEQ)+rowbase+q0+wid*QBLK;
  { bf16*stg=(bf16*)(shm+LDS_OST)+wid*2048;
    #pragma unroll
    for(int r=0;r<16;++r){const int orow=crow(r,hi);
      #pragma unroll
      for(int d0=0;d0<2;++d0)stg[orow*64+d0*32+r32]=__float2bfloat16(o[d0][r]*rli[r]);}
    asm volatile("s_waitcnt lgkmcnt(0)":::"memory");
    #pragma unroll
    for(int i=0;i<4;++i){const int row=i*8+(lane>>3),ch=lane&7; const u32x4 v=*(const u32x4*)(stg+row*64+ch*8); ATTN_STORE16(Ow+(long)row*OPITCH+ch*8,v);
      float q=0.f;
      #pragma unroll
      for(int e=0;e<4;++e){const float lo=__uint_as_float(v[e]<<16),hi2=__uint_as_float(v[e]&0xffff0000u); q+=lo*lo+hi2*hi2;}
      q+=__shfl_xor(q,1);q+=__shfl_xor(q,2);q+=__shfl_xor(q,4); if(ch==0)ssw[row]=q;} }
  asm volatile("s_waitcnt lgkmcnt(0)\n\ts_barrier":::"memory");
  #undef DMA_K
  #undef DMA_V
  #undef BIASLD
  #undef CMASK
  #undef START
  #undef RESC
  #undef ROT
}
constexpr int ATTN_LDS_BYTES=LDS_BYTES;
struct AttnTensors { const bf16* Q; const bf16* K; const bf16* V; bf16* O; const float* cum2; float* ssb; };
struct AttnUnit { int bh; int qb; };
struct StaticOrder {
  int vcu;
  __device__ __forceinline__ explicit StaticOrder(int grid,int block):vcu((block%8)*(grid/8)+block/8){}
  __device__ __forceinline__ bool next(int i,AttnUnit&u)const{ if(i>=4||vcu>=256)return false; const int s=vcu&3; u.bh=vcu>>2; u.qb=(i==0)?s:(i==1)?7-s:(i==2)?8+s:15-s; return true; }
  __device__ __forceinline__ void a_ready(const AttnUnit&)const{}
  __device__ __forceinline__ void done(const AttnUnit&)const{}
};
template<class Sched,int THRL=8> __device__ __forceinline__ void attn_phase(char*lds,const AttnTensors&T,const Sched&S){
  AttnUnit u;
  if(!S.next(0,u))return;
  { const int tid=otid(),lane=tid&63; const int wid=__builtin_amdgcn_readfirstlane(tid>>6); const int b=u.bh/NHEAD,h=u.bh%NHEAD;
    typedef __attribute__((address_space(3))) float ldsf; typedef __attribute__((address_space(3))) f32x4v ldsf4;
    ldsf*red=(ldsf*)((lds_cptr)lds+LDS_RED);
    { const f32x4v*cumh=(const f32x4v*)(T.cum2+(long)u.bh*SEQ); ldsf4*cumL=(ldsf4*)((lds_cptr)lds+LDS_CUM); for(int i=tid;i<SEQ/4;i+=NW*64)cumL[i]=cumh[i]; }
    { float mx=0.f; const bf16*Kh=T.K+((long)b*SEQ)*DM+h*D;
      for(int r=tid;r<SEQ;r+=NW*64){ const u32x4*pr=(const u32x4*)(Kh+(long)r*DM); float q=0.f;
        #pragma unroll
        for(int c=0;c<8;++c){ const u32x4 v=pr[c];
          #pragma unroll
          for(int e=0;e<4;++e){ const float lo=__uint_as_float(v[e]<<16),hi2=__uint_as_float(v[e]&0xffff0000u); q+=lo*lo+hi2*hi2; } }
        mx=fmaxf(mx,q); }
      #pragma unroll
      for(int o=1;o<64;o<<=1)mx=fmaxf(mx,__shfl_xor(mx,o));
      if(lane==0)red[wid]=mx; }
    for(int ui=0;ui<4;++ui){ AttnUnit uu; if(!S.next(ui,uu))break;
      const u32x4*pr=(const u32x4*)(T.Q+((long)b*SEQ+uu.qb*QB+(tid>>1))*DM+h*D+(tid&1)*32); float q=0.f;
      #pragma unroll
      for(int c=0;c<4;++c){ const u32x4 v=pr[c];
        #pragma unroll
        for(int e=0;e<4;++e){ const float lo=__uint_as_float(v[e]<<16),hi2=__uint_as_float(v[e]&0xffff0000u); q+=lo*lo+hi2*hi2; } }
      q+=__shfl_xor(q,1);
      #pragma unroll
      for(int o=2;o<64;o<<=1)q=fmaxf(q,__shfl_xor(q,o));
      if(lane==0)red[8+ui*8+wid]=q; }
    __syncthreads();
  }
  for(int i=0;S.next(i,u);++i){ S.a_ready(u);
    float bound;
    { typedef __attribute__((address_space(3))) float ldsf; const ldsf*red=(const ldsf*)((lds_cptr)lds+LDS_RED); float k2=0.f,q2=0.f;
      #pragma unroll
      for(int w=0;w<NW;++w){k2=fmaxf(k2,red[w]);q2=fmaxf(q2,red[8+i*8+w]);}
      bound=2.0f*sqrtf(k2*q2)*1.001f+40.0f; }
    attn_unit<THRL>(u.bh/NHEAD,u.bh%NHEAD,u.qb,T.Q,T.K,T.V,T.O,bound,i,T.ssb,lds); S.done(u); }
}
#undef SBAR
#undef WAIT_BAR
}
constexpr int NWAVES = 8;
constexpr int BATCH = 8, SEQ = 4096, DM_ = 1024, DFF = 2816, NIN = 2568, DA = 512, HA = 8, HB = 8;
constexpr int M = BATCH * SEQ;
constexpr float EPS = 1e-6f;
constexpr size_t MiB = 1u << 20;
constexpr size_t WS_MOD = 0;
constexpr size_t WS_LOGF = 1 * MiB;
constexpr size_t WS_CUM = 2 * MiB;
constexpr size_t WS_SS = 3 * MiB;
constexpr size_t WS_SSA = 5 * MiB;
constexpr size_t WS_SSB = 6 * MiB;
constexpr size_t WS_WGU0 = 8 * MiB;
constexpr size_t WS_WGU1 = 20 * MiB;
constexpr size_t WS_WD0 = 32 * MiB;
constexpr size_t WS_WD1 = 38 * MiB;
constexpr size_t WS_WIN = 44 * MiB;
constexpr size_t WS_WOUT = 50 * MiB;
constexpr size_t WS_H = 64 * MiB;
constexpr size_t WS_HD = 128 * MiB;
constexpr size_t WS_ACT = 192 * MiB;
constexpr size_t WS_ZG = 192 * MiB;
constexpr size_t WS_Q = 256 * MiB, WS_K = 288 * MiB, WS_V = 320 * MiB;
constexpr size_t WS_Y = 352 * MiB;
constexpr size_t WS_END = 416 * MiB;
static_assert(WS_ACT + (size_t)M * DFF * 2 <= WS_END && WS_Y + (size_t)M * 1024 * 2 <= WS_END, "ws map");
constexpr int LDS_BYTES = 147456;
constexpr int LDS_BARST = LDS_BYTES - 64;
constexpr size_t WS_CTL = 7 * MiB, CTL_BYTES = 16384;

#define GAS __attribute__((address_space(1)))
#define LAS __attribute__((address_space(3)))
typedef unsigned short bf16;
typedef unsigned v4u __attribute__((ext_vector_type(4)));
typedef unsigned v2u __attribute__((ext_vector_type(2)));
typedef float f32x4 __attribute__((ext_vector_type(4)));
typedef short bf16x8 __attribute__((ext_vector_type(8)));
#define LDS_WAIT() asm volatile("s_waitcnt lgkmcnt(0)" ::: "memory")
__device__ __forceinline__ unsigned f2bf(float f) { unsigned u = __builtin_bit_cast(unsigned, f); return (u + 0x7fffu + ((u >> 16) & 1u)) >> 16; }
__device__ __forceinline__ unsigned pk2(float lo, float hi) { return f2bf(lo) | (f2bf(hi) << 16); }
__device__ __forceinline__ float bf_lo(unsigned w) { return __builtin_bit_cast(float, w << 16); }
__device__ __forceinline__ float bf_hi(unsigned w) { return __builtin_bit_cast(float, w & 0xffff0000u); }
__device__ __forceinline__ float wave_sum(float v) {
#pragma unroll
    for (int o = 1; o < 64; o <<= 1) v += __shfl_xor(v, o);
    return v;
}

#define XB_TMO      128
#define XB_XCNT(j)  (256  + 64 * (j))
#define XB_XSUB(j)  (1280 + 64 * (j))
#define XB_XGEN(j)  (2304 + 64 * (j))
#define XB_TOP      3328
#define XB_TOPGEN   3392
#define XCD_BAR_WORDS 3456
#define XB_SPIN_CAP (1u << 18)

__device__ __forceinline__ unsigned xb_ld(unsigned* p)              { return __hip_atomic_load(p, __ATOMIC_RELAXED, __HIP_MEMORY_SCOPE_AGENT); }
__device__ __forceinline__ unsigned xb_add(unsigned* p, unsigned v) { return __hip_atomic_fetch_add(p, v, __ATOMIC_RELAXED, __HIP_MEMORY_SCOPE_AGENT); }
__device__ __forceinline__ unsigned xb_xcc_id() { return (unsigned)__builtin_amdgcn_s_getreg((3 << 11) | 20) & 0xFu; }
#define XB_SPIN(cond, bar) do { unsigned _sp = 0; while (cond) { __builtin_amdgcn_s_sleep(1); \
    if ((++_sp & 255u) == 0u) { if (xb_ld(&(bar)[XB_TMO])) break; if (_sp > XB_SPIN_CAP) { atomicAdd(&(bar)[XB_TMO], 1u); break; } } } } while (0)

struct XcdBarrier {
    unsigned* bar; unsigned x;
    volatile LAS unsigned* st;
};

__device__ __forceinline__ XcdBarrier xcd_barrier_post(unsigned* bar, volatile LAS unsigned* st) {
    XcdBarrier b; b.bar = bar; b.x = xb_xcc_id(); b.st = st;
    if (threadIdx.x == 0) (void)xb_add(&bar[XB_XCNT(b.x)], 1u);
    return b;
}
__device__ __forceinline__ void xcd_barrier_complete(unsigned* bar, unsigned x, unsigned& nloc, unsigned& nx) {
    const unsigned G = gridDim.x * gridDim.y * gridDim.z;
    unsigned sum, cnt, mine, sp = 0u;
    for (;;) {
        sum = 0u; cnt = 0u; mine = 0u;
#pragma unroll
        for (unsigned j = 0; j < 16; ++j) { const unsigned c = xb_ld(&bar[XB_XCNT(j)]); sum += c; cnt += (c > 0u) ? 1u : 0u; mine = (j == x) ? c : mine; }
        if (sum == G) break;
        __builtin_amdgcn_s_sleep(1);
        if ((++sp & 255u) == 0u) { if (xb_ld(&bar[XB_TMO])) break; if (sp > XB_SPIN_CAP) { atomicAdd(&bar[XB_TMO], 1u); break; } }
    }
    nloc = mine > 0u ? mine : 1u; nx = cnt > 0u ? cnt : 1u;
}

__device__ __forceinline__ void xcd_barrier(const XcdBarrier& b) {
    asm volatile("s_waitcnt vmcnt(0)" ::: "memory");
    __syncthreads();
    if (threadIdx.x == 0) {
        unsigned* bar = b.bar;
        __builtin_amdgcn_s_waitcnt(0);
        unsigned nloc = b.st[0], nx = b.st[1];
        if (nloc == 0u) { xcd_barrier_complete(bar, b.x, nloc, nx); b.st[0] = nloc; b.st[1] = nx; }
        const unsigned old = xb_add(&bar[XB_XSUB(b.x)], 1u);
        const unsigned gen = old / nloc;
        if (old + 1u == (gen + 1u) * nloc) {
            __builtin_amdgcn_fence(__ATOMIC_RELEASE, "agent");
            asm volatile("s_waitcnt vmcnt(0)" ::: "memory");
            const unsigned og = xb_add(&bar[XB_TOP], 1u);
            const unsigned tg = og / nx;
            if (og + 1u == (tg + 1u) * nx) xb_add(&bar[XB_TOPGEN], 1u);
            else XB_SPIN(xb_ld(&bar[XB_TOPGEN]) == tg, bar);
            __builtin_amdgcn_fence(__ATOMIC_ACQUIRE, "agent");
            xb_add(&bar[XB_XGEN(b.x)], 1u);
            asm volatile("s_waitcnt vmcnt(0)" ::: "memory");
        } else {
            XB_SPIN(xb_ld(&bar[XB_XGEN(b.x)]) == gen, bar);
            __builtin_amdgcn_fence(__ATOMIC_ACQUIRE, "agent");
            asm volatile("s_waitcnt vmcnt(0)" ::: "memory");
        }
    }
    __syncthreads();
}

struct Params {
    const float *x, *c, *w_ada, *b_ada, *pre_g, *post_g, *w_gate, *w_up, *w_down, *w_in, *ln_g, *ln_b, *sgu_w, *sgu_b, *b_f, *gn_a, *gn_b, *w_out;
    float* out; unsigned char* ws;
};

__device__ __forceinline__ void adaln_item(const Params& p, LAS unsigned char* lds, int cgp, int tid, int lane, int wave) {
    LAS float* sc = (LAS float*)lds;
    LAS float* red = (LAS float*)(lds + 32768);
    for (int idx = tid; idx < 8192; idx += 512) { const int b = idx >> 10, k = idx & 1023; const float v = p.c[idx]; sc[k * 8 + b] = v * pg8::fast_sigmoid(v); }
    __syncthreads();
    float acc[8];
#pragma unroll
    for (int b = 0; b < 8; ++b) acc[b] = 0.f;
    const float* wp = p.w_ada + (size_t)(wave * 128) * 9216 + cgp * 64 + lane;
#pragma unroll 32
    for (int k = 0; k < 128; ++k) { const float wv = wp[(size_t)k * 9216]; const f32x4 s0 = *(const LAS f32x4*)(sc + (wave * 128 + k) * 8), s1 = *(const LAS f32x4*)(sc + (wave * 128 + k) * 8 + 4);
        acc[0] += s0[0] * wv; acc[1] += s0[1] * wv; acc[2] += s0[2] * wv; acc[3] += s0[3] * wv; acc[4] += s1[0] * wv; acc[5] += s1[1] * wv; acc[6] += s1[2] * wv; acc[7] += s1[3] * wv; }
#pragma unroll
    for (int b = 0; b < 8; ++b) red[(wave * 8 + b) * 64 + lane] = acc[b];
    __syncthreads();
    { const int b = wave; float s = 0.f;
#pragma unroll
      for (int w = 0; w < 8; ++w) s += red[(w * 8 + b) * 64 + lane];
      const int j = cgp * 64 + lane; ((float*)(p.ws + WS_MOD))[b * 9216 + j] = s + p.b_ada[j]; }
    __syncthreads();
}
__device__ __forceinline__ void transpose_item(const float* W, int ldw, int k0, int n0, bf16* WT, int K, int drow0, LAS float* scr, int lane) {
#pragma unroll
    for (int i = 0; i < 32; ++i) { const int kk = 2 * i + (lane >> 5); scr[kk * 33 + (lane & 31)] = W[(size_t)(k0 + kk) * ldw + n0 + (lane & 31)]; }
    LDS_WAIT(); asm volatile("" ::: "memory");
    const int c = lane & 7;
#pragma unroll
    for (int j = 0; j < 4; ++j) { const int n = (lane >> 3) + 8 * j; const LAS float* s = scr + (8 * c) * 33 + n;
        v4u o; o.x = pk2(s[0 * 33], s[1 * 33]); o.y = pk2(s[2 * 33], s[3 * 33]); o.z = pk2(s[4 * 33], s[5 * 33]); o.w = pk2(s[6 * 33], s[7 * 33]);
        *(GAS v4u*)(WT + (size_t)(drow0 + n) * K + k0 + 8 * c) = o; }
    LDS_WAIT(); asm volatile("" ::: "memory");
}
__device__ __forceinline__ void convert_weights(const Params& p, LAS unsigned char* lds, int gw, int NGW, int lane, int wave) {
    LAS float* scr = (LAS float*)(lds + wave * 16384);
    constexpr int I_GU = 16 * 88, I_D = 44 * 32, I_IN = 16 * 80, I_OUT = 16 * 32;
    constexpr int NITEMS = 6 * I_GU + I_IN + I_OUT;
    static_assert(I_GU == I_D, "items");
    for (int it = gw; it < NITEMS; it += NGW) {
        int r = it;
        if (r < 4 * I_GU) {
            const int which = r / I_GU; r -= which * I_GU; const int f = which >> 1, up = which & 1;
            const int kb = r / 88, nb = r % 88, n0 = nb * 32;
            const float* W = (up ? p.w_up : p.w_gate) + (size_t)f * 1024 * DFF;
            bf16* WT = (bf16*)(p.ws + (f ? WS_WGU1 : WS_WGU0));
            transpose_item(W, DFF, kb * 64, n0, WT, 1024, 256 * (n0 >> 7) + (n0 & 127) + (up ? 128 : 0), scr, lane); continue; }
        r -= 4 * I_GU;
        if (r < 2 * I_D) { const int f = r / I_D; r -= f * I_D; const int kb = r / 32, nb = r % 32;
            transpose_item(p.w_down + (size_t)f * DFF * 1024, 1024, kb * 64, nb * 32, (bf16*)(p.ws + (f ? WS_WD1 : WS_WD0)), DFF, nb * 32, scr, lane); continue; }
        r -= 2 * I_D;
        if (r < I_IN) { const int kb = r / 80, nb = r % 80; transpose_item(p.w_in, NIN, kb * 64, nb * 32, (bf16*)(p.ws + WS_WIN), 1024, nb * 32, scr, lane); continue; }
        r -= I_IN;
        { const int kb = r / 32, nb = r % 32; transpose_item(p.w_out, 1024, kb * 64, nb * 32, (bf16*)(p.ws + WS_WOUT), 1024, nb * 32, scr, lane); }
    }
}

template <int MODE> __device__ __forceinline__ void ew_phase(const Params& p, LAS unsigned char* lds, int gw, int lane, const float* xin, int sub_res, float coef, int sub_next) {
    const int row0 = gw * 16; if (row0 >= M) return;
    asm volatile("" : "+v"(lane));
    const int b = row0 / SEQ;
    const unsigned lo = 4u * (unsigned)lane;
    const float* mod = (const float*)(p.ws + WS_MOD) + (size_t)b * 9216;
    f32x4 G[4], A[4], S[4];
    if (MODE & 1) {
#pragma unroll
        for (int j = 0; j < 4; ++j) { const unsigned col = lo + 256u * j; const f32x4 gt = *(const f32x4*)(mod + sub_res * 3072 + 2048 + col), pg = *(const f32x4*)(p.post_g + sub_res * 1024 + col); G[j] = coef * (1.0f + gt) * pg; }
        asm volatile("" : "+v"(G[0]), "+v"(G[1]), "+v"(G[2]), "+v"(G[3]) :: "memory");
    }
    if (MODE & 2) {
#pragma unroll
        for (int j = 0; j < 4; ++j) { const unsigned col = lo + 256u * j; const f32x4 sh = *(const f32x4*)(mod + sub_next * 3072 + col), scl = *(const f32x4*)(mod + sub_next * 3072 + 1024 + col), pg = *(const f32x4*)(p.pre_g + sub_next * 1024 + col);
            A[j] = pg * (1.0f + scl); S[j] = sh; }
        asm volatile("" : "+v"(A[0]), "+v"(A[1]), "+v"(A[2]), "+v"(A[3]) :: "memory");
        if (!(MODE & 4)) asm volatile("" : "+v"(S[0]), "+v"(S[1]), "+v"(S[2]), "+v"(S[3]));
    }
    const LAS f32x4* wfl = (const LAS f32x4*)lds + lane;
    const bf16* HD = (const bf16*)(p.ws + WS_HD);
    bf16* H = (bf16*)(p.ws + WS_H);
    float rs4[4] = {0.f, 0.f, 0.f, 0.f};
    if (MODE & 1) {
        const float* ss = (const float*)(p.ws + WS_SS) + row0 + (unsigned)((lane & 15) * M + (lane >> 4));
#pragma unroll
        for (int i = 0; i < 4; ++i) { float q = ss[4 * i]; q += __shfl_xor(q, 1); q += __shfl_xor(q, 2); q += __shfl_xor(q, 4); q += __shfl_xor(q, 8); rs4[i] = 1.0f / sqrtf(q * (1.0f / 1024.0f) + EPS); }
        asm volatile("" : "+v"(rs4[0]), "+v"(rs4[1]), "+v"(rs4[2]), "+v"(rs4[3]) :: "memory");
    }
    constexpr int NR = (MODE & 4) ? 1 : 2;
#pragma unroll 1
    for (int rp = 0; rp < 16 / NR; ++rp) {
        f32x4 v[NR][4]; v2u hw[NR][4];
#pragma unroll
        for (int k = 0; k < NR; ++k) { const int row = row0 + NR * rp + k;
#pragma unroll
            for (int j = 0; j < 4; ++j) { v[k][j] = *(const f32x4*)(xin + (size_t)row * 1024 + (lo + 256u * j));
                if (MODE & 1) hw[k][j] = *(const v2u*)(HD + (size_t)row * 1024 + (lo + 256u * j)); } }
#pragma unroll
        for (int k = 0; k < NR; ++k) { const int rr = NR * rp + k, row = row0 + rr;
            if (MODE & 1) {
                const int i = rr >> 2; const float sel = i == 0 ? rs4[0] : (i == 1 ? rs4[1] : (i == 2 ? rs4[2] : rs4[3]));
                const float rstd = __shfl(sel, (rr & 3) * 16);
#pragma unroll
                for (int j = 0; j < 4; ++j) { const f32x4 hv = (f32x4){bf_lo(hw[k][j].x), bf_hi(hw[k][j].x), bf_lo(hw[k][j].y), bf_hi(hw[k][j].y)};
                    v[k][j] = v[k][j] + G[j] * hv * rstd;
                    *(f32x4*)(p.out + (size_t)row * 1024 + (lo + 256u * j)) = v[k][j]; }
            }
            if (MODE & 2) {
                float s2 = 0.f;
#pragma unroll
                for (int j = 0; j < 4; ++j) s2 += (v[k][j][0] * v[k][j][0] + v[k][j][1] * v[k][j][1]) + (v[k][j][2] * v[k][j][2] + v[k][j][3] * v[k][j][3]);
                const float r2 = 1.0f / sqrtf(wave_sum(s2) * (1.0f / 1024.0f) + EPS);
                f32x4 hq[4];
#pragma unroll
                for (int j = 0; j < 4; ++j) { const f32x4 sj = (MODE & 4) ? *(const f32x4*)(mod + sub_next * 3072 + (lo + 256u * j)) : S[j];
                    hq[j] = v[k][j] * r2 * A[j] + sj;
                    v2u w; w.x = pk2(hq[j][0], hq[j][1]); w.y = pk2(hq[j][2], hq[j][3]);
                    *(v2u*)(H + (size_t)row * 1024 + (lo + 256u * j)) = w; }
                if (MODE & 4) {
                    f32x4 d0 = (f32x4){0.f, 0.f, 0.f, 0.f}, d1 = d0;
#pragma unroll
                    for (int j = 0; j < 4; ++j)
#pragma unroll
                        for (int e = 0; e < 4; ++e) { d0 += hq[j][e] * wfl[((j * 4 + e) * 2 + 0) * 64]; d1 += hq[j][e] * wfl[((j * 4 + e) * 2 + 1) * 64]; }
                    float dd[8] = {d0[0], d0[1], d0[2], d0[3], d1[0], d1[1], d1[2], d1[3]};
                    float mine = 0.f;
#pragma unroll
                    for (int hh = 0; hh < 8; ++hh) { const float t = wave_sum(dd[hh]); if (lane == hh) mine = t; }
                    if (lane < 8) { const float z = mine + p.b_f[lane];
                        const float ls = (z < 0.f ? z : 0.f) - log1pf(expf(-fabsf(z)));
                        ((float*)(p.ws + WS_LOGF))[((size_t)(b * 8 + lane)) * SEQ + (row - b * SEQ)] = ls; }
                }
            }
        }
    }
}
__device__ __forceinline__ void ew_fill_wf(const Params& p, LAS unsigned char* lds, int tid) {
    for (int idx = tid; idx < 2048; idx += NWAVES * 64) { const int l = idx & 63, half = (idx >> 6) & 1, e = (idx >> 7) & 3, j = idx >> 9;
        ((LAS f32x4*)lds)[idx] = *(const f32x4*)(p.w_in + (size_t)(4 * l + 256 * j + e) * NIN + 2560 + 4 * half); }
    __syncthreads();
}
__device__ __forceinline__ void scan_seq(const Params& p, int seq, int lane) {
    const float* src = (const float*)(p.ws + WS_LOGF) + (size_t)seq * SEQ + lane * 64;
    float* dst = (float*)(p.ws + WS_CUM) + (size_t)seq * SEQ + lane * 64;
    f32x4 v[16]; float run = 0.f;
#pragma unroll
    for (int i = 0; i < 16; ++i) { v[i] = *(const f32x4*)(src + 4 * i);
        run += v[i][0]; v[i][0] = run; run += v[i][1]; v[i][1] = run; run += v[i][2]; v[i][2] = run; run += v[i][3]; v[i][3] = run; }
    float incl = run;
#pragma unroll
    for (int o = 1; o < 64; o <<= 1) { const float t = __shfl_up(incl, o); if (lane >= o) incl += t; }
    const float excl = incl - run;
#pragma unroll
    for (int i = 0; i < 16; ++i) *(f32x4*)(dst + 4 * i) = (v[i] + excl) * 1.4426950408889634f;
}
constexpr int SGU_PITCH = 1044;
__device__ __forceinline__ void sgu_unit(const Params& p, LAS unsigned char* lds, int unit, int lane, int wave) {
    const int R0 = unit * 128;
    const bf16* ZG = (const bf16*)(p.ws + WS_ZG);
    bf16* Y = (bf16*)(p.ws + WS_Y);
    float* ssa = (float*)(p.ws + WS_SSA);
    {
        const f32x4 g0 = *(const f32x4*)(p.ln_g + 8 * lane), g1 = *(const f32x4*)(p.ln_g + 8 * lane + 4), b0 = *(const f32x4*)(p.ln_b + 8 * lane), b1 = *(const f32x4*)(p.ln_b + 8 * lane + 4);
        v4u wv[16];
#pragma unroll
        for (int rr = 0; rr < 16; ++rr) wv[rr] = *(const v4u*)(ZG + (size_t)(R0 + wave * 16 + rr) * 1024 + 512 + 8 * lane);
#pragma unroll
        for (int rr = 0; rr < 16; ++rr) { const int r = wave * 16 + rr; const v4u w = wv[rr];
            f32x4 a = (f32x4){bf_lo(w.x), bf_hi(w.x), bf_lo(w.y), bf_hi(w.y)}, c = (f32x4){bf_lo(w.z), bf_hi(w.z), bf_lo(w.w), bf_hi(w.w)};
            const float mean = wave_sum((a[0] + a[1]) + (a[2] + a[3]) + (c[0] + c[1]) + (c[2] + c[3])) * (1.0f / 512.0f);
            a = a - mean; c = c - mean;
            const float var = wave_sum((a[0] * a[0] + a[1] * a[1]) + (a[2] * a[2] + a[3] * a[3]) + (c[0] * c[0] + c[1] * c[1]) + (c[2] * c[2] + c[3] * c[3])) * (1.0f / 512.0f);
            const float rstd = 1.0f / sqrtf(var + EPS);
            a = a * rstd * g0 + b0; c = c * rstd * g1 + b1;
            LAS unsigned* d = (LAS unsigned*)(lds + r * SGU_PITCH + 16 * lane);
            d[0] = pk2(a[0], a[1]); d[1] = pk2(a[2], a[3]); d[2] = pk2(c[0], c[1]); d[3] = pk2(c[2], c[3]); }
    }
    __syncthreads();
    const int fr = lane & 15, fq = lane >> 4;
    const int i = wave * 16 + fr;
    const int nks = wave < 4 ? 2 : 4;
    const float* Wr0 = p.sgu_w + (size_t)i * 128 + 8 * fq;
    const size_t rowoff = (size_t)(R0 + i) * 1024;
    f32x4 wcur[4][2], wnxt[4][2];
#pragma unroll
    for (int ks = 0; ks < 4; ++ks) { wcur[ks][0] = *(const f32x4*)(Wr0 + 32 * ks); wcur[ks][1] = *(const f32x4*)(Wr0 + 32 * ks + 4); }
#pragma unroll 1
    for (int h = 0; h < HA; ++h) {
        const int hn = h + 1 < HA ? h + 1 : h;
#pragma unroll
        for (int ks = 0; ks < 4; ++ks) { wnxt[ks][0] = *(const f32x4*)(Wr0 + (size_t)hn * 16384 + 32 * ks); wnxt[ks][1] = *(const f32x4*)(Wr0 + (size_t)hn * 16384 + 32 * ks + 4); }
        v2u uw[4];
#pragma unroll
        for (int nt = 0; nt < 4; ++nt) uw[nt] = *(const v2u*)(ZG + rowoff + 64 * h + 16 * nt + 4 * fq);
        const float bs = p.sgu_b[h * 128 + i];
        f32x4 acc[4];
#pragma unroll
        for (int nt = 0; nt < 4; ++nt) acc[nt] = (f32x4){0.f, 0.f, 0.f, 0.f};
#pragma unroll
        for (int ks = 0; ks < 4; ++ks) if (ks < nks) {
            const f32x4 w0 = wcur[ks][0], w1 = wcur[ks][1];
            v4u wu; wu.x = pk2(w0[0], w0[1]); wu.y = pk2(w0[2], w0[3]); wu.z = pk2(w1[0], w1[1]); wu.w = pk2(w1[2], w1[3]);
            const bf16x8 wfrag = __builtin_bit_cast(bf16x8, wu);
            const LAS unsigned short* vb = (const LAS unsigned short*)(lds + (32 * ks + 8 * fq) * SGU_PITCH + (64 * h + fr) * 2);
#pragma unroll
            for (int nt = 0; nt < 4; ++nt) { bf16x8 vf;
#pragma unroll
                for (int e = 0; e < 8; ++e) vf[e] = (short)vb[e * (SGU_PITCH / 2) + 16 * nt];
                acc[nt] = __builtin_amdgcn_mfma_f32_16x16x32_bf16(vf, wfrag, acc[nt], 0, 0, 0); }
        }
        float q = 0.f;
#pragma unroll
        for (int nt = 0; nt < 4; ++nt) { const int c = 64 * h + 16 * nt + 4 * fq;
            const f32x4 uv = (f32x4){bf_lo(uw[nt].x), bf_hi(uw[nt].x), bf_lo(uw[nt].y), bf_hi(uw[nt].y)};
            const f32x4 y = uv * (acc[nt] + bs);
            v2u o; o.x = pk2(y[0], y[1]); o.y = pk2(y[2], y[3]);
            const f32x4 yr = (f32x4){bf_lo(o.x), bf_hi(o.x), bf_lo(o.y), bf_hi(o.y)};
            q += (yr[0] * yr[0] + yr[1] * yr[1]) + (yr[2] * yr[2] + yr[3] * yr[3]);
            *(v2u*)(Y + rowoff + c) = o; }
        q += __shfl_xor(q, 16); q += __shfl_xor(q, 32);
        if (fq == 0) ssa[(size_t)h * M + R0 + i] = q;
#pragma unroll
        for (int ks = 0; ks < 4; ++ks) { wcur[ks][0] = wnxt[ks][0]; wcur[ks][1] = wnxt[ks][1]; }
    }
    __syncthreads();
}
__device__ __forceinline__ void ynorm_phase(const Params& p, int gw, int lane) {
    const int row0 = gw * 16; if (row0 >= M) return;
    asm volatile("" : "+v"(lane));
    const f32x4 ga0 = *(const f32x4*)(p.gn_a + 8 * lane), ga1 = *(const f32x4*)(p.gn_a + 8 * lane + 4), gb0 = *(const f32x4*)(p.gn_b + 8 * lane), gb1 = *(const f32x4*)(p.gn_b + 8 * lane + 4);
    const float* ssa = (const float*)(p.ws + WS_SSA); const float* ssb = (const float*)(p.ws + WS_SSB);
    bf16* Y = (bf16*)(p.ws + WS_Y);
    for (int rr = 0; rr < 16; ++rr) { const int row = row0 + rr;
        float qa = 0.f, qb = 0.f;
#pragma unroll
        for (int h = 0; h < 8; ++h) { qa += ssa[(size_t)h * M + row]; qb += ssb[(size_t)h * M + row]; }
        const float ra = 1.0f / sqrtf(qa * (1.0f / 512.0f) + EPS), rb = 1.0f / sqrtf(qb * (1.0f / 512.0f) + EPS);
        v4u* pa = (v4u*)(Y + (size_t)row * 1024 + 8 * lane); v4u* pb = (v4u*)(Y + (size_t)row * 1024 + 512 + 8 * lane);
        const v4u wa = *pa, wb = *pb; v4u oa, ob;
        oa.x = pk2(bf_lo(wa.x) * ra * ga0[0], bf_hi(wa.x) * ra * ga0[1]); oa.y = pk2(bf_lo(wa.y) * ra * ga0[2], bf_hi(wa.y) * ra * ga0[3]);
        oa.z = pk2(bf_lo(wa.z) * ra * ga1[0], bf_hi(wa.z) * ra * ga1[1]); oa.w = pk2(bf_lo(wa.w) * ra * ga1[2], bf_hi(wa.w) * ra * ga1[3]);
        ob.x = pk2(bf_lo(wb.x) * rb * gb0[0], bf_hi(wb.x) * rb * gb0[1]); ob.y = pk2(bf_lo(wb.y) * rb * gb0[2], bf_hi(wb.y) * rb * gb0[3]);
        ob.z = pk2(bf_lo(wb.z) * rb * gb1[0], bf_hi(wb.z) * rb * gb1[1]); ob.w = pk2(bf_lo(wb.w) * rb * gb1[2], bf_hi(wb.w) * rb * gb1[3]);
        *pa = oa; *pb = ob; }
}

#ifndef PROBE
#define PROBE 0
#endif
#define REPS(cond) for (int rep_ = 0; rep_ < ((cond) ? 2 : 1); ++rep_)
__global__ void __launch_bounds__(NWAVES * 64, 2) mega_fwd(Params p) {
    extern __shared__ __attribute__((aligned(16))) unsigned char lds_raw[];
    cg::grid_group grid = cg::this_grid();
    LAS unsigned char* lds = (LAS unsigned char*)lds_raw;
    if (threadIdx.x < 16) ((LAS unsigned*)(lds + LDS_BARST))[threadIdx.x] = 0u;
    __syncthreads();
    const XcdBarrier bar = xcd_barrier_post((unsigned*)(p.ws + WS_CTL), (volatile LAS unsigned*)(lds + LDS_BARST));
    if (p.ws == nullptr) grid.sync();
#define GRID_SYNC() xcd_barrier(bar)
    const int G = gridDim.x, bx = blockIdx.x, NGW = G * NWAVES;
#define LANEVARS const int tid = otid(), lane = tid & 63, wave = __builtin_amdgcn_readfirstlane(tid >> 6), gw = bx * NWAVES + wave; (void)tid; (void)lane; (void)wave; (void)gw
    bf16* H = (bf16*)(p.ws + WS_H); bf16* HD = (bf16*)(p.ws + WS_HD); bf16* ACT = (bf16*)(p.ws + WS_ACT);
    float* SS = (float*)(p.ws + WS_SS);

    REPS(PROBE == 3) { LANEVARS; for (int it = bx; it < 144; it += G) adaln_item(p, lds, it, tid, lane, wave);
      convert_weights(p, lds, gw, NGW, lane, wave); __syncthreads(); }
    if (PROBE == 1) for (int i = 0; i < 12; ++i) GRID_SYNC();
    GRID_SYNC();
    REPS(PROBE == 5) { LANEVARS; for (int g = gw; g * 16 < M; g += NGW) ew_phase<2>(p, lds, g, lane, p.x, 0, 0.f, 0); }
    GRID_SYNC();
    REPS(PROBE == 4) { pg8::Gemm g{H, (const bf16*)(p.ws + WS_WGU0), M, 2 * DFF, 1024}; pg8::StaticOrder S; S.init(M, 2 * DFF, G, bx);
      pg8::EpiSwiGLU E{ACT, DFF}; pg8::gemm_phase<pg8::EpiSwiGLU, pg8::StaticOrder, true, true>(lds, g, S, E); }
    GRID_SYNC();
    REPS(PROBE == 4) { pg8::Gemm g{ACT, (const bf16*)(p.ws + WS_WD0), M, 1024, DFF}; pg8::StaticOrder S; S.init(M, 1024, G, bx);
      pg8::EpiBf16Ss E{HD, 1024, SS, M}; pg8::gemm_phase<pg8::EpiBf16Ss, pg8::StaticOrder, true, true>(lds, g, S, E); }
    GRID_SYNC();
    REPS(PROBE == 5) { LANEVARS; __syncthreads(); ew_fill_wf(p, lds, tid); for (int g = gw; g * 16 < M; g += NGW) ew_phase<7>(p, lds, g, lane, p.x, 0, 0.5f, 1); }
    GRID_SYNC();
    { LANEVARS; if (wave == 0) for (int s = bx; s < BATCH * HB; s += G) scan_seq(p, s, lane); }
    REPS(PROBE == 4) { pg8::Gemm g{H, (const bf16*)(p.ws + WS_WIN), M, 2560, 1024}; pg8::StaticOrder S; S.init(M, 2560, G, bx);
      static_assert(WS_K - WS_Q == WS_V - WS_K, "qkv stride");
      pg8::EpiMixIn E{(bf16*)(p.ws + WS_ZG), (bf16*)(p.ws + WS_Q), (WS_K - WS_Q) / 2, attn_body::C2};
      pg8::gemm_phase<pg8::EpiMixIn, pg8::StaticOrder, true, true>(lds, g, S, E); }
    GRID_SYNC();
    REPS(PROBE == 2) {
    { LANEVARS; for (int u = bx; u < M / 128; u += G) sgu_unit(p, lds, u, lane, wave); }
    { const attn_body::AttnTensors AT{(const attn_body::bf16*)(p.ws + WS_Q), (const attn_body::bf16*)(p.ws + WS_K), (const attn_body::bf16*)(p.ws + WS_V),
                                      (attn_body::bf16*)(p.ws + WS_Y) + 512, (const float*)(p.ws + WS_CUM), (float*)(p.ws + WS_SSB)};
      const attn_body::StaticOrder S(G, bx);
      attn_body::attn_phase<attn_body::StaticOrder>((char*)lds_raw, AT, S); }
    }
    GRID_SYNC();
    { LANEVARS; for (int g = gw; g * 16 < M; g += NGW) ynorm_phase(p, g, lane); }
    GRID_SYNC();
    REPS(PROBE == 4) { pg8::Gemm g{(const bf16*)(p.ws + WS_Y), (const bf16*)(p.ws + WS_WOUT), M, 1024, 1024}; pg8::StaticOrder S; S.init(M, 1024, G, bx);
      pg8::EpiBf16Ss E{HD, 1024, SS, M}; pg8::gemm_phase<pg8::EpiBf16Ss, pg8::StaticOrder, true, true>(lds, g, S, E); }
    GRID_SYNC();
    { LANEVARS; for (int g = gw; g * 16 < M; g += NGW) ew_phase<3>(p, lds, g, lane, p.out, 1, 1.0f, 2); }
    GRID_SYNC();
    REPS(PROBE == 4) { pg8::Gemm g{H, (const bf16*)(p.ws + WS_WGU1), M, 2 * DFF, 1024}; pg8::StaticOrder S; S.init(M, 2 * DFF, G, bx);
      pg8::EpiSwiGLU E{ACT, DFF}; pg8::gemm_phase<pg8::EpiSwiGLU, pg8::StaticOrder, true, true>(lds, g, S, E); }
    GRID_SYNC();
    REPS(PROBE == 4) { pg8::Gemm g{ACT, (const bf16*)(p.ws + WS_WD1), M, 1024, DFF}; pg8::StaticOrder S; S.init(M, 1024, G, bx);
      pg8::EpiBf16Ss E{HD, 1024, SS, M}; pg8::gemm_phase<pg8::EpiBf16Ss, pg8::StaticOrder, true, true>(lds, g, S, E); }
    GRID_SYNC();
    { LANEVARS; for (int g = gw; g * 16 < M; g += NGW) ew_phase<1>(p, lds, g, lane, p.out, 2, 0.5f, 0); }
}

extern "C" void kernel_launch(void* const* d_in, const int* in_sizes, int n_in, void* d_out, int out_size, void* d_ws, size_t ws_size, hipStream_t stream) {
    static int grid = 0;
    if (grid == 0) {
        if (n_in != 18 || out_size != M * 1024 || ws_size < WS_END) { fprintf(stderr, "kernel_launch: unexpected problem shape (n_in %d out %d ws %zu)\n", n_in, out_size, ws_size); grid = -1; return; }
        int dev = 0, cus = 0, per_cu = 0;
        (void)hipGetDevice(&dev); (void)hipDeviceGetAttribute(&cus, hipDeviceAttributeMultiprocessorCount, dev);
        if (hipFuncSetAttribute((const void*)mega_fwd, hipFuncAttributeMaxDynamicSharedMemorySize, LDS_BYTES) != hipSuccess) { fprintf(stderr, "kernel_launch: hipFuncSetAttribute failed\n"); grid = -1; return; }
        if (hipOccupancyMaxActiveBlocksPerMultiprocessor(&per_cu, (const void*)mega_fwd, NWAVES * 64, LDS_BYTES) != hipSuccess || per_cu < 1) { fprintf(stderr, "kernel_launch: occupancy query says %d\n", per_cu); per_cu = 1; }
        (void)hipGetLastError();
        grid = cus * 1;
        if (grid <= 0) grid = 256;
    }
    if (grid < 0) return;
    if (hipMemsetAsync((char*)d_ws + WS_CTL, 0, CTL_BYTES, stream) != hipSuccess) { fprintf(stderr, "kernel_launch: memset failed\n"); return; }
    Params p{};
    p.x = (const float*)d_in[0]; p.c = (const float*)d_in[1]; p.w_ada = (const float*)d_in[2]; p.b_ada = (const float*)d_in[3]; p.pre_g = (const float*)d_in[4]; p.post_g = (const float*)d_in[5];
    p.w_gate = (const float*)d_in[6]; p.w_up = (const float*)d_in[7]; p.w_down = (const float*)d_in[8]; p.w_in = (const float*)d_in[9]; p.ln_g = (const float*)d_in[10]; p.ln_b = (const float*)d_in[11];
    p.sgu_w = (const float*)d_in[12]; p.sgu_b = (const float*)d_in[13]; p.b_f = (const float*)d_in[14]; p.gn_a = (const float*)d_in[15]; p.gn_b = (const float*)d_in[16]; p.w_out = (const float*)d_in[17];
    p.out = (float*)d_out; p.ws = (unsigned char*)d_ws;
    void* args[] = {&p};
    hipError_t e = hipLaunchCooperativeKernel((const void*)mega_fwd, dim3(grid), dim3(NWAVES * 64), args, LDS_BYTES, stream);
    if (e != hipSuccess) fprintf(stderr, "kernel_launch: cooperative launch failed: %s (grid %d)\n", hipGetErrorString(e), grid);
}
```

```cpp
#include <hip/hip_runtime.h>
#include <hip/hip_cooperative_groups.h>
#include <hip/hip_bf16.h>
#include <cstdio>
#include <cstdint>
#include <cmath>
namespace cg = cooperative_groups;
__device__ __forceinline__ int otid() { int t = threadIdx.x; asm volatile("" : "+v"(t)); return t; }
namespace pg8 {
#define PG8_LAS __attribute__((address_space(3)))
typedef unsigned short bf16_t;
typedef short bf16x8 __attribute__((ext_vector_type(8)));
typedef float f32x4 __attribute__((ext_vector_type(4)));
typedef unsigned u32x4 __attribute__((ext_vector_type(4)));
constexpr int BM = 256, BK = 64, HALF = 128, HTB = HALF * BK * 2  , STAGE_BYTES = 8 * HTB, NXCD = 8, WGM = 8;

__host__ __device__ __forceinline__ int lds_byte(int r, int c) { const int st = (r >> 4) * 2 + (c >> 5), rr = r & 15, cc = c & 31, ob = rr * 64 + cc * 2; return st * 1024 + (ob ^ (((ob >> 9) & 1) << 5)); }
__host__ __device__ __forceinline__ void stage_rc(int b, int& R, int& C) { const int st = b / 1024, sb = b % 1024, swz = sb ^ (((sb >> 9) & 1) << 5); R = (st >> 1) * 16 + swz / 64; C = (st & 1) * 32 + (swz % 64) / 2; }
__host__ __device__ __forceinline__ int perm32(int rho) { const int n = rho >> 4, i = rho & 15; return 8 * (i >> 2) + 4 * n + (i & 3); }

struct Unit { int pm, pn; };
struct Gemm { const bf16_t* A; const bf16_t* Bt; int M, N, K; };

struct StaticOrder {
    int nM, nN, nwg, G, c;
    __host__ __device__ __forceinline__ void init(int M, int N, int G_, int c_) { nM = M / BM; nN = N / BM; nwg = nM * nN; G = G_; c = c_; }
    __host__ __device__ __forceinline__ bool next(int i, Unit& u) const {
        const long L = (long)i * G + c; if (L >= nwg) return false;
        int wgid = (int)L; { const int q = nwg / NXCD, r = nwg % NXCD, xcd = wgid % NXCD, off = wgid / NXCD; wgid = (xcd < r ? xcd * (q + 1) : r * (q + 1) + (xcd - r) * q) + off; }
        const int nig = WGM * nN, gid = wgid / nig, fm = gid * WGM, gsz = (nM - fm) < WGM ? (nM - fm) : WGM;
        u.pm = fm + ((wgid % nig) % gsz); u.pn = (wgid % nig) / gsz; return true;
    }
    __device__ __forceinline__ void a_ready(const Unit&) const {}
    __device__ __forceinline__ void done(const Unit&) const {}
};

__device__ __forceinline__ unsigned cvt_pk_bf16(float lo, float hi) { unsigned r; asm volatile("v_cvt_pk_bf16_f32 %0, %1, %2" : "=v"(r) : "v"(lo), "v"(hi)); return r; }
typedef float f32x2 __attribute__((ext_vector_type(2)));
__device__ __forceinline__ float fast_sigmoid(float t) { return __builtin_amdgcn_rcpf(1.0f + __builtin_amdgcn_exp2f(-1.4426950408889634f * t)); }
struct EpiSwiGLU {
    static constexpr bool PERM = true, AFTER_DRAIN = false, HAS_MID = false;
    bf16_t* O; int ldc; int mode;
    __device__ __forceinline__ void operator()(const f32x4 (&acc)[2][2][4][2], const Unit& u, int wr, int wc, int fr, int fq) const {
        if (mode == 2) return;
        const int row0 = u.pm * BM + wr * 64 + fr; const int col0 = u.pn * HALF + wc * 32 + 8 * fq;
#pragma unroll
        for (int ai = 0; ai < 2; ++ai)
#pragma unroll
            for (int m = 0; m < 4; ++m) { bf16_t* rowp = O + (size_t)(row0 + ai * HALF + m * 16) * ldc + col0;
                float o[8];
#pragma unroll
                for (int n = 0; n < 2; ++n)
#pragma unroll
                    for (int e = 0; e < 4; ++e) { const float g = acc[ai][0][m][n][e], up = acc[ai][1][m][n][e]; o[n * 4 + e] = g * fast_sigmoid(g) * up; }
                u32x4 w; w.x = cvt_pk_bf16(o[0], o[1]); w.y = cvt_pk_bf16(o[2], o[3]); w.z = cvt_pk_bf16(o[4], o[5]); w.w = cvt_pk_bf16(o[6], o[7]);
                if (mode == 0) *(u32x4*)rowp = w; else if (w.x == 0x12345678u && w.y == 0x9abcdef0u) *(u32x4*)rowp = w; }
    }
};
struct EpiBf16Ss {
    static constexpr bool PERM = true, AFTER_DRAIN = false, HAS_MID = false;
    bf16_t* O; int ldc; float* ss; int M;
    __device__ __forceinline__ void operator()(const f32x4 (&acc)[2][2][4][2], const Unit& u, int wr, int wc, int fr, int fq) const {
        const int row0 = u.pm * BM + wr * 64 + fr; const int col0 = u.pn * BM + wc * 32 + 8 * fq;
        float* ssp = ss + (size_t)(u.pn * 4 + wc) * M;
#pragma unroll
        for (int ai = 0; ai < 2; ++ai)
#pragma unroll
            for (int m = 0; m < 4; ++m) { const int row = row0 + ai * HALF + m * 16; bf16_t* rowp = O + (size_t)row * ldc + col0; float q = 0.f;
#pragma unroll
                for (int bj = 0; bj < 2; ++bj) { const f32x4 v0 = acc[ai][bj][m][0], v1 = acc[ai][bj][m][1];
                    q += (v0[0] * v0[0] + v0[1] * v0[1]) + (v0[2] * v0[2] + v0[3] * v0[3]) + (v1[0] * v1[0] + v1[1] * v1[1]) + (v1[2] * v1[2] + v1[3] * v1[3]);
                    u32x4 w; w.x = cvt_pk_bf16(v0[0], v0[1]); w.y = cvt_pk_bf16(v0[2], v0[3]); w.z = cvt_pk_bf16(v1[0], v1[1]); w.w = cvt_pk_bf16(v1[2], v1[3]);
                    __builtin_nontemporal_store(w, (u32x4*)(rowp + bj * HALF)); }
                q += __shfl_xor(q, 16); q += __shfl_xor(q, 32);
                if (fq == 0) ssp[row] = q; }
    }
};
struct EpiRowScaleSs {
    static constexpr bool PERM = true, AFTER_DRAIN = false, HAS_MID = true;
    bf16_t* O; int ldc; float* ss; int M; const PG8_LAS f32x2* tab; int pm0;
    __device__ __forceinline__ void mid(f32x4 (&acc)[2][2][4][2], const Unit& u, int wr, int fr) const {
        const PG8_LAS f32x2* t = tab + (u.pm == pm0 ? 0 : 256) + wr * 64 + fr;
#pragma unroll
        for (int ai = 0; ai < 2; ++ai)
#pragma unroll
            for (int m = 0; m < 4; ++m) { const float f = t[ai * HALF + m * 16].x;
#pragma unroll
                for (int bj = 0; bj < 2; ++bj)
#pragma unroll
                    for (int n = 0; n < 2; ++n) acc[ai][bj][m][n] = acc[ai][bj][m][n] * f; }
    }
    __device__ __forceinline__ void operator()(const f32x4 (&acc)[2][2][4][2], const Unit& u, int wr, int wc, int fr, int fq) const {
        const int row0 = u.pm * BM + wr * 64 + fr; const int col0 = u.pn * BM + wc * 32 + 8 * fq;
        float* ssp = ss + (size_t)(u.pn * 4 + wc) * M;
        const PG8_LAS f32x2* t = tab + (u.pm == pm0 ? 0 : 256) + wr * 64 + fr;
#pragma unroll
        for (int ai = 0; ai < 2; ++ai)
#pragma unroll
            for (int m = 0; m < 4; ++m) { const int row = row0 + ai * HALF + m * 16; bf16_t* rowp = O + (size_t)row * ldc + col0; float q = 0.f; const float f = t[ai * HALF + m * 16].y;
#pragma unroll
                for (int bj = 0; bj < 2; ++bj) { const f32x4 v0 = acc[ai][bj][m][0] * f, v1 = acc[ai][bj][m][1] * f;
                    q += (v0[0] * v0[0] + v0[1] * v0[1]) + (v0[2] * v0[2] + v0[3] * v0[3]) + (v1[0] * v1[0] + v1[1] * v1[1]) + (v1[2] * v1[2] + v1[3] * v1[3]);
                    u32x4 w; w.x = cvt_pk_bf16(v0[0], v0[1]); w.y = cvt_pk_bf16(v0[2], v0[3]); w.z = cvt_pk_bf16(v1[0], v1[1]); w.w = cvt_pk_bf16(v1[2], v1[3]);
                    __builtin_nontemporal_store(w, (u32x4*)(rowp + bj * HALF)); }
                q += __shfl_xor(q, 16); q += __shfl_xor(q, 32);
                if (fq == 0) ssp[row] = q; }
    }
};
struct EpiMixIn {
    static constexpr bool PERM = true, AFTER_DRAIN = false, HAS_MID = false;
    bf16_t* ZG; bf16_t* Q; size_t qkv_stride; float qscale; size_t pad_zg, pad_qkv;
    __device__ __forceinline__ void operator()(const f32x4 (&acc)[2][2][4][2], const Unit& u, int wr, int wc, int fr, int fq) const {
        const int row0 = u.pm * BM + wr * 64 + fr;
        bf16_t* base; int ldc, colt; float sc = 1.f; const bool gelu = u.pn < 4;
        if (u.pn < 4) { base = ZG + (size_t)(u.pm >> 4) * pad_zg; ldc = 1024; colt = u.pn * BM; }
        else { const int t = (u.pn - 4) >> 1; base = Q + (size_t)t * qkv_stride + (size_t)(u.pm >> 4) * pad_qkv; ldc = 512; colt = ((u.pn - 4) & 1) * BM; if (t == 0) sc = qscale; }
        const int col0 = colt + wc * 32 + 8 * fq;
#pragma unroll
        for (int ai = 0; ai < 2; ++ai)
#pragma unroll
            for (int m = 0; m < 4; ++m) { bf16_t* rowp = base + (size_t)(row0 + ai * HALF + m * 16) * ldc + col0;
#pragma unroll
                for (int bj = 0; bj < 2; ++bj) { float o[8];
#pragma unroll
                    for (int n = 0; n < 2; ++n)
#pragma unroll
                        for (int e = 0; e < 4; ++e) { float x = acc[ai][bj][m][n][e];
                            if (gelu) { const float t = 1.5957691216057308f * (x + 0.044715f * x * x * x); x = x * fast_sigmoid(t); } else x *= sc;
                            o[n * 4 + e] = x; }
                    u32x4 w; w.x = cvt_pk_bf16(o[0], o[1]); w.y = cvt_pk_bf16(o[2], o[3]); w.z = cvt_pk_bf16(o[4], o[5]); w.w = cvt_pk_bf16(o[6], o[7]);
                    *(u32x4*)(rowp + bj * HALF) = w; } }
    }
};

template <class Epi, class Sched, bool ALIGN_EPI = false, bool SP2 = false>
__device__ __forceinline__ void gemm_phase(PG8_LAS unsigned char* lds, const Gemm g, const Sched& S, const Epi& E) {
    const int tid = otid(), wid = __builtin_amdgcn_readfirstlane(tid >> 6), lane = tid & 63, wr = wid >> 2, wc = wid & 3, fr = lane & 15, fq = lane >> 4;
    const int K = g.K, nt = K / BK;
    unsigned voffA[2], voffB[2];
#pragma unroll
    for (int i = 0; i < 2; ++i) { int R, C; stage_rc(tid * 16 + i * 8192, R, C); const int Rb = Epi::PERM ? ((R & ~31) + perm32(R & 31)) : R;
        voffA[i] = (unsigned)(R * K + C) * 2u; voffB[i] = (unsigned)(Rb * K + C) * 2u; }
    const size_t kstep = (size_t)(BK * 2);
    const size_t hstep = (size_t)HALF * K * 2;
    const size_t tstep = 2 * hstep;
    const unsigned ldsw = (unsigned)wid * 1024u;
    const int aoff = lds_byte(wr * 64 + fr, fq * 8), boff = lds_byte(wc * 32 + fr, fq * 8);
#define PG8_SA(b, h) (((b) * 2 + (h)) * HTB)
#define PG8_SB(b, h) ((4 + (b) * 2 + (h)) * HTB)
#define PG8_STAGE(bufoff, gbase, voff) do { _Pragma("unroll") for (int _i = 0; _i < 2; ++_i) \
        __builtin_amdgcn_global_load_lds((const unsigned*)((const char*)(gbase) + (voff)[_i]), (PG8_LAS unsigned*)(lds + (bufoff) + ldsw + _i * 8192), 16, 0, 0); } while (0)
#define PG8_LDA(dst, b, h) do { _Pragma("unroll") for (int m = 0; m < 4; ++m) _Pragma("unroll") for (int k = 0; k < 2; ++k) dst[m][k] = *(const PG8_LAS bf16x8*)(lds + PG8_SA(b, h) + aoff + m * 2048 + k * 1024); } while (0)
#define PG8_LDB(dst, b, h) do { _Pragma("unroll") for (int n = 0; n < 2; ++n) _Pragma("unroll") for (int k = 0; k < 2; ++k) dst[n][k] = *(const PG8_LAS bf16x8*)(lds + PG8_SB(b, h) + boff + n * 2048 + k * 1024); } while (0)
#define PG8_MMA(ai, bj, At, Bt) do { __builtin_amdgcn_s_setprio(1); _Pragma("unroll") for (int m = 0; m < 4; ++m) _Pragma("unroll") for (int n = 0; n < 2; ++n) _Pragma("unroll") for (int k = 0; k < 2; ++k) \
        acc[ai][bj][m][n] = __builtin_amdgcn_mfma_f32_16x16x32_bf16(Bt[n][k], At[m][k], acc[ai][bj][m][n], 0, 0, 0); __builtin_amdgcn_s_setprio(0); } while (0)
#define PG8_WAIT_V(n) asm volatile("s_waitcnt vmcnt(" #n ")" ::: "memory")
#define PG8_WAIT_L(n) asm volatile("s_waitcnt lgkmcnt(" #n ")" ::: "memory")
#define PG8_BAR __builtin_amdgcn_s_barrier()
#define PG8_SCHED __builtin_amdgcn_sched_barrier(0)
    Unit cur, nxt; int ui = 0;
    if (!S.next(0, cur)) return;
    f32x4 acc[2][2][4][2];
#pragma unroll
    for (int a = 0; a < 2; ++a)
#pragma unroll
        for (int b = 0; b < 2; ++b)
#pragma unroll
            for (int m = 0; m < 4; ++m)
#pragma unroll
                for (int n = 0; n < 2; ++n) acc[a][b][m][n] = (f32x4){0.f, 0.f, 0.f, 0.f};
    bf16x8 At[4][2], B0[2][2], B1[2][2];
    const char* cA = (const char*)g.A + (size_t)cur.pm * tstep; const char* cB = (const char*)g.Bt + (size_t)cur.pn * tstep;
    S.a_ready(cur);
    if constexpr (SP2) {
        PG8_STAGE(PG8_SB(0, 0), cB, voffB); PG8_STAGE(PG8_SB(0, 1), cB + hstep, voffB); PG8_STAGE(PG8_SA(0, 0), cA, voffA); PG8_STAGE(PG8_SA(0, 1), cA + hstep, voffA);
        if (wr == 1) PG8_BAR;
        PG8_WAIT_V(2); PG8_BAR;
        PG8_STAGE(PG8_SB(1, 0), cB + kstep, voffB); PG8_STAGE(PG8_SA(1, 0), cA + kstep, voffA); PG8_STAGE(PG8_SB(1, 1), cB + hstep + kstep, voffB);
        PG8_WAIT_V(6); PG8_BAR;
    } else {
        PG8_STAGE(PG8_SB(0, 0), cB, voffB); PG8_STAGE(PG8_SA(0, 0), cA, voffA); PG8_STAGE(PG8_SB(0, 1), cB + hstep, voffB); PG8_STAGE(PG8_SA(0, 1), cA + hstep, voffA);
        if (wr == 1) PG8_BAR;
        PG8_WAIT_V(4); PG8_BAR;
        PG8_STAGE(PG8_SB(1, 0), cB + kstep, voffB); PG8_STAGE(PG8_SA(1, 0), cA + kstep, voffA); PG8_STAGE(PG8_SB(1, 1), cB + hstep + kstep, voffB);
        PG8_WAIT_V(6); PG8_BAR;
    }
    for (;;) {
        const bool has_next = S.next(ui + 1, nxt);
        const char* nA = has_next ? (const char*)g.A + (size_t)nxt.pm * tstep : cA; const char* nB = has_next ? (const char*)g.Bt + (size_t)nxt.pn * tstep : cB;
        for (int t = 0; t < nt; t += 2) {
            const bool last = (t == nt - 2);
            const char* a1 = cA + (size_t)(t + 1) * kstep;
            const char* a2 = last ? nA : cA + (size_t)(t + 2) * kstep; const char* b2 = last ? nB : cB + (size_t)(t + 2) * kstep;
            const char* a3 = a2 + kstep; const char* b3 = b2 + kstep;
            if (last && has_next) S.a_ready(nxt);
            if constexpr (Epi::HAS_MID) { if (t == nt / 2) E.mid(acc, cur, wr, fr); }
            if constexpr (SP2) {
            PG8_LDB(B0, 0, 0); PG8_LDB(B1, 0, 1); PG8_SCHED; PG8_LDA(At, 0, 0); PG8_STAGE(PG8_SA(1, 1), a1 + hstep, voffA);
            PG8_WAIT_V(8); PG8_WAIT_L(0); PG8_BAR; PG8_MMA(0, 0, At, B0); PG8_MMA(0, 1, At, B1); PG8_BAR; PG8_SCHED;
            PG8_LDA(At, 0, 1); PG8_STAGE(PG8_SB(0, 0), b2, voffB); PG8_STAGE(PG8_SB(0, 1), b2 + hstep, voffB); PG8_STAGE(PG8_SA(0, 0), a2, voffA);
            PG8_WAIT_V(8); PG8_WAIT_L(0); PG8_BAR; PG8_MMA(1, 0, At, B0); PG8_MMA(1, 1, At, B1); PG8_BAR; PG8_SCHED;
            PG8_LDB(B0, 1, 0); PG8_LDB(B1, 1, 1); PG8_SCHED; PG8_LDA(At, 1, 0); PG8_STAGE(PG8_SA(0, 1), a2 + hstep, voffA);
            PG8_WAIT_V(8); PG8_WAIT_L(0); PG8_BAR; PG8_MMA(0, 0, At, B0); PG8_MMA(0, 1, At, B1); PG8_BAR; PG8_SCHED;
            PG8_LDA(At, 1, 1); PG8_STAGE(PG8_SB(1, 0), b3, voffB); PG8_STAGE(PG8_SB(1, 1), b3 + hstep, voffB); PG8_STAGE(PG8_SA(1, 0), a3, voffA);
            PG8_WAIT_V(8); PG8_WAIT_L(0); PG8_BAR; PG8_MMA(1, 0, At, B0); PG8_MMA(1, 1, At, B1); PG8_BAR; PG8_SCHED;
            } else {
            PG8_LDB(B0, 0, 0); PG8_SCHED; PG8_LDA(At, 0, 0); PG8_STAGE(PG8_SA(1, 1), a1 + hstep, voffA);
            PG8_WAIT_L(8); PG8_BAR; PG8_WAIT_L(0); PG8_MMA(0, 0, At, B0); PG8_BAR; PG8_SCHED;
            PG8_LDB(B1, 0, 1); PG8_STAGE(PG8_SB(0, 0), b2, voffB);
            PG8_BAR; PG8_WAIT_L(0); PG8_MMA(0, 1, At, B1); PG8_BAR;
            PG8_LDA(At, 0, 1); PG8_STAGE(PG8_SA(0, 0), a2, voffA);
            PG8_BAR; PG8_WAIT_L(0); PG8_MMA(1, 0, At, B0); PG8_BAR; PG8_SCHED;
            PG8_STAGE(PG8_SB(0, 1), b2 + hstep, voffB);
            PG8_WAIT_V(6); PG8_BAR; PG8_MMA(1, 1, At, B1); PG8_BAR;
            PG8_LDB(B0, 1, 0); PG8_SCHED; PG8_LDA(At, 1, 0); PG8_STAGE(PG8_SA(0, 1), a2 + hstep, voffA);
            PG8_WAIT_L(8); PG8_BAR; PG8_WAIT_L(0); PG8_MMA(0, 0, At, B0); PG8_BAR; PG8_SCHED;
            PG8_LDB(B1, 1, 1); PG8_STAGE(PG8_SB(1, 0), b3, voffB);
            PG8_BAR; PG8_WAIT_L(0); PG8_MMA(0, 1, At, B1); PG8_BAR;
            PG8_LDA(At, 1, 1); PG8_STAGE(PG8_SA(1, 0), a3, voffA);
            PG8_BAR; PG8_WAIT_L(0); PG8_MMA(1, 0, At, B0); PG8_BAR; PG8_SCHED;
            PG8_STAGE(PG8_SB(1, 1), b3 + hstep, voffB);
            PG8_WAIT_V(6); PG8_BAR; PG8_MMA(1, 1, At, B1); PG8_BAR;
            }
        }
        if constexpr (ALIGN_EPI) { if (wr == 0) PG8_BAR; }
        if constexpr (!Epi::AFTER_DRAIN) { E(acc, cur, wr, wc, fr, fq); S.done(cur); }
        if (!has_next) break;
#pragma unroll
        for (int a = 0; a < 2; ++a)
#pragma unroll
            for (int b = 0; b < 2; ++b)
#pragma unroll
                for (int m = 0; m < 4; ++m)
#pragma unroll
                    for (int n = 0; n < 2; ++n) acc[a][b][m][n] = (f32x4){0.f, 0.f, 0.f, 0.f};
        cur = nxt; cA = nA; cB = nB; ++ui;
        if constexpr (ALIGN_EPI) { if (wr == 1) PG8_BAR; }
    }
    PG8_WAIT_V(0);
    if constexpr (!ALIGN_EPI) { if (wr == 0) PG8_BAR; }
    PG8_BAR;
    if constexpr (Epi::AFTER_DRAIN) { E.fused(acc, cur, wr, wc, fr, fq, lds, wid, lane); S.done(cur); }
#undef PG8_SA
#undef PG8_SB
#undef PG8_STAGE
#undef PG8_LDA
#undef PG8_LDB
#undef PG8_MMA
#undef PG8_WAIT_V
#undef PG8_WAIT_L
#undef PG8_BAR
#undef PG8_SCHED
}
}

#ifndef PG8_SP2
#define PG8_SP2 true
#endif
#ifndef PG8_ALIGN
#define PG8_ALIGN true
#endif
#include <hip/hip_bf16.h>
#include <cmath>
namespace attn_body {
using bf16=__hip_bfloat16;
using bf16x8=__attribute__((ext_vector_type(8)))short;
using s16x4=__attribute__((ext_vector_type(4)))short;
using f32x16=__attribute__((ext_vector_type(16)))float;
using u32x4=__attribute__((ext_vector_type(4)))unsigned;
using u32x2=__attribute__((ext_vector_type(2)))unsigned;
using f32x4v=__attribute__((ext_vector_type(4)))float;
constexpr int BATCH=8,NHEAD=8,SEQ=4096,D=64,DM=NHEAD*D,OPITCH=1024;
constexpr long QKV_BPAD=((long)SEQ*2816*2-(long)SEQ*DM*2)/2;
constexpr int NW=8,QBLK=32,QB=QBLK*NW,KVBLK=64,NQB=SEQ/QB;
constexpr int ATTN_PITCH=DM, ATTN_UNIT_ROWS=QB;
__device__ __forceinline__ int crow(int r,int hi){return (r&3)+8*(r>>2)+4*hi;}
#define SBAR() __builtin_amdgcn_sched_barrier(0)
__device__ __forceinline__ void cmask(f32x16&p0,f32x16&p1,int jb,int qrel,int hi){
  const float NEG=-INFINITY; int kb=64*jb+4*hi;
  #pragma unroll
  for(int r=0;r<16;++r){int kv=kb+(r&3)+8*(r>>2); if(kv>qrel)p0[r]=NEG; if(kv+32>qrel)p1[r]=NEG;}
}

constexpr int NSLOT=3, SLOTB=8192;
constexpr int LDS_K=0, LDS_V=NSLOT*SLOTB, LDS_WS=2*NSLOT*SLOTB, LDS_OST=LDS_WS+NW*64*4, LDS_BIAS=LDS_OST+NW*4096, LDS_RED=135168, LDS_BYTES=LDS_RED+1024;   static_assert(LDS_BIAS+SEQ*8<=LDS_RED,"attn lds");
constexpr float C2=0.125f*1.4426950408889634f;
__device__ __forceinline__ void glds16(const void*gsrc,unsigned lds_dst){unsigned keep;
  asm volatile("s_mov_b32 %0, m0\n\ts_mov_b32 m0, %2\n\ts_nop 0\n\tglobal_load_lds_dwordx4 %1, off\n\ts_mov_b32 m0, %0":"=&s"(keep):"v"(gsrc),"s"(lds_dst):"memory");}
__device__ __forceinline__ float max3f(float a,float b,float c){float r;asm("v_max3_f32 %0, %1, %2, %3":"=v"(r):"v"(a),"v"(b),"v"(c));return r;}
__device__ __forceinline__ float max2f(float a,float b){float r;asm("v_max_f32_e32 %0, %1, %2":"=v"(r):"v"(a),"v"(b));return r;}
__device__ __forceinline__ float fadd_s(float a,float b){float r;asm("v_add_f32_e32 %0, %1, %2":"=v"(r):"v"(a),"v"(b));return r;}
__device__ __forceinline__ float fsub_s(float a,float b){float r;asm("v_sub_f32_e32 %0, %1, %2":"=v"(r):"v"(a),"v"(b));return r;}
typedef float f32x2_t __attribute__((ext_vector_type(2))); typedef __bf16 bf16x2_t __attribute__((ext_vector_type(2)));
__device__ __forceinline__ unsigned cvtpk_s(float lo,float hi){f32x2_t v={lo,hi};bf16x2_t b=__builtin_convertvector(v,bf16x2_t);return __builtin_bit_cast(unsigned,b);}
#define WAIT_BAR(N) asm volatile("s_waitcnt vmcnt(" #N ") lgkmcnt(0)\n\ts_barrier":::"memory")

__device__ __forceinline__ void qkt(f32x16&p0,f32x16&p1,const char*Kslot,const bf16x8*qr,const f32x16&negm,int r32,int hi,bf16x8 kx0,bf16x8 kx1,bf16x8 qx){
  const char*kb=Kslot+hi*1024+r32*16;
  p0=__builtin_amdgcn_mfma_f32_32x32x16_bf16(kx0,qx,negm,0,0,0);p1=__builtin_amdgcn_mfma_f32_32x32x16_bf16(kx1,qx,negm,0,0,0);
  #pragma unroll
  for(int d0=0;d0<4;++d0){
    const bf16x8 b0=*reinterpret_cast<const bf16x8*>(kb+d0*2048);
    const bf16x8 b1=*reinterpret_cast<const bf16x8*>(kb+d0*2048+512);
    p0=__builtin_amdgcn_mfma_f32_32x32x16_bf16(b0,qr[d0],p0,0,0,0);p1=__builtin_amdgcn_mfma_f32_32x32x16_bf16(b1,qr[d0],p1,0,0,0);}
}
typedef __attribute__((address_space(3))) const char* lds_cptr;
typedef short v4i16_t __attribute__((ext_vector_type(4)));
__device__ __forceinline__ void kload8(bf16x8*kf,lds_cptr kp){
  kf[0]=*(const __attribute__((address_space(3))) bf16x8*)(kp);      kf[1]=*(const __attribute__((address_space(3))) bf16x8*)(kp+512);
  kf[2]=*(const __attribute__((address_space(3))) bf16x8*)(kp+2048); kf[3]=*(const __attribute__((address_space(3))) bf16x8*)(kp+2560);
  kf[4]=*(const __attribute__((address_space(3))) bf16x8*)(kp+4096); kf[5]=*(const __attribute__((address_space(3))) bf16x8*)(kp+4608);
  kf[6]=*(const __attribute__((address_space(3))) bf16x8*)(kp+6144); kf[7]=*(const __attribute__((address_space(3))) bf16x8*)(kp+6656);
}
__device__ __forceinline__ void kload2(bf16x8*kf,lds_cptr kp,int j){ kf[2*j]=*(const __attribute__((address_space(3))) bf16x8*)(kp+j*2048); kf[2*j+1]=*(const __attribute__((address_space(3))) bf16x8*)(kp+j*2048+512); }
__device__ __forceinline__ s16x4 vtr(lds_cptr p){ return __builtin_bit_cast(s16x4,__builtin_amdgcn_ds_read_tr16_b64_v4i16((__attribute__((address_space(3))) v4i16_t*)p)); }
__device__ __forceinline__ float rowmax(const f32x16&p0,const f32x16&p1){
  float a=max3f(p0[0],p0[1],p1[0]),b=max3f(p0[2],p0[3],p1[1]);a=max3f(a,p1[2],p1[3]);
  #pragma unroll
  for(int r=4;r<16;r+=4){a=max3f(a,p0[r],p0[r+1]);b=max3f(b,p0[r+2],p0[r+3]);a=max3f(a,p1[r],p1[r+1]);b=max3f(b,p1[r+2],p1[r+3]);}
  const float m=max2f(a,b);
  auto rr=__builtin_amdgcn_permlane32_swap(__float_as_uint(m),__float_as_uint(m),false,false);
  return max2f(__uint_as_float(rr[0]),__uint_as_float(rr[1]));
}
__device__ __forceinline__ void pv(f32x16*o,int vb,bf16x8 pa0,bf16x8 pa1,bf16x8 pa2,bf16x8 pa3){
  #pragma unroll
  for(int d0=0;d0<2;++d0){s16x4 lo[4],hi[4];
    #pragma unroll
    for(int ks=0;ks<4;++ks){
      asm volatile("ds_read_b64_tr_b16 %0,%1 offset:%c2":"=&v"(lo[ks]):"v"(vb),"i"(d0*4096+ks*1024):"memory");
      asm volatile("ds_read_b64_tr_b16 %0,%1 offset:%c2":"=&v"(hi[ks]):"v"(vb),"i"(d0*4096+ks*1024+512):"memory");}
    asm volatile("s_waitcnt lgkmcnt(0)":::"memory");SBAR();
    #define PK(k) (bf16x8){lo[k][0],lo[k][1],lo[k][2],lo[k][3],hi[k][0],hi[k][1],hi[k][2],hi[k][3]}
    o[d0]=__builtin_amdgcn_mfma_f32_32x32x16_bf16(pa0,PK(0),o[d0],0,0,0);
    o[d0]=__builtin_amdgcn_mfma_f32_32x32x16_bf16(pa1,PK(1),o[d0],0,0,0);
    o[d0]=__builtin_amdgcn_mfma_f32_32x32x16_bf16(pa2,PK(2),o[d0],0,0,0);
    o[d0]=__builtin_amdgcn_mfma_f32_32x32x16_bf16(pa3,PK(3),o[d0],0,0,0);
    #undef PK
  }
}

#ifndef ATTN_STORE16
#define ATTN_STORE16(p,v) (*(u32x4*)(p)=(v))
#endif
template<int THRL> __device__ __forceinline__ void attn_unit(int b,int h,int qb,const bf16*Q,const bf16*__restrict__ K,const bf16*__restrict__ V,bf16*O,float bound,int ui,const float*__restrict__ cumh,float*ssb,char*shm){
  const int tid=otid(),lane=tid&63,r32=lane&31,hi=lane>>5; const int wid=__builtin_amdgcn_readfirstlane(tid>>6);
  const long rowbase=(long)b*SEQ; const int q0=qb*QB;
  const bf16*Qw=Q+(long)b*QKV_BPAD+(rowbase+q0+wid*QBLK)*DM+h*D;
  const bf16*Kh=K+(long)b*QKV_BPAD+rowbase*DM+h*D,*Vh=V+(long)b*QKV_BPAD+rowbase*DM+h*D;
  const lds_cptr shm3=(lds_cptr)shm;
  const unsigned lds0=(unsigned)(uintptr_t)shm;
  float*wsf=(float*)(shm+LDS_WS)+wid*64;
  const bf16*ksrc0=Kh+(long)lane*DM+wid*8;
  const bf16*vsrc0=Vh+(long)(16*(wid&3)+(lane>>2))*DM+(wid>>2)*32+(lane&3)*8;
  const unsigned kdst=lds0+LDS_K+wid*1024, vdst=lds0+LDS_V+wid*1024;
  #define DMA_K(t,slot) glds16(ksrc+(long)(t)*KVBLK*DM,(unsigned)__builtin_amdgcn_readfirstlane(kdst+(slot)))
  #define DMA_V(t,slot) glds16(vsrc+(long)(t)*KVBLK*DM,(unsigned)__builtin_amdgcn_readfirstlane(vdst+(slot)))
  const int vb0=(int)(lds0+LDS_V)+((lane>>4)&1)*32+(lane&3)*8+(4*hi+((lane&15)>>2))*64;
  const char*Kbase=shm+LDS_K; bf16x8 kf[8];
  const lds_cptr kp0=shm3+LDS_K+hi*1024+r32*16; const lds_cptr vp0=shm3+LDS_V+((lane>>4)&1)*32+(lane&3)*8+(4*hi+((lane&15)>>2))*64;
  int NT=(q0+QB)/KVBLK;
  int ts;
  { __attribute__((address_space(3))) float*red=(__attribute__((address_space(3))) float*)(shm3+LDS_RED);
    const float cref=cumh[q0]; int cnt=0; const int nk=q0+QB;
    float cv[SEQ/(NW*64)];
    #pragma unroll
    for(int k=0;k<SEQ/(NW*64);++k){ const int i=tid+k*NW*64; cv[k]=(i<nk)?cumh[i]:0.f; }
    #pragma unroll
    for(int k=0;k<SEQ/(NW*64);++k){ const int i=tid+k*NW*64; if(i<nk){ const float x=cref-cv[k]; cnt+=(x<=-bound)?1:0; const unsigned u1=__float_as_uint(x)&0xffff0000u; const float r1=x-__uint_as_float(u1);
      const unsigned u2=__float_as_uint(r1)&0xffff0000u; const float r2=r1-__uint_as_float(u2); const unsigned u3=__float_as_uint(r2)&0xffff0000u;
      u32x2 w; w.x=(u1>>16)|u2; w.y=u3>>16; *(__attribute__((address_space(3))) u32x2*)(shm3+LDS_BIAS+i*8)=w; } }
    #pragma unroll
    for(int o=1;o<64;o<<=1)cnt+=__shfl_xor(cnt,o);
    if(lane==0)red[64+ui*8+wid]=(float)cnt;
    asm volatile("s_waitcnt lgkmcnt(0)\n\ts_barrier":::"memory");
    float tot=0.f;
    #pragma unroll
    for(int w=0;w<NW;++w)tot+=red[64+ui*8+w];
    ts=((int)tot>>6)&~1; if(ts>NT-4)ts=NT-4;
    ts=__builtin_amdgcn_readfirstlane(ts); }
  const bf16*ksrc=ksrc0+(long)ts*KVBLK*DM; const bf16*vsrc=vsrc0+(long)ts*KVBLK*DM; NT-=ts;
  const lds_cptr bp0=shm3+LDS_BIAS+r32*8+ts*512;
  bf16x8 qx; { const u32x4 t=(hi==0)?(u32x4){0x3F803F80u,0x00003F80u,0u,0u}:(u32x4){0u,0u,0u,0u}; qx=__builtin_bit_cast(bf16x8,t); }
  #define BIASLD(t,which) ({ const u32x2 w_=*(const __attribute__((address_space(3))) u32x2*)(bp0+(t)*512+(which)*256); const u32x4 t_=(u32x4){w_.x,w_.y,0u,0u}; __builtin_bit_cast(bf16x8,t_); })
  DMA_K(0,0);DMA_V(0,0);DMA_K(1,SLOTB);
  bf16x8 qr[4];
  #pragma unroll
  for(int d0=0;d0<4;++d0)qr[d0]=*reinterpret_cast<const bf16x8*>(&Qw[(long)r32*DM+d0*16+hi*8]);
  float mhat=0.f,l_reg=0.f;f32x16 o[2];o[0]=f32x16{};o[1]=f32x16{};f32x16 negm=f32x16{};asm volatile("":"+v"(negm));
  const int qrel=wid*QBLK+r32;
  #define CMASK(P0,P1,t) do{int jb_=(t)-(NT-4); if(jb_>=0)cmask(P0,P1,jb_,qrel,hi);}while(0)
  bool resc=false;
  #define START(P0,P1) do{ const float rm=rowmax(P0,P1); resc=false; \
    { const float dl=rm; mhat=fadd_s(mhat,dl); \
      _Pragma("unroll") for(int r=0;r<16;++r){P0[r]=fsub_s(P0[r],dl);P1[r]=fsub_s(P1[r],dl);} \
      _Pragma("unroll") for(int r=0;r<16;++r)negm[r]=-mhat; asm volatile("":"+v"(negm)); } \
    _Pragma("unroll") for(int r=0;r<16;++r)P0[r]=__builtin_amdgcn_exp2f(P0[r]); }while(0)
  #define RESC() do{ if(resc){ asm volatile("s_waitcnt lgkmcnt(0)":::"memory"); \
      _Pragma("unroll") for(int d_=0;d_<2;++d_) _Pragma("unroll") for(int r=0;r<16;++r)o[d_][r]*=wsf[crow(r,hi)]; } }while(0)
  f32x16 pA0,pA1,pB0,pB1;
  int sl_prev=0,sl_cur=0,sl_next=SLOTB;
  #define ROT() do{sl_prev=sl_cur;sl_cur=sl_next;sl_next=(sl_next==(NSLOT-1)*SLOTB)?0:sl_next+SLOTB;}while(0)
  DMA_K(2,2*SLOTB);
  WAIT_BAR(3);
  qkt(pA0,pA1,Kbase,qr,negm,r32,hi,BIASLD(0,0),BIASLD(0,1),qx);asm volatile("s_nop 15\n\ts_nop 7":"+v"(pA0),"+v"(pA1));CMASK(pA0,pA1,0);
  START(pA0,pA1);
  _Pragma("unroll") for(int r=0;r<16;++r)pA1[r]=__builtin_amdgcn_exp2f(pA1[r]);
  WAIT_BAR(0);
  DMA_K(3,0);DMA_V(1,SLOTB);
  ROT();
  kload8(kf,kp0+sl_cur);
  WAIT_BAR(2);
  s16x4 vlo[8],vhi[8]; u32x4 pw0,pw1,pw2,pw3;
  #define PKW(P,B) cvtpk_s(P[B],P[B+1])
  #define PAF(k) __builtin_bit_cast(bf16x8,pw##k)
  #define VFR(i) (bf16x8){vlo[i][0],vlo[i][1],vlo[i][2],vlo[i][3],vhi[i][0],vhi[i][1],vhi[i][2],vhi[i][3]}
  #define PIN(x) asm volatile("":"+v"(x))
  #define MX3(a,b,c) __builtin_fmaxf(__builtin_fmaxf((a),(b)),(c))
  #define GAPA(MF,A0,A1,A2,A3,W0,W1,PW) do{ MF; sacc+=A0; sacc+=A1; sacc+=A2; sacc+=A3; PIN(sacc); W0; W1; PIN(PW); SBAR(); }while(0)
  #define EX(v) __builtin_amdgcn_exp2f(v)
  #define GAPB(MF,X,B) do{ MF; X[B]=EX(X[B]); X[B+1]=EX(X[B+1]); X[B+2]=EX(X[B+2]); X[B+3]=EX(X[B+3]); PIN(X); SBAR(); }while(0)
  #define VRD(i) do{ vlo[i]=vtr(vp_+(((i)>>2)*4096+((i)&3)*1024)); vhi[i]=vtr(vp_+(((i)>>2)*4096+((i)&3)*1024+512)); }while(0)
  #define KRD(G,j) do{ if(G){ kload2(kf,kp0+sl_next,j); SBAR(); } }while(0)
  #define STEP(C0,C1,P0,P1,t,GK,GV,GL) do{ SBAR(); \
    const lds_cptr vp_=vp0+sl_prev; \
    C0=__builtin_amdgcn_mfma_f32_32x32x16_bf16(kbx0,qx,negm,0,0,0); C1=__builtin_amdgcn_mfma_f32_32x32x16_bf16(kbx1,qx,negm,0,0,0); SBAR(); \
    VRD(0); SBAR(); float sacc=(P0[0]+P0[1]); \
    GAPA(C0=__builtin_amdgcn_mfma_f32_32x32x16_bf16(kf[0],qr[0],C0,0,0,0), P0[2],P0[3],P0[4],P0[5],     pw0[0]=PKW(P0,0), pw0[1]=PKW(P0,2), pw0); \
    VRD(4); SBAR(); GAPA(C1=__builtin_amdgcn_mfma_f32_32x32x16_bf16(kf[1],qr[0],C1,0,0,0), P0[6],P0[7],P0[8],P0[9],     pw0[2]=PKW(P0,4), pw0[3]=PKW(P0,6), pw0); \
    VRD(1); SBAR(); GAPA(C0=__builtin_amdgcn_mfma_f32_32x32x16_bf16(kf[2],qr[1],C0,0,0,0),   P0[10],P0[11],P0[12],P0[13], pw1[0]=PKW(P0,8), pw1[1]=PKW(P0,10), pw1); \
    VRD(5); SBAR(); GAPA(C1=__builtin_amdgcn_mfma_f32_32x32x16_bf16(kf[3],qr[1],C1,0,0,0),   P0[14],P0[15],P1[0],P1[1],   pw1[2]=PKW(P0,12),pw1[3]=PKW(P0,14), pw1); \
    VRD(2); SBAR(); GAPA(C0=__builtin_amdgcn_mfma_f32_32x32x16_bf16(kf[4],qr[2],C0,0,0,0),   P1[2],P1[3],P1[4],P1[5],     pw2[0]=PKW(P1,0), pw2[1]=PKW(P1,2), pw2); \
    VRD(6); SBAR(); GAPA(C1=__builtin_amdgcn_mfma_f32_32x32x16_bf16(kf[5],qr[2],C1,0,0,0),   P1[6],P1[7],P1[8],P1[9],     pw2[2]=PKW(P1,4), pw2[3]=PKW(P1,6), pw2); \
    VRD(3); SBAR(); GAPA(C0=__builtin_amdgcn_mfma_f32_32x32x16_bf16(kf[6],qr[3],C0,0,0,0),   P1[10],P1[11],P1[12],P1[13], pw3[0]=PKW(P1,8), pw3[1]=PKW(P1,10), pw3); \
    VRD(7); SBAR(); GAPA(C1=__builtin_amdgcn_mfma_f32_32x32x16_bf16(kf[7],qr[3],C1,0,0,0),   P1[14],P1[15],0.f,0.f,       pw3[2]=PKW(P1,12),pw3[3]=PKW(P1,14), pw3); \
    l_reg+=sacc; \
    if(GK){DMA_K((t)+3,sl_cur);} if(GV){DMA_V((t)+1,sl_next);} \
    CMASK(C0,C1,t); \
    { float a=MX3(C0[0],C0[1],C1[0]),b=MX3(C0[2],C0[3],C1[1]); a=MX3(a,C1[2],C1[3]); \
      _Pragma("unroll") for(int r=4;r<16;r+=4){a=MX3(a,C0[r],C0[r+1]);b=MX3(b,C0[r+2],C0[r+3]);a=MX3(a,C1[r],C1[r+1]);b=MX3(b,C1[r+2],C1[r+3]);} \
      float rm=__builtin_fmaxf(a,b); { auto rr=__builtin_amdgcn_permlane32_swap(__float_as_uint(rm),__float_as_uint(rm),false,false); rm=__builtin_fmaxf(__uint_as_float(rr[0]),__uint_as_float(rr[1])); } \
      resc=false; \
      if(__builtin_expect(__any(rm>(float)THRL),0)){ const float dl=__builtin_fmaxf(rm,0.f); mhat+=dl; \
        _Pragma("unroll") for(int r=0;r<16;++r){C0[r]-=dl;C1[r]-=dl;} \
        _Pragma("unroll") for(int r=0;r<16;++r)negm[r]=-mhat; asm volatile("":"+v"(negm)); \
        const float f=__builtin_amdgcn_exp2f(-dl); l_reg*=f; if(hi==0)wsf[r32]=f; resc=true; } } \
    SBAR(); \
    GAPB(o[0]=__builtin_amdgcn_mfma_f32_32x32x16_bf16(PAF(0),VFR(0),o[0],0,0,0), C0,0); \
    GAPB(o[1]=__builtin_amdgcn_mfma_f32_32x32x16_bf16(PAF(0),VFR(4),o[1],0,0,0), C0,4); \
    KRD(GL,0); GAPB(o[0]=__builtin_amdgcn_mfma_f32_32x32x16_bf16(PAF(1),VFR(1),o[0],0,0,0), C0,8); \
    KRD(GL,1); GAPB(o[1]=__builtin_amdgcn_mfma_f32_32x32x16_bf16(PAF(1),VFR(5),o[1],0,0,0), C0,12); \
    KRD(GL,2); GAPB(o[0]=__builtin_amdgcn_mfma_f32_32x32x16_bf16(PAF(2),VFR(2),o[0],0,0,0), C1,0); \
    KRD(GL,3); GAPB(o[1]=__builtin_amdgcn_mfma_f32_32x32x16_bf16(PAF(2),VFR(6),o[1],0,0,0), C1,4); \
    GAPB(o[0]=__builtin_amdgcn_mfma_f32_32x32x16_bf16(PAF(3),VFR(3),o[0],0,0,0), C1,8); \
    GAPB(o[1]=__builtin_amdgcn_mfma_f32_32x32x16_bf16(PAF(3),VFR(7),o[1],0,0,0), C1,12); \
    if(GL){ kbx0=BIASLD((t)+1,0); kbx1=BIASLD((t)+1,1); } \
    }while(0)
  int t=1; bf16x8 kbx0=BIASLD(1,0),kbx1=BIASLD(1,1);
  #undef CMASK
  #define CMASK(P0,P1,t) do{}while(0)
  for(;t+5<NT;t+=2){
    STEP(pB0,pB1,pA0,pA1,t,true,true,true);     WAIT_BAR(2); RESC(); ROT();
    STEP(pA0,pA1,pB0,pB1,t+1,true,true,true);   WAIT_BAR(2); RESC(); ROT();
  }
  #undef CMASK
  #define CMASK(P0,P1,t) do{int jb_=(t)-(NT-4); if(jb_>=0)cmask(P0,P1,jb_,qrel,hi);}while(0)
  #define ENDW(tt) do{ if((tt)+3<NT){WAIT_BAR(2);} else if((tt)+2<NT){WAIT_BAR(1);} else {WAIT_BAR(0);} }while(0)
  for(;t+1<NT;t+=2){
    STEP(pB0,pB1,pA0,pA1,t,(t+3<NT),(t+1<NT),(t+1<NT));       ENDW(t);   RESC(); ROT();
    STEP(pA0,pA1,pB0,pB1,t+1,(t+4<NT),(t+2<NT),(t+2<NT));     ENDW(t+1); RESC(); ROT();
  }
  STEP(pB0,pB1,pA0,pA1,NT-1,false,false,false); RESC();
  { float sacc=pB0[0]+pB0[1]; _Pragma("unroll") for(int r=2;r<16;++r)sacc+=pB0[r]; _Pragma("unroll") for(int r=0;r<16;++r)sacc+=pB1[r]; l_reg+=sacc;
    pw0=(u32x4){PKW(pB0,0),PKW(pB0,2),PKW(pB0,4),PKW(pB0,6)};pw1=(u32x4){PKW(pB0,8),PKW(pB0,10),PKW(pB0,12),PKW(pB0,14)};pw2=(u32x4){PKW(pB1,0),PKW(pB1,2),PKW(pB1,4),PKW(pB1,6)};pw3=(u32x4){PKW(pB1,8),PKW(pB1,10),PKW(pB1,12),PKW(pB1,14)};
    SBAR(); pv(o,vb0+sl_cur,PAF(0),PAF(1),PAF(2),PAF(3)); }
  #undef PKW
  #undef PAF
  #undef VFR
  #undef PIN
  #undef MX3
  #undef GAPA
  #undef GAPB
  #undef EX
  #undef VRD
  #undef KRD
  #undef STEP
  #undef ENDW
  {auto rr=__builtin_amdgcn_permlane32_swap(__float_as_uint(l_reg),__float_as_uint(l_reg),false,false);l_reg=__uint_as_float(rr[0])+__uint_as_float(rr[1]);}
  if(hi==0)wsf[32+r32]=l_reg;asm volatile("s_waitcnt lgkmcnt(0)":::"memory");
  float rli[16];
  #pragma unroll
  for(int r=0;r<16;++r)rli[r]=__builtin_amdgcn_rcpf(wsf[32+crow(r,hi)]);
  bf16*Ow=O+(rowbase+q0+wid*QBLK)*OPITCH+h*D; float*ssw=ssb+(long)h*(BATCH*SEQ)+rowbase+q0+wid*QBLK;
  { bf16*stg=(bf16*)(shm+LDS_OST)+wid*2048;
    #pragma unroll
    for(int r=0;r<16;++r){const int orow=crow(r,hi);
      #pragma unroll
      for(int d0=0;d0<2;++d0)stg[orow*64+d0*32+r32]=__float2bfloat16(o[d0][r]*rli[r]);}
    asm volatile("s_waitcnt lgkmcnt(0)":::"memory");
    #pragma unroll
    for(int i=0;i<4;++i){const int row=i*8+(lane>>3),ch=lane&7; const u32x4 v=*(const u32x4*)(stg+row*64+ch*8); ATTN_STORE16(Ow+(long)row*OPITCH+ch*8,v);
      float q=0.f;
      #pragma unroll
      for(int e=0;e<4;++e){const float lo=__uint_as_float(v[e]<<16),hi2=__uint_as_float(v[e]&0xffff0000u); q+=lo*lo+hi2*hi2;}
      q+=__shfl_xor(q,1);q+=__shfl_xor(q,2);q+=__shfl_xor(q,4); if(ch==0)ssw[row]=q;} }
  asm volatile("s_waitcnt lgkmcnt(0)\n\ts_barrier":::"memory");
  #undef DMA_K
  #undef DMA_V
  #undef BIASLD
  #undef CMASK
  #undef START
  #undef RESC
  #undef ROT
}
constexpr int ATTN_LDS_BYTES=LDS_BYTES;
struct AttnTensors { const bf16* Q; const bf16* K; const bf16* V; bf16* O; const float* cum2; float* ssb; float* kpart; };
struct AttnUnit { int bh; int qb; };
struct StaticOrder {
  int vcu;
  __device__ __forceinline__ explicit StaticOrder(int grid,int block):vcu((block%8)*(grid/8)+block/8){}
  __device__ __forceinline__ bool next(int i,AttnUnit&u)const{ if(i>=4||vcu>=256)return false; const int s=(vcu>>3)&3,h0=vcu&7; u.bh=(vcu>>5)*NHEAD+((h0+2*i)&7); u.qb=(i==0)?s:(i==1)?7-s:(i==2)?8+s:15-s; return true; }
  __device__ __forceinline__ void a_ready(const AttnUnit&)const{}
  __device__ __forceinline__ void done(const AttnUnit&)const{}
};
template<class Sched> __device__ __forceinline__ void attn_pre(char*lds,const AttnTensors&T,const Sched&S){
  AttnUnit u;
  if(!S.next(0,u))return;
  const int tid=otid(),lane=tid&63; const int wid=__builtin_amdgcn_readfirstlane(tid>>6); const int b=u.bh/NHEAD;
  typedef __attribute__((address_space(3))) float ldsf;
  ldsf*red=(ldsf*)((lds_cptr)lds+LDS_RED);
  { const int hk=S.vcu&7,sk=(S.vcu>>3)&3; float mx=0.f; const bf16*Kh=T.K+(long)b*QKV_BPAD+((long)b*SEQ+sk*(SEQ/4))*DM+hk*D;
    for(int r=tid;r<SEQ/4;r+=NW*64){ const u32x4*pr=(const u32x4*)(Kh+(long)r*DM); float q=0.f;
      #pragma unroll
      for(int c=0;c<8;++c){ const u32x4 v=pr[c];
        #pragma unroll
        for(int e=0;e<4;++e){ const float lo=__uint_as_float(v[e]<<16),hi2=__uint_as_float(v[e]&0xffff0000u); q+=lo*lo+hi2*hi2; } }
      mx=fmaxf(mx,q); }
    #pragma unroll
    for(int o=1;o<64;o<<=1)mx=fmaxf(mx,__shfl_xor(mx,o));
    if(lane==0)red[wid]=mx;
    __syncthreads();
    if(tid==0){ float m=0.f;
      #pragma unroll
      for(int w=0;w<NW;++w)m=fmaxf(m,red[w]);
      T.kpart[(b*NHEAD+hk)*4+sk]=m; } }
  for(int ui=0;ui<4;++ui){ AttnUnit uu; if(!S.next(ui,uu))break; const int h=uu.bh%NHEAD;
    const long row=(long)b*SEQ+uu.qb*QB+(tid>>1);
    const u32x4*pr=(const u32x4*)(T.Q+(long)b*QKV_BPAD+row*DM+h*D+(tid&1)*32); const u32x4*pk=(const u32x4*)(T.K+(long)b*QKV_BPAD+row*DM+h*D+(tid&1)*32); float q=0.f,dg=0.f;
    #pragma unroll
    for(int c=0;c<4;++c){ const u32x4 v=pr[c],kv=pk[c];
      #pragma unroll
      for(int e=0;e<4;++e){ const float lo=__uint_as_float(v[e]<<16),hi2=__uint_as_float(v[e]&0xffff0000u); q+=lo*lo+hi2*hi2;
        dg+=lo*__uint_as_float(kv[e]<<16)+hi2*__uint_as_float(kv[e]&0xffff0000u); } }
    q+=__shfl_xor(q,1); dg+=__shfl_xor(dg,1);
    dg+=T.cum2[(long)uu.bh*SEQ+uu.qb*QB]-T.cum2[(long)uu.bh*SEQ+uu.qb*QB+(tid>>1)];
    #pragma unroll
    for(int o=2;o<64;o<<=1){q=fmaxf(q,__shfl_xor(q,o));dg=fminf(dg,__shfl_xor(dg,o));}
    if(lane==0){red[8+ui*8+wid]=q;red[96+ui*8+wid]=dg;} }
  __syncthreads();
}
template<class Sched,int THRL=24> __device__ __forceinline__ void attn_run(char*lds,const AttnTensors&T,const Sched&S){
  AttnUnit u;
  for(int i=0;S.next(i,u);++i){ S.a_ready(u);
    float bound;
    { typedef __attribute__((address_space(3))) float ldsf; const ldsf*red=(const ldsf*)((lds_cptr)lds+LDS_RED); float q2=0.f,dmin=3.0e38f;
      const float*kp=T.kpart+u.bh*4; const float k2=fmaxf(fmaxf(kp[0],kp[1]),fmaxf(kp[2],kp[3]));
      #pragma unroll
      for(int w=0;w<NW;++w){q2=fmaxf(q2,red[8+i*8+w]);dmin=fminf(dmin,red[96+i*8+w]);}
      const float qk=sqrtf(k2*q2)*1.001f;
      bound=qk+32.0f+0.05f-fmaxf(fminf(dmin,0.f),-qk); }
    attn_unit<THRL>(u.bh/NHEAD,u.bh%NHEAD,u.qb,T.Q,T.K,T.V,T.O,bound,i,T.cum2+(long)u.bh*SEQ,T.ssb,lds); S.done(u); }
}
#undef SBAR
#undef WAIT_BAR
}
constexpr int NWAVES = 8;
constexpr int BATCH = 8, SEQ = 4096, DM_ = 1024, DFF = 2816, NIN = 2568, DA = 512, HA = 8, HB = 8;
constexpr int M = BATCH * SEQ;
constexpr float EPS = 1e-6f;
constexpr size_t MiB = 1u << 20;
constexpr size_t WS_MOD = 0;
constexpr size_t WS_LOGF = 1 * MiB;
constexpr size_t WS_CUM = 2 * MiB;
constexpr size_t WS_SS = 3 * MiB;
constexpr size_t WS_SSA = 5 * MiB;
constexpr size_t WS_SSB = 6 * MiB;
constexpr size_t WS_WGU0 = 8 * MiB;
constexpr size_t WS_WGU1 = 20 * MiB;
constexpr size_t WS_WD0 = 32 * MiB;
constexpr size_t WS_WD1 = 38 * MiB;
constexpr size_t WS_WIN = 44 * MiB;
constexpr size_t WS_WOUT = 50 * MiB;
constexpr size_t WS_H = 64 * MiB;
constexpr size_t WS_HD = 128 * MiB;
constexpr size_t WS_ACT = 192 * MiB;
constexpr size_t BSLAB = (size_t)SEQ * DFF * 2;
constexpr size_t WS_ZG = WS_ACT;
constexpr size_t WS_Q = WS_ACT + 8 * MiB, WS_K = WS_ACT + 12 * MiB, WS_V = WS_ACT + 16 * MiB;
constexpr size_t PAD_ZG = (BSLAB - (size_t)SEQ * 1024 * 2) / 2, PAD_QKV = (BSLAB - (size_t)SEQ * 512 * 2) / 2;
static_assert(BSLAB == 22 * MiB && 8 * MiB + 3 * (size_t)SEQ * 512 * 2 <= BSLAB, "slab map");
constexpr size_t WS_Y = WS_H;
constexpr size_t WS_X1 = 416 * MiB;
constexpr size_t WS_END = 480 * MiB;
static_assert(WS_ACT + (size_t)M * DFF * 2 <= 416 * MiB && WS_X1 + (size_t)M * 1024 * 2 <= WS_END, "ws map");
constexpr int LDS_BYTES = 147456;
constexpr int LDS_BARST = LDS_BYTES - 64;
constexpr size_t WS_KPART = 7 * MiB + 65536;
constexpr size_t WS_CTL = 7 * MiB, CTL_BYTES = 16384;

#define GAS __attribute__((address_space(1)))
#define LAS __attribute__((address_space(3)))
typedef unsigned short bf16;
typedef unsigned v4u __attribute__((ext_vector_type(4)));
typedef unsigned v2u __attribute__((ext_vector_type(2)));
typedef float f32x4 __attribute__((ext_vector_type(4)));
typedef short bf16x8 __attribute__((ext_vector_type(8)));
#define LDS_WAIT() asm volatile("s_waitcnt lgkmcnt(0)" ::: "memory")
__device__ __forceinline__ unsigned f2bf(float f) { unsigned u = __builtin_bit_cast(unsigned, f); return (u + 0x7fffu + ((u >> 16) & 1u)) >> 16; }
typedef float pk_f32x2 __attribute__((ext_vector_type(2))); typedef __bf16 pk_bf16x2 __attribute__((ext_vector_type(2)));
__device__ __forceinline__ unsigned pk2(float lo, float hi) { const pk_f32x2 v = {lo, hi}; return __builtin_bit_cast(unsigned, __builtin_convertvector(v, pk_bf16x2)); }
__device__ __forceinline__ float bf_lo(unsigned w) { return __builtin_bit_cast(float, w << 16); }
__device__ __forceinline__ float bf_hi(unsigned w) { return __builtin_bit_cast(float, w & 0xffff0000u); }
template <int CTRL> __device__ __forceinline__ float dpp_f(float v) { return __builtin_bit_cast(float, __builtin_amdgcn_update_dpp(0, __builtin_bit_cast(int, v), CTRL, 0xF, 0xF, false)); }
__device__ __forceinline__ float wave_sum(float v) {
    v += dpp_f<0xB1>(v); v += dpp_f<0x4E>(v); v += dpp_f<0x141>(v); v += dpp_f<0x140>(v);
    const float r0 = __builtin_bit_cast(float, __builtin_amdgcn_readlane(__builtin_bit_cast(int, v), 0)), r1 = __builtin_bit_cast(float, __builtin_amdgcn_readlane(__builtin_bit_cast(int, v), 16));
    const float r2 = __builtin_bit_cast(float, __builtin_amdgcn_readlane(__builtin_bit_cast(int, v), 32)), r3 = __builtin_bit_cast(float, __builtin_amdgcn_readlane(__builtin_bit_cast(int, v), 48));
    return (r0 + r1) + (r2 + r3);
}

#define XB_TMO      128
#define XB_XCNT(j)  (256  + 64 * (j))
#define XB_XSUB(j)  (1280 + 64 * (j))
#define XB_XGEN(j)  (2304 + 64 * (j))
#define XB_TOP      3328
#define XB_TOPGEN   3392
#define XCD_BAR_WORDS 3456
#define XB_SPIN_CAP (1u << 18)

__device__ __forceinline__ unsigned xb_ld(unsigned* p)              { return __hip_atomic_load(p, __ATOMIC_RELAXED, __HIP_MEMORY_SCOPE_AGENT); }
__device__ __forceinline__ unsigned xb_add(unsigned* p, unsigned v) { return __hip_atomic_fetch_add(p, v, __ATOMIC_RELAXED, __HIP_MEMORY_SCOPE_AGENT); }
__device__ __forceinline__ unsigned xb_xcc_id() { return (unsigned)__builtin_amdgcn_s_getreg((3 << 11) | 20) & 0xFu; }
#define XB_SPIN(cond, bar) do { unsigned _sp = 0; while (cond) { __builtin_amdgcn_s_sleep(1); \
    if ((++_sp & 255u) == 0u) { if (xb_ld(&(bar)[XB_TMO])) break; if (_sp > XB_SPIN_CAP) { atomicAdd(&(bar)[XB_TMO], 1u); break; } } } } while (0)

struct XcdBarrier {
    unsigned* bar; unsigned x;
    volatile LAS unsigned* st;
};

__device__ __forceinline__ XcdBarrier xcd_barrier_post(unsigned* bar, volatile LAS unsigned* st) {
    XcdBarrier b; b.bar = bar; b.x = xb_xcc_id(); b.st = st;
    if (threadIdx.x == 0) st[3] = xb_add(&bar[XB_XCNT(b.x)], 1u);
    return b;
}
__device__ __forceinline__ void xcd_barrier_complete(unsigned* bar, unsigned x, unsigned& nloc, unsigned& nx) {
    const unsigned G = gridDim.x * gridDim.y * gridDim.z;
    unsigned sum, cnt, mine, sp = 0u;
    for (;;) {
        sum = 0u; cnt = 0u; mine = 0u;
#pragma unroll
        for (unsigned j = 0; j < 16; ++j) { const unsigned c = xb_ld(&bar[XB_XCNT(j)]); sum += c; cnt += (c > 0u) ? 1u : 0u; mine = (j == x) ? c : mine; }
        if (sum == G) break;
        __builtin_amdgcn_s_sleep(1);
        if ((++sp & 255u) == 0u) { if (xb_ld(&bar[XB_TMO])) break; if (sp > XB_SPIN_CAP) { atomicAdd(&bar[XB_TMO], 1u); break; } }
    }
    nloc = mine > 0u ? mine : 1u; nx = cnt > 0u ? cnt : 1u;
}
__device__ __forceinline__ unsigned xcd_census_uniform(unsigned* bar) {
    unsigned ok = (gridDim.x == 256u) ? 1u : 0u;
#pragma unroll
    for (unsigned j = 0; j < 16; ++j) { const unsigned c = xb_ld(&bar[XB_XCNT(j)]); ok &= (c == (j < 8u ? 32u : 0u)) ? 1u : 0u; }
    return ok;
}

__device__ __forceinline__ void xcd_barrier(const XcdBarrier& b) {
    asm volatile("s_waitcnt vmcnt(0)" ::: "memory");
    __syncthreads();
    if (threadIdx.x == 0) {
        unsigned* bar = b.bar;
        __builtin_amdgcn_s_waitcnt(0);
        unsigned nloc = b.st[0], nx = b.st[1];
        if (nloc == 0u) { xcd_barrier_complete(bar, b.x, nloc, nx); b.st[0] = nloc; b.st[1] = nx; b.st[2] = xcd_census_uniform(bar); }
        const unsigned old = xb_add(&bar[XB_XSUB(b.x)], 1u);
        const unsigned gen = old / nloc;
        if (old + 1u == (gen + 1u) * nloc) {
            __builtin_amdgcn_fence(__ATOMIC_RELEASE, "agent");
            asm volatile("s_waitcnt vmcnt(0)" ::: "memory");
            const unsigned og = xb_add(&bar[XB_TOP], 1u);
            const unsigned tg = og / nx;
            if (og + 1u == (tg + 1u) * nx) xb_add(&bar[XB_TOPGEN], 1u);
            else XB_SPIN(xb_ld(&bar[XB_TOPGEN]) == tg, bar);
            __builtin_amdgcn_fence(__ATOMIC_ACQUIRE, "agent");
            xb_add(&bar[XB_XGEN(b.x)], 1u);
            asm volatile("s_waitcnt vmcnt(0)" ::: "memory");
        } else {
            XB_SPIN(xb_ld(&bar[XB_XGEN(b.x)]) == gen, bar);
            __builtin_amdgcn_fence(__ATOMIC_ACQUIRE, "agent");
            asm volatile("s_waitcnt vmcnt(0)" ::: "memory");
        }
    }
    __syncthreads();
}

__device__ __forceinline__ void xcd_local_barrier(const XcdBarrier& b) {
    asm volatile("s_waitcnt vmcnt(0)" ::: "memory");
    __syncthreads();
    if (threadIdx.x == 0) {
        unsigned* bar = b.bar;
        __builtin_amdgcn_s_waitcnt(0);
        const unsigned nloc = b.st[0];
        const unsigned old = xb_add(&bar[XB_XSUB(b.x)], 1u);
        const unsigned gen = old / nloc;
        if (old + 1u == (gen + 1u) * nloc) xb_add(&bar[XB_XGEN(b.x)], 1u);
        else XB_SPIN(xb_ld(&bar[XB_XGEN(b.x)]) == gen, bar);
        __builtin_amdgcn_fence(__ATOMIC_ACQUIRE, "agent");
        asm volatile("s_waitcnt vmcnt(0)" ::: "memory");
    }
    __syncthreads();
}

struct Params {
    const float *x, *c, *w_ada, *b_ada, *pre_g, *post_g, *w_gate, *w_up, *w_down, *w_in, *ln_g, *ln_b, *sgu_w, *sgu_b, *b_f, *gn_a, *gn_b, *w_out;
    float* out; unsigned char* ws;
};

__device__ __forceinline__ void adaln_item(const Params& p, LAS unsigned char* lds, int cgp, int tid, int lane, int wave) {
    LAS float* sc = (LAS float*)lds;
    LAS float* red = (LAS float*)(lds + 32768);
    for (int idx = tid; idx < 8192; idx += 512) { const int b = idx >> 10, k = idx & 1023; const float v = p.c[idx]; sc[k * 8 + b] = v * pg8::fast_sigmoid(v); }
    __syncthreads();
    float acc[8];
#pragma unroll
    for (int b = 0; b < 8; ++b) acc[b] = 0.f;
    const float* wp = p.w_ada + (size_t)(wave * 128) * 9216 + cgp * 64 + lane;
#pragma unroll 1
    for (int k0 = 0; k0 < 128; k0 += 32) {
        float wv[32];
#pragma unroll
        for (int k = 0; k < 32; ++k) { const float* rowp = p.w_ada + (size_t)(wave * 128 + k0 + k) * 9216 + cgp * 64;
            wv[k] = __builtin_nontemporal_load(rowp + (unsigned)lane); }
        __builtin_amdgcn_sched_barrier(0);
#pragma unroll
        for (int k = 0; k < 32; ++k) { const f32x4 s0 = *(const LAS f32x4*)(sc + (wave * 128 + k0 + k) * 8), s1 = *(const LAS f32x4*)(sc + (wave * 128 + k0 + k) * 8 + 4);
            acc[0] += s0[0] * wv[k]; acc[1] += s0[1] * wv[k]; acc[2] += s0[2] * wv[k]; acc[3] += s0[3] * wv[k]; acc[4] += s1[0] * wv[k]; acc[5] += s1[1] * wv[k]; acc[6] += s1[2] * wv[k]; acc[7] += s1[3] * wv[k];
            if ((k & 7) == 7) __builtin_amdgcn_sched_barrier(0); }
    }
#pragma unroll
    for (int b = 0; b < 8; ++b) red[(wave * 8 + b) * 64 + lane] = acc[b];
    __syncthreads();
    { const int b = wave; float s = 0.f;
#pragma unroll
      for (int w = 0; w < 8; ++w) s += red[(w * 8 + b) * 64 + lane];
      const int j = cgp * 64 + lane; ((float*)(p.ws + WS_MOD))[b * 9216 + j] = s + p.b_ada[j]; }
    __syncthreads();
}
__device__ __forceinline__ void conv_decode(const Params& p, int it, const float*& W, int& ldw, int& k0, int& n0, bf16*& WT, int& K, int& drow0, const float*& kgain) {
    constexpr int I_GU = 16 * 88, I_D = 44 * 32, I_IN = 16 * 80;
    static_assert(I_GU == I_D, "items");
    int r = it; kgain = nullptr;
    if (r < 4 * I_GU) {
        const int which = r / I_GU; r -= which * I_GU; const int f = which >> 1, up = which & 1;
        const int kb = r / 88, nb = r % 88; n0 = nb * 32; k0 = kb * 64; ldw = DFF; K = 1024;
        W = (up ? p.w_up : p.w_gate) + (size_t)f * 1024 * DFF; WT = (bf16*)(p.ws + (f ? WS_WGU1 : WS_WGU0));
        drow0 = 256 * (n0 >> 7) + (n0 & 127) + (up ? 128 : 0); return; }
    r -= 4 * I_GU;
    if (r < 2 * I_D) { const int f = r / I_D; r -= f * I_D; const int kb = r / 32, nb = r % 32;
        W = p.w_down + (size_t)f * DFF * 1024; ldw = 1024; k0 = kb * 64; n0 = nb * 32; WT = (bf16*)(p.ws + (f ? WS_WD1 : WS_WD0)); K = DFF; drow0 = nb * 32; return; }
    r -= 2 * I_D;
    if (r < I_IN) { const int kb = r / 80, nb = r % 80; W = p.w_in; ldw = NIN; k0 = kb * 64; n0 = nb * 32; WT = (bf16*)(p.ws + WS_WIN); K = 1024; drow0 = nb * 32; return; }
    r -= I_IN;
    { const int kb = r / 32, nb = r % 32;
      W = p.w_out; ldw = 1024; k0 = kb * 64; n0 = nb * 32; WT = (bf16*)(p.ws + WS_WOUT); K = 1024; drow0 = nb * 32; kgain = (kb < 8 ? p.gn_a + kb * 64 : p.gn_b + (kb - 8) * 64); }
}
__device__ __forceinline__ void conv_load(const float* W, int ldw, int k0, int n0, const float* kgain, int lane, float (&r)[32]) {
#pragma unroll
    for (int i = 0; i < 32; ++i) { const int kk = 2 * i + (lane >> 5); r[i] = __builtin_nontemporal_load(W + (size_t)(k0 + kk) * ldw + n0 + (lane & 31)); }
    if (kgain) {
#pragma unroll
        for (int i = 0; i < 32; ++i) r[i] *= kgain[2 * i + (lane >> 5)]; }
}
__device__ __forceinline__ void conv_store(const float (&r)[32], bf16* WT, int K, int drow0, int k0, LAS float* scr, int lane) {
#pragma unroll
    for (int i = 0; i < 32; ++i) { const int kk = 2 * i + (lane >> 5); scr[kk * 33 + (lane & 31)] = r[i]; }
    LDS_WAIT(); asm volatile("" ::: "memory");
    const int c = lane & 7;
#pragma unroll
    for (int j = 0; j < 4; ++j) { const int n = (lane >> 3) + 8 * j; const LAS float* s = scr + (8 * c) * 33 + n;
        v4u o; o.x = pk2(s[0 * 33], s[1 * 33]); o.y = pk2(s[2 * 33], s[3 * 33]); o.z = pk2(s[4 * 33], s[5 * 33]); o.w = pk2(s[6 * 33], s[7 * 33]);
        *(GAS v4u*)(WT + (size_t)(drow0 + n) * K + k0 + 8 * c) = o; }
    LDS_WAIT(); asm volatile("" ::: "memory");
}
__device__ __forceinline__ void convert_weights(const Params& p, LAS unsigned char* lds, int gw, int NGW, int lane, int wave) {
    LAS float* scr = (LAS float*)(lds + wave * 16384);
    constexpr int NITEMS = 6 * (16 * 88) + 16 * 80 + 16 * 32;
    int it = gw; if (it >= NITEMS) return;
    const float *Wa, *Wb, *ga, *gb; bf16 *Ta, *Tb; int la, lb, ka, kb_, na, nb_, Ka, Kb, da, db;
    float ra[32], rb[32];
    conv_decode(p, it, Wa, la, ka, na, Ta, Ka, da, ga); conv_load(Wa, la, ka, na, ga, lane, ra);
    for (;;) {
        int itn = it + NGW; bool more = itn < NITEMS;
        if (more) { conv_decode(p, itn, Wb, lb, kb_, nb_, Tb, Kb, db, gb); conv_load(Wb, lb, kb_, nb_, gb, lane, rb); }
        conv_store(ra, Ta, Ka, da, ka, scr, lane);
        if (!more) break;
        it = itn; itn = it + NGW; more = itn < NITEMS;
        if (more) { conv_decode(p, itn, Wa, la, ka, na, Ta, Ka, da, ga); conv_load(Wa, la, ka, na, ga, lane, ra); }
        conv_store(rb, Tb, Kb, db, kb_, scr, lane);
        if (!more) break;
        it = itn;
    }
}

template <int MODE, bool XIN16 = false, bool XOUT16 = false> __device__ __forceinline__ void ew_phase(const Params& p, LAS unsigned char* lds, int gw, int lane, const float* xin, int sub_res, float coef, int sub_next) {
    const int row0 = gw * 16; if (row0 >= M) return;
    asm volatile("" : "+v"(lane));
    const int b = row0 / SEQ;
    const unsigned lo = 4u * (unsigned)lane;
    const float* mod = (const float*)(p.ws + WS_MOD) + (size_t)b * 9216;
    f32x4 G[4], A[4], S[4];
    if (MODE & 1) {
#pragma unroll
        for (int j = 0; j < 4; ++j) { const unsigned col = lo + 256u * j; const f32x4 gt = *(const f32x4*)(mod + sub_res * 3072 + 2048 + col), pg = *(const f32x4*)(p.post_g + sub_res * 1024 + col); G[j] = coef * (1.0f + gt) * pg; }
        asm volatile("" : "+v"(G[0]), "+v"(G[1]), "+v"(G[2]), "+v"(G[3]) :: "memory");
    }
    if (MODE & 2) {
#pragma unroll
        for (int j = 0; j < 4; ++j) { const unsigned col = lo + 256u * j; const f32x4 sh = *(const f32x4*)(mod + sub_next * 3072 + col), scl = *(const f32x4*)(mod + sub_next * 3072 + 1024 + col), pg = *(const f32x4*)(p.pre_g + sub_next * 1024 + col);
            A[j] = pg * (1.0f + scl); S[j] = sh; }
        asm volatile("" : "+v"(A[0]), "+v"(A[1]), "+v"(A[2]), "+v"(A[3]) :: "memory");
        if (!(MODE & 4)) asm volatile("" : "+v"(S[0]), "+v"(S[1]), "+v"(S[2]), "+v"(S[3]));
    }
    const LAS f32x4* wfl = (const LAS f32x4*)lds + lane;
    const bf16* HD = (const bf16*)(p.ws + WS_HD);
    bf16* H = (bf16*)(p.ws + WS_H);
    bf16* X1 = (bf16*)(p.ws + WS_X1);
    float rs4[4] = {0.f, 0.f, 0.f, 0.f};
    if (MODE & 1) {
        const float* ss = (const float*)(p.ws + WS_SS) + row0 + (unsigned)((lane & 15) * M + (lane >> 4));
#pragma unroll
        for (int i = 0; i < 4; ++i) { float q = ss[4 * i]; q += __shfl_xor(q, 1); q += __shfl_xor(q, 2); q += __shfl_xor(q, 4); q += __shfl_xor(q, 8); rs4[i] = __builtin_amdgcn_rsqf(q * (1.0f / 1024.0f) + EPS); }
        asm volatile("" : "+v"(rs4[0]), "+v"(rs4[1]), "+v"(rs4[2]), "+v"(rs4[3]) :: "memory");
    }
    constexpr int NR = (MODE & 4) ? 1 : 2;
#pragma unroll 1
    for (int rp = 0; rp < 16 / NR; ++rp) {
        f32x4 v[NR][4]; v2u hw[NR][4];
#pragma unroll
        for (int k = 0; k < NR; ++k) { const int row = row0 + NR * rp + k;
#pragma unroll
            for (int j = 0; j < 4; ++j) {
                if (XIN16) { const v2u xw = __builtin_nontemporal_load((const v2u*)(X1 + (size_t)row * 1024 + (lo + 256u * j))); v[k][j] = (f32x4){bf_lo(xw.x), bf_hi(xw.x), bf_lo(xw.y), bf_hi(xw.y)}; }
                else v[k][j] = __builtin_nontemporal_load((const f32x4*)(xin + (size_t)row * 1024 + (lo + 256u * j)));
                if (MODE & 1) hw[k][j] = __builtin_nontemporal_load((const v2u*)(HD + (size_t)row * 1024 + (lo + 256u * j))); } }
#pragma unroll
        for (int k = 0; k < NR; ++k) { const int rr = NR * rp + k, row = row0 + rr;
            if (MODE & 1) {
                const int i = rr >> 2; const float sel = i == 0 ? rs4[0] : (i == 1 ? rs4[1] : (i == 2 ? rs4[2] : rs4[3]));
                const float rstd = __shfl(sel, (rr & 3) * 16);
#pragma unroll
                for (int j = 0; j < 4; ++j) { const f32x4 hv = (f32x4){bf_lo(hw[k][j].x), bf_hi(hw[k][j].x), bf_lo(hw[k][j].y), bf_hi(hw[k][j].y)};
                    v[k][j] = v[k][j] + G[j] * hv * rstd;
                    if (XOUT16) { v2u xw; xw.x = pk2(v[k][j][0], v[k][j][1]); xw.y = pk2(v[k][j][2], v[k][j][3]); __builtin_nontemporal_store(xw, (v2u*)(X1 + (size_t)row * 1024 + (lo + 256u * j))); }
                    else __builtin_nontemporal_store(v[k][j], (f32x4*)(p.out + (size_t)row * 1024 + (lo + 256u * j))); }
            }
            if (MODE & 2) {
                float s2 = 0.f;
#pragma unroll
                for (int j = 0; j < 4; ++j) s2 += (v[k][j][0] * v[k][j][0] + v[k][j][1] * v[k][j][1]) + (v[k][j][2] * v[k][j][2] + v[k][j][3] * v[k][j][3]);
                const float r2 = __builtin_amdgcn_rsqf(wave_sum(s2) * (1.0f / 1024.0f) + EPS);
                f32x4 hq[4];
#pragma unroll
                for (int j = 0; j < 4; ++j) { const f32x4 sj = (MODE & 4) ? *(const f32x4*)(mod + sub_next * 3072 + (lo + 256u * j)) : S[j];
                    hq[j] = v[k][j] * r2 * A[j] + sj;
                    v2u w; w.x = pk2(hq[j][0], hq[j][1]); w.y = pk2(hq[j][2], hq[j][3]);
                    *(v2u*)(H + (size_t)row * 1024 + (lo + 256u * j)) = w; }
                if (MODE & 4) {
                    f32x4 d0 = (f32x4){0.f, 0.f, 0.f, 0.f}, d1 = d0;
#pragma unroll
                    for (int j = 0; j < 4; ++j)
#pragma unroll
                        for (int e = 0; e < 4; ++e) { d0 += hq[j][e] * wfl[((j * 4 + e) * 2 + 0) * 64]; d1 += hq[j][e] * wfl[((j * 4 + e) * 2 + 1) * 64]; }
                    const bool b5 = lane & 32, b4 = lane & 16, b3 = lane & 8;
                    const f32x4 snd = b5 ? d0 : d1; f32x4 k4 = b5 ? d1 : d0;
                    k4[0] += __shfl_xor(snd[0], 32); k4[1] += __shfl_xor(snd[1], 32); k4[2] += __shfl_xor(snd[2], 32); k4[3] += __shfl_xor(snd[3], 32);
                    const float s0 = b4 ? k4[0] : k4[2], s1 = b4 ? k4[1] : k4[3]; float k0 = b4 ? k4[2] : k4[0], k1 = b4 ? k4[3] : k4[1];
                    k0 += __shfl_xor(s0, 16); k1 += __shfl_xor(s1, 16);
                    float mine = (b3 ? k1 : k0) + __shfl_xor(b3 ? k0 : k1, 8);
                    mine += dpp_f<0xB1>(mine); mine += dpp_f<0x4E>(mine); mine += dpp_f<0x141>(mine);
                    if ((lane & 7) == 0) { const int hh = lane >> 3; const float z = mine + p.b_f[hh];
                        const float ls = (z < 0.f ? z : 0.f) - 0.6931471805599453f * __builtin_amdgcn_logf(1.0f + __builtin_amdgcn_exp2f(-1.4426950408889634f * fabsf(z)));
                        ((float*)(p.ws + WS_LOGF))[((size_t)(b * 8 + hh)) * SEQ + (row - b * SEQ)] = ls; }
                }
            }
        }
    }
}
__device__ __forceinline__ void ew_fill_wf(const Params& p, LAS unsigned char* lds, int tid) {
    for (int idx = tid; idx < 2048; idx += NWAVES * 64) { const int l = idx & 63, half = (idx >> 6) & 1, e = (idx >> 7) & 3, j = idx >> 9;
        ((LAS f32x4*)lds)[idx] = *(const f32x4*)(p.w_in + (size_t)(4 * l + 256 * j + e) * NIN + 2560 + 4 * half); }
    __syncthreads();
}
__device__ __forceinline__ void scan_seq(const Params& p, int seq, int lane) {
    const float* src = (const float*)(p.ws + WS_LOGF) + (size_t)seq * SEQ + lane * 64;
    float* dst = (float*)(p.ws + WS_CUM) + (size_t)seq * SEQ + lane * 64;
    f32x4 v[16]; float run = 0.f;
#pragma unroll
    for (int i = 0; i < 16; ++i) { v[i] = *(const f32x4*)(src + 4 * i);
        run += v[i][0]; v[i][0] = run; run += v[i][1]; v[i][1] = run; run += v[i][2]; v[i][2] = run; run += v[i][3]; v[i][3] = run; }
    float incl = run;
#pragma unroll
    for (int o = 1; o < 64; o <<= 1) { const float t = __shfl_up(incl, o); if (lane >= o) incl += t; }
    const float excl = incl - run;
#pragma unroll
    for (int i = 0; i < 16; ++i) *(f32x4*)(dst + 4 * i) = (v[i] + excl) * 1.4426950408889634f;
}
constexpr int SGU_PITCH = 1044;
__device__ __forceinline__ void sgu_unit(const Params& p, LAS unsigned char* lds, int unit, int lane, int wave) {
    const int R0 = unit * 128;
    const bf16* ZG = (const bf16*)(p.ws + WS_ZG) + (size_t)(unit >> 5) * PAD_ZG;
    bf16* Y = (bf16*)(p.ws + WS_Y);
    float* ssa = (float*)(p.ws + WS_SSA);
    {
        const f32x4 g0 = *(const f32x4*)(p.ln_g + 8 * lane), g1 = *(const f32x4*)(p.ln_g + 8 * lane + 4), b0 = *(const f32x4*)(p.ln_b + 8 * lane), b1 = *(const f32x4*)(p.ln_b + 8 * lane + 4);
        v4u wv[16];
#pragma unroll
        for (int rr = 0; rr < 16; ++rr) wv[rr] = __builtin_nontemporal_load((const v4u*)(ZG + (size_t)(R0 + wave * 16 + rr) * 1024 + 512 + 8 * lane));
#pragma unroll
        for (int rr = 0; rr < 16; ++rr) { const int r = wave * 16 + rr; const v4u w = wv[rr];
            f32x4 a = (f32x4){bf_lo(w.x), bf_hi(w.x), bf_lo(w.y), bf_hi(w.y)}, c = (f32x4){bf_lo(w.z), bf_hi(w.z), bf_lo(w.w), bf_hi(w.w)};
            const float mean = wave_sum((a[0] + a[1]) + (a[2] + a[3]) + (c[0] + c[1]) + (c[2] + c[3])) * (1.0f / 512.0f);
            a = a - mean; c = c - mean;
            const float var = wave_sum((a[0] * a[0] + a[1] * a[1]) + (a[2] * a[2] + a[3] * a[3]) + (c[0] * c[0] + c[1] * c[1]) + (c[2] * c[2] + c[3] * c[3])) * (1.0f / 512.0f);
            const float rstd = __builtin_amdgcn_rsqf(var + EPS);
            a = a * rstd * g0 + b0; c = c * rstd * g1 + b1;
            LAS unsigned* d = (LAS unsigned*)(lds + r * SGU_PITCH + 16 * lane);
            d[0] = pk2(a[0], a[1]); d[1] = pk2(a[2], a[3]); d[2] = pk2(c[0], c[1]); d[3] = pk2(c[2], c[3]); }
    }
    __syncthreads();
    const int fr = lane & 15, fq = lane >> 4;
    const int h = wave;
    bf16x8 vfr[4][4];
#pragma unroll
    for (int ks = 0; ks < 4; ++ks) { const LAS unsigned short* vb = (const LAS unsigned short*)(lds + (32 * ks + 8 * fq) * SGU_PITCH + (64 * h + fr) * 2);
#pragma unroll
        for (int nt = 0; nt < 4; ++nt) { bf16x8 vf;
#pragma unroll
            for (int e = 0; e < 8; ++e) vf[e] = (short)vb[e * (SGU_PITCH / 2) + 16 * nt];
            vfr[ks][nt] = vf; } }
    const float* Wh = p.sgu_w + (size_t)h * 16384 + (size_t)fr * 128 + 8 * fq;
#pragma unroll 1
    for (int rt2 = 0; rt2 < 8; rt2 += 2) {
        f32x4 wv[2][4][2]; v2u uw[2][4]; float bs[2];
#pragma unroll
        for (int t = 0; t < 2; ++t) { const int i = (rt2 + t) * 16 + fr;
#pragma unroll
            for (int ks = 0; ks < 4; ++ks) { wv[t][ks][0] = *(const f32x4*)(Wh + (size_t)(rt2 + t) * 2048 + 32 * ks); wv[t][ks][1] = *(const f32x4*)(Wh + (size_t)(rt2 + t) * 2048 + 32 * ks + 4); }
#pragma unroll
            for (int nt = 0; nt < 4; ++nt) uw[t][nt] = __builtin_nontemporal_load((const v2u*)(ZG + (size_t)(R0 + i) * 1024 + 64 * h + 16 * nt + 4 * fq));
            bs[t] = p.sgu_b[h * 128 + i]; }
        __builtin_amdgcn_sched_barrier(0);
#pragma unroll
        for (int t = 0; t < 2; ++t) { const int i = (rt2 + t) * 16 + fr; const size_t rowoff = (size_t)(R0 + i) * 1024;
            f32x4 acc[4];
#pragma unroll
            for (int nt = 0; nt < 4; ++nt) acc[nt] = (f32x4){0.f, 0.f, 0.f, 0.f};
#pragma unroll
            for (int ks = 0; ks < 4; ++ks) if (ks < 2 || rt2 >= 4) {
                const f32x4 w0 = wv[t][ks][0], w1 = wv[t][ks][1];
                v4u wu; wu.x = pk2(w0[0], w0[1]); wu.y = pk2(w0[2], w0[3]); wu.z = pk2(w1[0], w1[1]); wu.w = pk2(w1[2], w1[3]);
                const bf16x8 wfrag = __builtin_bit_cast(bf16x8, wu);
#pragma unroll
                for (int nt = 0; nt < 4; ++nt) acc[nt] = __builtin_amdgcn_mfma_f32_16x16x32_bf16(vfr[ks][nt], wfrag, acc[nt], 0, 0, 0);
            }
            float q = 0.f;
#pragma unroll
            for (int nt = 0; nt < 4; ++nt) { const int c = 64 * h + 16 * nt + 4 * fq;
                const f32x4 uv = (f32x4){bf_lo(uw[t][nt].x), bf_hi(uw[t][nt].x), bf_lo(uw[t][nt].y), bf_hi(uw[t][nt].y)};
                const f32x4 y = uv * (acc[nt] + bs[t]);
                v2u o; o.x = pk2(y[0], y[1]); o.y = pk2(y[2], y[3]);
                const f32x4 yr = (f32x4){bf_lo(o.x), bf_hi(o.x), bf_lo(o.y), bf_hi(o.y)};
                q += (yr[0] * yr[0] + yr[1] * yr[1]) + (yr[2] * yr[2] + yr[3] * yr[3]);
                *(v2u*)(Y + rowoff + c) = o; }
            q += __shfl_xor(q, 16); q += __shfl_xor(q, 32);
            if (fq == 0) ssa[(size_t)h * M + R0 + i] = q;
        }
    }
    __syncthreads();
}
__device__ __forceinline__ void ynorm_phase(const Params& p, int gw, int lane) {
    const int row0 = gw * 16; if (row0 >= M) return;
    asm volatile("" : "+v"(lane));
    const f32x4 ga0 = *(const f32x4*)(p.gn_a + 8 * lane), ga1 = *(const f32x4*)(p.gn_a + 8 * lane + 4), gb0 = *(const f32x4*)(p.gn_b + 8 * lane), gb1 = *(const f32x4*)(p.gn_b + 8 * lane + 4);
    const float* ssa = (const float*)(p.ws + WS_SSA); const float* ssb = (const float*)(p.ws + WS_SSB);
    bf16* Y = (bf16*)(p.ws + WS_Y);
    for (int rr = 0; rr < 16; ++rr) { const int row = row0 + rr;
        float qa = 0.f, qb = 0.f;
#pragma unroll
        for (int h = 0; h < 8; ++h) { qa += ssa[(size_t)h * M + row]; qb += ssb[(size_t)h * M + row]; }
        const float ra = __builtin_amdgcn_rsqf(qa * (1.0f / 512.0f) + EPS), rb = __builtin_amdgcn_rsqf(qb * (1.0f / 512.0f) + EPS);
        v4u* pa = (v4u*)(Y + (size_t)row * 1024 + 8 * lane); v4u* pb = (v4u*)(Y + (size_t)row * 1024 + 512 + 8 * lane);
        const v4u wa = *pa, wb = *pb; v4u oa, ob;
        oa.x = pk2(bf_lo(wa.x) * ra * ga0[0], bf_hi(wa.x) * ra * ga0[1]); oa.y = pk2(bf_lo(wa.y) * ra * ga0[2], bf_hi(wa.y) * ra * ga0[3]);
        oa.z = pk2(bf_lo(wa.z) * ra * ga1[0], bf_hi(wa.z) * ra * ga1[1]); oa.w = pk2(bf_lo(wa.w) * ra * ga1[2], bf_hi(wa.w) * ra * ga1[3]);
        ob.x = pk2(bf_lo(wb.x) * rb * gb0[0], bf_hi(wb.x) * rb * gb0[1]); ob.y = pk2(bf_lo(wb.y) * rb * gb0[2], bf_hi(wb.y) * rb * gb0[3]);
        ob.z = pk2(bf_lo(wb.z) * rb * gb1[0], bf_hi(wb.z) * rb * gb1[1]); ob.w = pk2(bf_lo(wb.w) * rb * gb1[2], bf_hi(wb.w) * rb * gb1[3]);
        *pa = oa; *pb = ob; }
}

#ifndef PROBE
#define PROBE 0
#endif
#ifndef STAG_TICKS
#define STAG_TICKS 700
#endif
__device__ __forceinline__ void stagger_start(int bx) {
    const unsigned long long d = (unsigned long long)(((unsigned)bx * 97u) & 255u) * STAG_TICKS / 256u, t0 = __builtin_amdgcn_s_memrealtime();
    while (__builtin_amdgcn_s_memrealtime() - t0 < d) __builtin_amdgcn_s_sleep(8);
}
#define REPS(cond) for (int rep_ = 0; rep_ < ((cond) ? 2 : 1); ++rep_)
__global__ void __launch_bounds__(NWAVES * 64, 2) mega_fwd(Params p) {
    extern __shared__ __attribute__((aligned(16))) unsigned char lds_raw[];
    cg::grid_group grid = cg::this_grid();
    LAS unsigned char* lds = (LAS unsigned char*)lds_raw;
    if (threadIdx.x < 16) ((LAS unsigned*)(lds + LDS_BARST))[threadIdx.x] = 0u;
    __syncthreads();
    const XcdBarrier bar = xcd_barrier_post((unsigned*)(p.ws + WS_CTL), (volatile LAS unsigned*)(lds + LDS_BARST));
    if (p.ws == nullptr) grid.sync();
    const int G = gridDim.x, NGW = G * NWAVES;
    int bx = blockIdx.x;
    int cgx = blockIdx.x;
    int sid = blockIdx.x;
    bool uni = false;
#define GRID_SYNC() do { if (uni) xcd_local_barrier(bar); else xcd_barrier(bar); } while (0)
#define LANEVARS const int tid = otid(), lane = tid & 63, wave = __builtin_amdgcn_readfirstlane(tid >> 6), gw = bx * NWAVES + wave; (void)tid; (void)lane; (void)wave; (void)gw
    bf16* H = (bf16*)(p.ws + WS_H); bf16* HD = (bf16*)(p.ws + WS_HD); bf16* ACT = (bf16*)(p.ws + WS_ACT);
    float* SS = (float*)(p.ws + WS_SS);

    REPS(PROBE == 3) { LANEVARS; for (int it = bx; it < 144; it += G) adaln_item(p, lds, it, tid, lane, wave);
      convert_weights(p, lds, gw, NGW, lane, wave); __syncthreads(); }
    xcd_barrier(bar);
    { volatile LAS unsigned* st = (volatile LAS unsigned*)(lds + LDS_BARST);
      const unsigned u_ = __builtin_amdgcn_readfirstlane(st[2]), r_ = __builtin_amdgcn_readfirstlane(st[3]), x_ = bar.x;
#ifndef FORCE_FALLBACK
#define FORCE_FALLBACK 0
#endif
      if (!FORCE_FALLBACK && u_ != 0u && r_ < 32u && x_ < 8u) { uni = true; bx = (int)(x_ * 32u + r_); cgx = (int)(r_ * 8u + x_); sid = r_ < 8u ? (int)(x_ * 8u + r_) : (1 << 20); } }
    REPS(PROBE == 5) { LANEVARS; for (int g = gw; g * 16 < M; g += NGW) ew_phase<2>(p, lds, g, lane, p.x, 0, 0.f, 0); }
    GRID_SYNC();
    REPS(PROBE == 4 || PROBE >= 6) { pg8::Gemm g{H, (const bf16*)(p.ws + WS_WGU0), M, 2 * DFF, 1024}; pg8::StaticOrder S; S.init(M, 2 * DFF, G, cgx);
      pg8::EpiSwiGLU E{ACT, DFF, (rep_ == 1 && PROBE >= 6) ? PROBE - 6 : 0}; pg8::gemm_phase<pg8::EpiSwiGLU, pg8::StaticOrder, true, true>(lds, g, S, E); }
    GRID_SYNC();
    REPS(PROBE == 4) { pg8::Gemm g{ACT, (const bf16*)(p.ws + WS_WD0), M, 1024, DFF}; pg8::StaticOrder S; S.init(M, 1024, G, cgx);
      pg8::EpiBf16Ss E{HD, 1024, SS, M}; pg8::gemm_phase<pg8::EpiBf16Ss, pg8::StaticOrder, true, true>(lds, g, S, E); }
    GRID_SYNC();
    REPS(PROBE == 5) { LANEVARS; __syncthreads(); ew_fill_wf(p, lds, tid); for (int g = gw; g * 16 < M; g += NGW) ew_phase<7, false, true>(p, lds, g, lane, p.x, 0, 0.5f, 1); }
    GRID_SYNC();
    { LANEVARS; if (wave == 0) for (int s = sid; s < BATCH * HB; s += G) scan_seq(p, s, lane); }
    REPS(PROBE == 4) { pg8::Gemm g{H, (const bf16*)(p.ws + WS_WIN), M, 2560, 1024}; pg8::StaticOrder S; S.init(M, 2560, G, cgx);
      static_assert(WS_K - WS_Q == WS_V - WS_K, "qkv stride");
      pg8::EpiMixIn E{(bf16*)(p.ws + WS_ZG), (bf16*)(p.ws + WS_Q), (WS_K - WS_Q) / 2, attn_body::C2, PAD_ZG, PAD_QKV};
      pg8::gemm_phase<pg8::EpiMixIn, pg8::StaticOrder, true, true>(lds, g, S, E); }
    GRID_SYNC();
    { const attn_body::AttnTensors AT{(const attn_body::bf16*)(p.ws + WS_Q), (const attn_body::bf16*)(p.ws + WS_K), (const attn_body::bf16*)(p.ws + WS_V),
                                      (attn_body::bf16*)(p.ws + WS_Y) + 512, (const float*)(p.ws + WS_CUM), (float*)(p.ws + WS_SSB), (float*)(p.ws + WS_KPART)};
      const attn_body::StaticOrder S(G, cgx);
      attn_body::attn_pre<attn_body::StaticOrder>((char*)lds_raw, AT, S);
      { LANEVARS; for (int u = bx; u < M / 128; u += G) sgu_unit(p, lds, u, lane, wave); }
      GRID_SYNC();
      attn_body::attn_run<attn_body::StaticOrder>((char*)lds_raw, AT, S); }
    GRID_SYNC();
    { pg8::Gemm g{(const bf16*)(p.ws + WS_Y), (const bf16*)(p.ws + WS_WOUT), M, 1024, 1024}; pg8::StaticOrder S; S.init(M, 1024, G, cgx);
      LAS pg8::f32x2* tab = (LAS pg8::f32x2*)(lds + 131072);
      pg8::Unit u0{0, 0}, u1{0, 0}; const bool has0 = S.next(0, u0), has1 = S.next(1, u1); pg8::Unit u2; const bool has2 = S.next(2, u2);
      { LANEVARS; const int ui = tid >> 8, r = tid & 255; const int pmu = ui ? u1.pm : u0.pm;
        if (ui ? has1 : has0) { const float* ssa = (const float*)(p.ws + WS_SSA) + (size_t)pmu * 256 + r; const float* ssb = (const float*)(p.ws + WS_SSB) + (size_t)pmu * 256 + r; float qa = 0.f, qb = 0.f;
#pragma unroll
          for (int h = 0; h < 8; ++h) { qa += ssa[(size_t)h * M]; qb += ssb[(size_t)h * M]; }
          const float ra = __builtin_amdgcn_rsqf(qa * (1.0f / 512.0f) + EPS), rb = __builtin_amdgcn_rsqf(qb * (1.0f / 512.0f) + EPS);
          tab[ui * 256 + r] = (pg8::f32x2){ra / rb, rb}; }
        __syncthreads(); }
      if (!has2 && (!has1 || u1.pm != u0.pm)) {
        pg8::EpiRowScaleSs E{HD, 1024, SS, M, tab, u0.pm}; pg8::gemm_phase<pg8::EpiRowScaleSs, pg8::StaticOrder, true, true>(lds, g, S, E); }
    }
    GRID_SYNC();
    { LANEVARS; for (int g = gw; g * 16 < M; g += NGW) ew_phase<3, true, true>(p, lds, g, lane, p.x, 1, 1.0f, 2); }
    GRID_SYNC();
    REPS(PROBE == 4) { pg8::Gemm g{H, (const bf16*)(p.ws + WS_WGU1), M, 2 * DFF, 1024}; pg8::StaticOrder S; S.init(M, 2 * DFF, G, cgx);
      pg8::EpiSwiGLU E{ACT, DFF, 0}; pg8::gemm_phase<pg8::EpiSwiGLU, pg8::StaticOrder, true, true>(lds, g, S, E); }
    GRID_SYNC();
    REPS(PROBE == 4) { pg8::Gemm g{ACT, (const bf16*)(p.ws + WS_WD1), M, 1024, DFF}; pg8::StaticOrder S; S.init(M, 1024, G, cgx);
      pg8::EpiBf16Ss E{HD, 1024, SS, M}; pg8::gemm_phase<pg8::EpiBf16Ss, pg8::StaticOrder, true, true>(lds, g, S, E); }
    GRID_SYNC();
    { LANEVARS; for (int g = gw; g * 16 < M; g += NGW) ew_phase<1, true, false>(p, lds, g, lane, p.x, 2, 0.5f, 0); }
}

extern "C" void kernel_launch(void* const* d_in, const int* in_sizes, int n_in, void* d_out, int out_size, void* d_ws, size_t ws_size, hipStream_t stream) {
    static int grid = 0;
    if (grid == 0) {
        if (n_in != 18 || out_size != M * 1024 || ws_size < WS_END) { fprintf(stderr, "kernel_launch: unexpected problem shape (n_in %d out %d ws %zu)\n", n_in, out_size, ws_size); grid = -1; return; }
        int dev = 0, cus = 0, per_cu = 0;
        (void)hipGetDevice(&dev); (void)hipDeviceGetAttribute(&cus, hipDeviceAttributeMultiprocessorCount, dev);
        if (hipFuncSetAttribute((const void*)mega_fwd, hipFuncAttributeMaxDynamicSharedMemorySize, LDS_BYTES) != hipSuccess) { fprintf(stderr, "kernel_launch: hipFuncSetAttribute failed\n"); grid = -1; return; }
        if (hipOccupancyMaxActiveBlocksPerMultiprocessor(&per_cu, (const void*)mega_fwd, NWAVES * 64, LDS_BYTES) != hipSuccess || per_cu < 1) { fprintf(stderr, "kernel_launch: occupancy query says %d\n", per_cu); per_cu = 1; }
        (void)hipGetLastError();
        grid = cus * 1;
        if (grid <= 0) grid = 256;
    }
    if (grid < 0) return;
    if (hipMemsetAsync((char*)d_ws + WS_CTL, 0, CTL_BYTES, stream) != hipSuccess) { fprintf(stderr, "kernel_launch: memset failed\n"); return; }
    Params p{};
    p.x = (const float*)d_in[0]; p.c = (const float*)d_in[1]; p.w_ada = (const float*)d_in[2]; p.b_ada = (const float*)d_in[3]; p.pre_g = (const float*)d_in[4]; p.post_g = (const float*)d_in[5];
    p.w_gate = (const float*)d_in[6]; p.w_up = (const float*)d_in[7]; p.w_down = (const float*)d_in[8]; p.w_in = (const float*)d_in[9]; p.ln_g = (const float*)d_in[10]; p.ln_b = (const float*)d_in[11];
    p.sgu_w = (const float*)d_in[12]; p.sgu_b = (const float*)d_in[13]; p.b_f = (const float*)d_in[14]; p.gn_a = (const float*)d_in[15]; p.gn_b = (const float*)d_in[16]; p.w_out = (const float*)d_in[17];
    p.out = (float*)d_out; p.ws = (unsigned char*)d_ws;
    void* args[] = {&p};
    hipError_t e = hipLaunchCooperativeKernel((const void*)mega_fwd, dim3(grid), dim3(NWAVES * 64), args, LDS_BYTES, stream);
    if (e != hipSuccess) fprintf(stderr, "kernel_launch: cooperative launch failed: %s (grid %d)\n", hipGetErrorString(e), grid);
}
```

```cpp
#include <hip/hip_runtime.h>
#include <hip/hip_cooperative_groups.h>
#include <hip/hip_bf16.h>
#include <cstdio>
#include <cstdint>
#include <cmath>
namespace cg = cooperative_groups;
__device__ __forceinline__ int otid() { int t = threadIdx.x; asm volatile("" : "+v"(t)); return t; }
namespace pg8 {
#define PG8_LAS __attribute__((address_space(3)))
typedef unsigned short bf16_t;
typedef short bf16x8 __attribute__((ext_vector_type(8)));
typedef float f32x4 __attribute__((ext_vector_type(4)));
typedef unsigned u32x4 __attribute__((ext_vector_type(4)));
constexpr int BM = 256, BK = 64, HALF = 128, HTB = HALF * BK * 2  , STAGE_BYTES = 8 * HTB, NXCD = 8, WGM = 8;

__host__ __device__ __forceinline__ int lds_byte(int r, int c) { const int st = (r >> 4) * 2 + (c >> 5), rr = r & 15, cc = c & 31, ob = rr * 64 + cc * 2; return st * 1024 + (ob ^ (((ob >> 9) & 1) << 5)); }
__host__ __device__ __forceinline__ void stage_rc(int b, int& R, int& C) { const int st = b / 1024, sb = b % 1024, swz = sb ^ (((sb >> 9) & 1) << 5); R = (st >> 1) * 16 + swz / 64; C = (st & 1) * 32 + (swz % 64) / 2; }
__host__ __device__ __forceinline__ int perm32(int rho) { const int n = rho >> 4, i = rho & 15; return 8 * (i >> 2) + 4 * n + (i & 3); }

struct Unit { int pm, pn; };
struct Gemm { const bf16_t* A; const bf16_t* Bt; int M, N, K; };

struct StaticOrder {
    int nM, nN, nwg, G, c;
    __host__ __device__ __forceinline__ void init(int M, int N, int G_, int c_) { nM = M / BM; nN = N / BM; nwg = nM * nN; G = G_; c = c_; }
    __host__ __device__ __forceinline__ bool next(int i, Unit& u) const {
        const long L = (long)i * G + c; if (L >= nwg) return false;
        int wgid = (int)L; { const int q = nwg / NXCD, r = nwg % NXCD, xcd = wgid % NXCD, off = wgid / NXCD; wgid = (xcd < r ? xcd * (q + 1) : r * (q + 1) + (xcd - r) * q) + off; }
        const int nig = WGM * nN, gid = wgid / nig, fm = gid * WGM, gsz = (nM - fm) < WGM ? (nM - fm) : WGM;
        u.pm = fm + ((wgid % nig) % gsz); u.pn = (wgid % nig) / gsz; return true;
    }
    __device__ __forceinline__ void a_ready(const Unit&) const {}
    __device__ __forceinline__ void done(const Unit&) const {}
};

__device__ __forceinline__ unsigned cvt_pk_bf16(float lo, float hi) { unsigned r; asm volatile("v_cvt_pk_bf16_f32 %0, %1, %2" : "=v"(r) : "v"(lo), "v"(hi)); return r; }
typedef float f32x2 __attribute__((ext_vector_type(2)));
__device__ __forceinline__ float fast_sigmoid(float t) { return __builtin_amdgcn_rcpf(1.0f + __builtin_amdgcn_exp2f(-1.4426950408889634f * t)); }
struct EpiSwiGLU {
    static constexpr bool PERM = true, AFTER_DRAIN = false, HAS_MID = false;
    bf16_t* O; int ldc; int mode;
    __device__ __forceinline__ void operator()(const f32x4 (&acc)[2][2][4][2], const Unit& u, int wr, int wc, int fr, int fq) const {
        if (mode == 2) return;
        const int row0 = u.pm * BM + wr * 64 + fr; const int col0 = u.pn * HALF + wc * 32 + 8 * fq;
#pragma unroll
        for (int ai = 0; ai < 2; ++ai)
#pragma unroll
            for (int m = 0; m < 4; ++m) { bf16_t* rowp = O + (size_t)(row0 + ai * HALF + m * 16) * ldc + col0;
                float o[8];
#pragma unroll
                for (int n = 0; n < 2; ++n)
#pragma unroll
                    for (int e = 0; e < 4; ++e) { const float g = acc[ai][0][m][n][e], up = acc[ai][1][m][n][e]; o[n * 4 + e] = g * fast_sigmoid(g) * up; }
                u32x4 w; w.x = cvt_pk_bf16(o[0], o[1]); w.y = cvt_pk_bf16(o[2], o[3]); w.z = cvt_pk_bf16(o[4], o[5]); w.w = cvt_pk_bf16(o[6], o[7]);
                if (mode == 0) *(u32x4*)rowp = w; else if (w.x == 0x12345678u && w.y == 0x9abcdef0u) *(u32x4*)rowp = w; }
    }
};
struct EpiBf16Ss {
    static constexpr bool PERM = true, AFTER_DRAIN = false, HAS_MID = false;
    bf16_t* O; int ldc; float* ss; int M;
    __device__ __forceinline__ void operator()(const f32x4 (&acc)[2][2][4][2], const Unit& u, int wr, int wc, int fr, int fq) const {
        const int row0 = u.pm * BM + wr * 64 + fr; const int col0 = u.pn * BM + wc * 32 + 8 * fq;
        float* ssp = ss + (size_t)(u.pn * 4 + wc) * M;
#pragma unroll
        for (int ai = 0; ai < 2; ++ai)
#pragma unroll
            for (int m = 0; m < 4; ++m) { const int row = row0 + ai * HALF + m * 16; bf16_t* rowp = O + (size_t)row * ldc + col0; float q = 0.f;
#pragma unroll
                for (int bj = 0; bj < 2; ++bj) { const f32x4 v0 = acc[ai][bj][m][0], v1 = acc[ai][bj][m][1];
                    q += (v0[0] * v0[0] + v0[1] * v0[1]) + (v0[2] * v0[2] + v0[3] * v0[3]) + (v1[0] * v1[0] + v1[1] * v1[1]) + (v1[2] * v1[2] + v1[3] * v1[3]);
                    u32x4 w; w.x = cvt_pk_bf16(v0[0], v0[1]); w.y = cvt_pk_bf16(v0[2], v0[3]); w.z = cvt_pk_bf16(v1[0], v1[1]); w.w = cvt_pk_bf16(v1[2], v1[3]);
                    *(u32x4*)(rowp + bj * HALF) = w; }
                q += __shfl_xor(q, 16); q += __shfl_xor(q, 32);
                if (fq == 0) ssp[row] = q; }
    }
};
struct EpiRowScaleSs {
    static constexpr bool PERM = true, AFTER_DRAIN = false, HAS_MID = true;
    bf16_t* O; int ldc; float* ss; int M; const PG8_LAS f32x2* tab; int pm0;
    __device__ __forceinline__ void mid(f32x4 (&acc)[2][2][4][2], const Unit& u, int wr, int fr) const {
        const PG8_LAS f32x2* t = tab + (u.pm == pm0 ? 0 : 256) + wr * 64 + fr;
#pragma unroll
        for (int ai = 0; ai < 2; ++ai)
#pragma unroll
            for (int m = 0; m < 4; ++m) { const float f = t[ai * HALF + m * 16].x;
#pragma unroll
                for (int bj = 0; bj < 2; ++bj)
#pragma unroll
                    for (int n = 0; n < 2; ++n) acc[ai][bj][m][n] = acc[ai][bj][m][n] * f; }
    }
    __device__ __forceinline__ void operator()(const f32x4 (&acc)[2][2][4][2], const Unit& u, int wr, int wc, int fr, int fq) const {
        const int row0 = u.pm * BM + wr * 64 + fr; const int col0 = u.pn * BM + wc * 32 + 8 * fq;
        float* ssp = ss + (size_t)(u.pn * 4 + wc) * M;
        const PG8_LAS f32x2* t = tab + (u.pm == pm0 ? 0 : 256) + wr * 64 + fr;
#pragma unroll
        for (int ai = 0; ai < 2; ++ai)
#pragma unroll
            for (int m = 0; m < 4; ++m) { const int row = row0 + ai * HALF + m * 16; bf16_t* rowp = O + (size_t)row * ldc + col0; float q = 0.f; const float f = t[ai * HALF + m * 16].y;
#pragma unroll
                for (int bj = 0; bj < 2; ++bj) { const f32x4 v0 = acc[ai][bj][m][0] * f, v1 = acc[ai][bj][m][1] * f;
                    q += (v0[0] * v0[0] + v0[1] * v0[1]) + (v0[2] * v0[2] + v0[3] * v0[3]) + (v1[0] * v1[0] + v1[1] * v1[1]) + (v1[2] * v1[2] + v1[3] * v1[3]);
                    u32x4 w; w.x = cvt_pk_bf16(v0[0], v0[1]); w.y = cvt_pk_bf16(v0[2], v0[3]); w.z = cvt_pk_bf16(v1[0], v1[1]); w.w = cvt_pk_bf16(v1[2], v1[3]);
                    *(u32x4*)(rowp + bj * HALF) = w; }
                q += __shfl_xor(q, 16); q += __shfl_xor(q, 32);
                if (fq == 0) ssp[row] = q; }
    }
};
struct EpiMixIn {
    static constexpr bool PERM = true, AFTER_DRAIN = false, HAS_MID = false;
    bf16_t* ZG; bf16_t* Q; size_t qkv_stride; float qscale; size_t pad_zg, pad_qkv;
    __device__ __forceinline__ void operator()(const f32x4 (&acc)[2][2][4][2], const Unit& u, int wr, int wc, int fr, int fq) const {
        const int row0 = u.pm * BM + wr * 64 + fr;
        bf16_t* base; int ldc, colt; float sc = 1.f; const bool gelu = u.pn < 4;
        if (u.pn < 4) { base = ZG + (size_t)(u.pm >> 4) * pad_zg; ldc = 1024; colt = u.pn * BM; }
        else { const int t = (u.pn - 4) >> 1; base = Q + (size_t)t * qkv_stride + (size_t)(u.pm >> 4) * pad_qkv; ldc = 512; colt = ((u.pn - 4) & 1) * BM; if (t == 0) sc = qscale; }
        const int col0 = colt + wc * 32 + 8 * fq;
#pragma unroll
        for (int ai = 0; ai < 2; ++ai)
#pragma unroll
            for (int m = 0; m < 4; ++m) { bf16_t* rowp = base + (size_t)(row0 + ai * HALF + m * 16) * ldc + col0;
#pragma unroll
                for (int bj = 0; bj < 2; ++bj) { float o[8];
#pragma unroll
                    for (int n = 0; n < 2; ++n)
#pragma unroll
                        for (int e = 0; e < 4; ++e) { float x = acc[ai][bj][m][n][e];
                            if (gelu) { const float t = 1.5957691216057308f * (x + 0.044715f * x * x * x); x = x * fast_sigmoid(t); } else x *= sc;
                            o[n * 4 + e] = x; }
                    u32x4 w; w.x = cvt_pk_bf16(o[0], o[1]); w.y = cvt_pk_bf16(o[2], o[3]); w.z = cvt_pk_bf16(o[4], o[5]); w.w = cvt_pk_bf16(o[6], o[7]);
                    *(u32x4*)(rowp + bj * HALF) = w; } }
    }
};

template <class Epi, class Sched, bool ALIGN_EPI = false, bool SP2 = false>
__device__ __forceinline__ void gemm_phase(PG8_LAS unsigned char* lds, const Gemm g, const Sched& S, const Epi& E) {
    const int tid = otid(), wid = __builtin_amdgcn_readfirstlane(tid >> 6), lane = tid & 63, wr = wid >> 2, wc = wid & 3, fr = lane & 15, fq = lane >> 4;
    const int K = g.K, nt = K / BK;
    unsigned voffA[2], voffB[2];
#pragma unroll
    for (int i = 0; i < 2; ++i) { int R, C; stage_rc(tid * 16 + i * 8192, R, C); const int Rb = Epi::PERM ? ((R & ~31) + perm32(R & 31)) : R;
        voffA[i] = (unsigned)(R * K + C) * 2u; voffB[i] = (unsigned)(Rb * K + C) * 2u; }
    const size_t kstep = (size_t)(BK * 2);
    const size_t hstep = (size_t)HALF * K * 2;
    const size_t tstep = 2 * hstep;
    const unsigned ldsw = (unsigned)wid * 1024u;
    const int aoff = lds_byte(wr * 64 + fr, fq * 8), boff = lds_byte(wc * 32 + fr, fq * 8);
#define PG8_SA(b, h) (((b) * 2 + (h)) * HTB)
#define PG8_SB(b, h) ((4 + (b) * 2 + (h)) * HTB)
#define PG8_STAGE(bufoff, gbase, voff) do { _Pragma("unroll") for (int _i = 0; _i < 2; ++_i) \
        __builtin_amdgcn_global_load_lds((const unsigned*)((const char*)(gbase) + (voff)[_i]), (PG8_LAS unsigned*)(lds + (bufoff) + ldsw + _i * 8192), 16, 0, 0); } while (0)
#define PG8_LDA(dst, b, h) do { _Pragma("unroll") for (int m = 0; m < 4; ++m) _Pragma("unroll") for (int k = 0; k < 2; ++k) dst[m][k] = *(const PG8_LAS bf16x8*)(lds + PG8_SA(b, h) + aoff + m * 2048 + k * 1024); } while (0)
#define PG8_LDB(dst, b, h) do { _Pragma("unroll") for (int n = 0; n < 2; ++n) _Pragma("unroll") for (int k = 0; k < 2; ++k) dst[n][k] = *(const PG8_LAS bf16x8*)(lds + PG8_SB(b, h) + boff + n * 2048 + k * 1024); } while (0)
#define PG8_MMA(ai, bj, At, Bt) do { __builtin_amdgcn_s_setprio(1); _Pragma("unroll") for (int m = 0; m < 4; ++m) _Pragma("unroll") for (int n = 0; n < 2; ++n) _Pragma("unroll") for (int k = 0; k < 2; ++k) \
        acc[ai][bj][m][n] = __builtin_amdgcn_mfma_f32_16x16x32_bf16(Bt[n][k], At[m][k], acc[ai][bj][m][n], 0, 0, 0); __builtin_amdgcn_s_setprio(0); } while (0)
#define PG8_WAIT_V(n) asm volatile("s_waitcnt vmcnt(" #n ")" ::: "memory")
#define PG8_WAIT_L(n) asm volatile("s_waitcnt lgkmcnt(" #n ")" ::: "memory")
#define PG8_BAR __builtin_amdgcn_s_barrier()
#define PG8_SCHED __builtin_amdgcn_sched_barrier(0)
    Unit cur, nxt; int ui = 0;
    if (!S.next(0, cur)) return;
    f32x4 acc[2][2][4][2];
#pragma unroll
    for (int a = 0; a < 2; ++a)
#pragma unroll
        for (int b = 0; b < 2; ++b)
#pragma unroll
            for (int m = 0; m < 4; ++m)
#pragma unroll
                for (int n = 0; n < 2; ++n) acc[a][b][m][n] = (f32x4){0.f, 0.f, 0.f, 0.f};
    bf16x8 At[4][2], B0[2][2], B1[2][2];
    const char* cA = (const char*)g.A + (size_t)cur.pm * tstep; const char* cB = (const char*)g.Bt + (size_t)cur.pn * tstep;
    S.a_ready(cur);
    if constexpr (SP2) {
        PG8_STAGE(PG8_SB(0, 0), cB, voffB); PG8_STAGE(PG8_SB(0, 1), cB + hstep, voffB); PG8_STAGE(PG8_SA(0, 0), cA, voffA); PG8_STAGE(PG8_SA(0, 1), cA + hstep, voffA);
        if (wr == 1) PG8_BAR;
        PG8_WAIT_V(2); PG8_BAR;
        PG8_STAGE(PG8_SB(1, 0), cB + kstep, voffB); PG8_STAGE(PG8_SA(1, 0), cA + kstep, voffA); PG8_STAGE(PG8_SB(1, 1), cB + hstep + kstep, voffB);
        PG8_WAIT_V(6); PG8_BAR;
    } else {
        PG8_STAGE(PG8_SB(0, 0), cB, voffB); PG8_STAGE(PG8_SA(0, 0), cA, voffA); PG8_STAGE(PG8_SB(0, 1), cB + hstep, voffB); PG8_STAGE(PG8_SA(0, 1), cA + hstep, voffA);
        if (wr == 1) PG8_BAR;
        PG8_WAIT_V(4); PG8_BAR;
        PG8_STAGE(PG8_SB(1, 0), cB + kstep, voffB); PG8_STAGE(PG8_SA(1, 0), cA + kstep, voffA); PG8_STAGE(PG8_SB(1, 1), cB + hstep + kstep, voffB);
        PG8_WAIT_V(6); PG8_BAR;
    }
    for (;;) {
        const bool has_next = S.next(ui + 1, nxt);
        const char* nA = has_next ? (const char*)g.A + (size_t)nxt.pm * tstep : cA; const char* nB = has_next ? (const char*)g.Bt + (size_t)nxt.pn * tstep : cB;
        for (int t = 0; t < nt; t += 2) {
            const bool last = (t == nt - 2);
            const char* a1 = cA + (size_t)(t + 1) * kstep;
            const char* a2 = last ? nA : cA + (size_t)(t + 2) * kstep; const char* b2 = last ? nB : cB + (size_t)(t + 2) * kstep;
            const char* a3 = a2 + kstep; const char* b3 = b2 + kstep;
            if (last && has_next) S.a_ready(nxt);
            if constexpr (Epi::HAS_MID) { if (t == nt / 2) E.mid(acc, cur, wr, fr); }
            if constexpr (SP2) {
            PG8_LDB(B0, 0, 0); PG8_LDB(B1, 0, 1); PG8_SCHED; PG8_LDA(At, 0, 0); PG8_STAGE(PG8_SA(1, 1), a1 + hstep, voffA);
            PG8_WAIT_V(8); PG8_WAIT_L(0); PG8_BAR; PG8_MMA(0, 0, At, B0); PG8_MMA(0, 1, At, B1); PG8_BAR; PG8_SCHED;
            PG8_LDA(At, 0, 1); PG8_STAGE(PG8_SB(0, 0), b2, voffB); PG8_STAGE(PG8_SB(0, 1), b2 + hstep, voffB); PG8_STAGE(PG8_SA(0, 0), a2, voffA);
            PG8_WAIT_V(8); PG8_WAIT_L(0); PG8_BAR; PG8_MMA(1, 0, At, B0); PG8_MMA(1, 1, At, B1); PG8_BAR; PG8_SCHED;
            PG8_LDB(B0, 1, 0); PG8_LDB(B1, 1, 1); PG8_SCHED; PG8_LDA(At, 1, 0); PG8_STAGE(PG8_SA(0, 1), a2 + hstep, voffA);
            PG8_WAIT_V(8); PG8_WAIT_L(0); PG8_BAR; PG8_MMA(0, 0, At, B0); PG8_MMA(0, 1, At, B1); PG8_BAR; PG8_SCHED;
            PG8_LDA(At, 1, 1); PG8_STAGE(PG8_SB(1, 0), b3, voffB); PG8_STAGE(PG8_SB(1, 1), b3 + hstep, voffB); PG8_STAGE(PG8_SA(1, 0), a3, voffA);
            PG8_WAIT_V(8); PG8_WAIT_L(0); PG8_BAR; PG8_MMA(1, 0, At, B0); PG8_MMA(1, 1, At, B1); PG8_BAR; PG8_SCHED;
            } else {
            PG8_LDB(B0, 0, 0); PG8_SCHED; PG8_LDA(At, 0, 0); PG8_STAGE(PG8_SA(1, 1), a1 + hstep, voffA);
            PG8_WAIT_L(8); PG8_BAR; PG8_WAIT_L(0); PG8_MMA(0, 0, At, B0); PG8_BAR; PG8_SCHED;
            PG8_LDB(B1, 0, 1); PG8_STAGE(PG8_SB(0, 0), b2, voffB);
            PG8_BAR; PG8_WAIT_L(0); PG8_MMA(0, 1, At, B1); PG8_BAR;
            PG8_LDA(At, 0, 1); PG8_STAGE(PG8_SA(0, 0), a2, voffA);
            PG8_BAR; PG8_WAIT_L(0); PG8_MMA(1, 0, At, B0); PG8_BAR; PG8_SCHED;
            PG8_STAGE(PG8_SB(0, 1), b2 + hstep, voffB);
            PG8_WAIT_V(6); PG8_BAR; PG8_MMA(1, 1, At, B1); PG8_BAR;
            PG8_LDB(B0, 1, 0); PG8_SCHED; PG8_LDA(At, 1, 0); PG8_STAGE(PG8_SA(0, 1), a2 + hstep, voffA);
            PG8_WAIT_L(8); PG8_BAR; PG8_WAIT_L(0); PG8_MMA(0, 0, At, B0); PG8_BAR; PG8_SCHED;
            PG8_LDB(B1, 1, 1); PG8_STAGE(PG8_SB(1, 0), b3, voffB);
            PG8_BAR; PG8_WAIT_L(0); PG8_MMA(0, 1, At, B1); PG8_BAR;
            PG8_LDA(At, 1, 1); PG8_STAGE(PG8_SA(1, 0), a3, voffA);
            PG8_BAR; PG8_WAIT_L(0); PG8_MMA(1, 0, At, B0); PG8_BAR; PG8_SCHED;
            PG8_STAGE(PG8_SB(1, 1), b3 + hstep, voffB);
            PG8_WAIT_V(6); PG8_BAR; PG8_MMA(1, 1, At, B1); PG8_BAR;
            }
        }
        if constexpr (ALIGN_EPI) { if (wr == 0) PG8_BAR; }
        if constexpr (!Epi::AFTER_DRAIN) { E(acc, cur, wr, wc, fr, fq); S.done(cur); }
        if (!has_next) break;
#pragma unroll
        for (int a = 0; a < 2; ++a)
#pragma unroll
            for (int b = 0; b < 2; ++b)
#pragma unroll
                for (int m = 0; m < 4; ++m)
#pragma unroll
                    for (int n = 0; n < 2; ++n) acc[a][b][m][n] = (f32x4){0.f, 0.f, 0.f, 0.f};
        cur = nxt; cA = nA; cB = nB; ++ui;
        if constexpr (ALIGN_EPI) { if (wr == 1) PG8_BAR; }
    }
    PG8_WAIT_V(0);
    if constexpr (!ALIGN_EPI) { if (wr == 0) PG8_BAR; }
    PG8_BAR;
    if constexpr (Epi::AFTER_DRAIN) { E.fused(acc, cur, wr, wc, fr, fq, lds, wid, lane); S.done(cur); }
#undef PG8_SA
#undef PG8_SB
#undef PG8_STAGE
#undef PG8_LDA
#undef PG8_LDB
#undef PG8_MMA
#undef PG8_WAIT_V
#undef PG8_WAIT_L
#undef PG8_BAR
#undef PG8_SCHED
}
}

#ifndef PG8_SP2
#define PG8_SP2 true
#endif
#ifndef PG8_ALIGN
#define PG8_ALIGN true
#endif
#include <hip/hip_bf16.h>
#include <cmath>
namespace attn_body {
using bf16=__hip_bfloat16;
using bf16x8=__attribute__((ext_vector_type(8)))short;
using s16x4=__attribute__((ext_vector_type(4)))short;
using f32x16=__attribute__((ext_vector_type(16)))float;
using u32x4=__attribute__((ext_vector_type(4)))unsigned;
using u32x2=__attribute__((ext_vector_type(2)))unsigned;
using f32x4v=__attribute__((ext_vector_type(4)))float;
constexpr int BATCH=8,NHEAD=8,SEQ=4096,D=64,DM=NHEAD*D,OPITCH=1024;
constexpr long QKV_BPAD=((long)SEQ*2816*2-(long)SEQ*DM*2)/2;
constexpr int NW=8,QBLK=32,QB=QBLK*NW,KVBLK=64,NQB=SEQ/QB;
constexpr int ATTN_PITCH=DM, ATTN_UNIT_ROWS=QB;
__device__ __forceinline__ int crow(int r,int hi){return (r&3)+8*(r>>2)+4*hi;}
#define SBAR() __builtin_amdgcn_sched_barrier(0)
__device__ __forceinline__ void cmask(f32x16&p0,f32x16&p1,int jb,int qrel,int hi){
  const float NEG=-INFINITY; int kb=64*jb+4*hi;
  #pragma unroll
  for(int r=0;r<16;++r){int kv=kb+(r&3)+8*(r>>2); if(kv>qrel)p0[r]=NEG; if(kv+32>qrel)p1[r]=NEG;}
}

constexpr int NSLOT=3, SLOTB=8192;
constexpr int LDS_K=0, LDS_V=NSLOT*SLOTB, LDS_WS=2*NSLOT*SLOTB, LDS_OST=LDS_WS+NW*64*4, LDS_BIAS=LDS_OST+NW*4096, LDS_RED=135168, LDS_BYTES=LDS_RED+1024;   static_assert(LDS_BIAS+SEQ*8<=LDS_RED,"attn lds");
constexpr float C2=0.125f*1.4426950408889634f;
__device__ __forceinline__ void glds16(const void*gsrc,unsigned lds_dst){unsigned keep;
  asm volatile("s_mov_b32 %0, m0\n\ts_mov_b32 m0, %2\n\ts_nop 0\n\tglobal_load_lds_dwordx4 %1, off\n\ts_mov_b32 m0, %0":"=&s"(keep):"v"(gsrc),"s"(lds_dst):"memory");}
__device__ __forceinline__ float max3f(float a,float b,float c){float r;asm("v_max3_f32 %0, %1, %2, %3":"=v"(r):"v"(a),"v"(b),"v"(c));return r;}
__device__ __forceinline__ float max2f(float a,float b){float r;asm("v_max_f32_e32 %0, %1, %2":"=v"(r):"v"(a),"v"(b));return r;}
__device__ __forceinline__ float fadd_s(float a,float b){float r;asm("v_add_f32_e32 %0, %1, %2":"=v"(r):"v"(a),"v"(b));return r;}
__device__ __forceinline__ float fsub_s(float a,float b){float r;asm("v_sub_f32_e32 %0, %1, %2":"=v"(r):"v"(a),"v"(b));return r;}
typedef float f32x2_t __attribute__((ext_vector_type(2))); typedef __bf16 bf16x2_t __attribute__((ext_vector_type(2)));
__device__ __forceinline__ unsigned cvtpk_s(float lo,float hi){f32x2_t v={lo,hi};bf16x2_t b=__builtin_convertvector(v,bf16x2_t);return __builtin_bit_cast(unsigned,b);}
#define WAIT_BAR(N) asm volatile("s_waitcnt vmcnt(" #N ") lgkmcnt(0)\n\ts_barrier":::"memory")

__device__ __forceinline__ void qkt(f32x16&p0,f32x16&p1,const char*Kslot,const bf16x8*qr,const f32x16&negm,int r32,int hi,bf16x8 kx0,bf16x8 kx1,bf16x8 qx){
  const char*kb=Kslot+hi*1024+r32*16;
  p0=__builtin_amdgcn_mfma_f32_32x32x16_bf16(kx0,qx,negm,0,0,0);p1=__builtin_amdgcn_mfma_f32_32x32x16_bf16(kx1,qx,negm,0,0,0);
  #pragma unroll
  for(int d0=0;d0<4;++d0){
    const bf16x8 b0=*reinterpret_cast<const bf16x8*>(kb+d0*2048);
    const bf16x8 b1=*reinterpret_cast<const bf16x8*>(kb+d0*2048+512);
    p0=__builtin_amdgcn_mfma_f32_32x32x16_bf16(b0,qr[d0],p0,0,0,0);p1=__builtin_amdgcn_mfma_f32_32x32x16_bf16(b1,qr[d0],p1,0,0,0);}
}
typedef __attribute__((address_space(3))) const char* lds_cptr;
typedef short v4i16_t __attribute__((ext_vector_type(4)));
__device__ __forceinline__ void kload8(bf16x8*kf,lds_cptr kp){
  kf[0]=*(const __attribute__((address_space(3))) bf16x8*)(kp);      kf[1]=*(const __attribute__((address_space(3))) bf16x8*)(kp+512);
  kf[2]=*(const __attribute__((address_space(3))) bf16x8*)(kp+2048); kf[3]=*(const __attribute__((address_space(3))) bf16x8*)(kp+2560);
  kf[4]=*(const __attribute__((address_space(3))) bf16x8*)(kp+4096); kf[5]=*(const __attribute__((address_space(3))) bf16x8*)(kp+4608);
  kf[6]=*(const __attribute__((address_space(3))) bf16x8*)(kp+6144); kf[7]=*(const __attribute__((address_space(3))) bf16x8*)(kp+6656);
}
__device__ __forceinline__ void kload2(bf16x8*kf,lds_cptr kp,int j){ kf[2*j]=*(const __attribute__((address_space(3))) bf16x8*)(kp+j*2048); kf[2*j+1]=*(const __attribute__((address_space(3))) bf16x8*)(kp+j*2048+512); }
__device__ __forceinline__ s16x4 vtr(lds_cptr p){ return __builtin_bit_cast(s16x4,__builtin_amdgcn_ds_read_tr16_b64_v4i16((__attribute__((address_space(3))) v4i16_t*)p)); }
__device__ __forceinline__ float rowmax(const f32x16&p0,const f32x16&p1){
  float a=max3f(p0[0],p0[1],p1[0]),b=max3f(p0[2],p0[3],p1[1]);a=max3f(a,p1[2],p1[3]);
  #pragma unroll
  for(int r=4;r<16;r+=4){a=max3f(a,p0[r],p0[r+1]);b=max3f(b,p0[r+2],p0[r+3]);a=max3f(a,p1[r],p1[r+1]);b=max3f(b,p1[r+2],p1[r+3]);}
  const float m=max2f(a,b);
  auto rr=__builtin_amdgcn_permlane32_swap(__float_as_uint(m),__float_as_uint(m),false,false);
  return max2f(__uint_as_float(rr[0]),__uint_as_float(rr[1]));
}
__device__ __forceinline__ void pv(f32x16*o,int vb,bf16x8 pa0,bf16x8 pa1,bf16x8 pa2,bf16x8 pa3){
  #pragma unroll
  for(int d0=0;d0<2;++d0){s16x4 lo[4],hi[4];
    #pragma unroll
    for(int ks=0;ks<4;++ks){
      asm volatile("ds_read_b64_tr_b16 %0,%1 offset:%c2":"=&v"(lo[ks]):"v"(vb),"i"(d0*4096+ks*1024):"memory");
      asm volatile("ds_read_b64_tr_b16 %0,%1 offset:%c2":"=&v"(hi[ks]):"v"(vb),"i"(d0*4096+ks*1024+512):"memory");}
    asm volatile("s_waitcnt lgkmcnt(0)":::"memory");SBAR();
    #define PK(k) (bf16x8){lo[k][0],lo[k][1],lo[k][2],lo[k][3],hi[k][0],hi[k][1],hi[k][2],hi[k][3]}
    o[d0]=__builtin_amdgcn_mfma_f32_32x32x16_bf16(pa0,PK(0),o[d0],0,0,0);
    o[d0]=__builtin_amdgcn_mfma_f32_32x32x16_bf16(pa1,PK(1),o[d0],0,0,0);
    o[d0]=__builtin_amdgcn_mfma_f32_32x32x16_bf16(pa2,PK(2),o[d0],0,0,0);
    o[d0]=__builtin_amdgcn_mfma_f32_32x32x16_bf16(pa3,PK(3),o[d0],0,0,0);
    #undef PK
  }
}

#ifndef ATTN_STORE16
#define ATTN_STORE16(p,v) (*(u32x4*)(p)=(v))
#endif
template<int THRL> __device__ __forceinline__ void attn_unit(int b,int h,int qb,const bf16*Q,const bf16*__restrict__ K,const bf16*__restrict__ V,bf16*O,int ts_in,const float*__restrict__ cumh,float*ssb,char*shm){
  const int tid=otid(),lane=tid&63,r32=lane&31,hi=lane>>5; const int wid=__builtin_amdgcn_readfirstlane(tid>>6);
  const long rowbase=(long)b*SEQ; const int q0=qb*QB;
  const bf16*Qw=Q+(long)b*QKV_BPAD+(rowbase+q0+wid*QBLK)*DM+h*D;
  const bf16*Kh=K+(long)b*QKV_BPAD+rowbase*DM+h*D,*Vh=V+(long)b*QKV_BPAD+rowbase*DM+h*D;
  const lds_cptr shm3=(lds_cptr)shm;
  const unsigned lds0=(unsigned)(uintptr_t)shm;
  float*wsf=(float*)(shm+LDS_WS)+wid*64;
  const bf16*ksrc0=Kh+(long)lane*DM+wid*8;
  const bf16*vsrc0=Vh+(long)(16*(wid&3)+(lane>>2))*DM+(wid>>2)*32+(lane&3)*8;
  const unsigned kdst=lds0+LDS_K+wid*1024, vdst=lds0+LDS_V+wid*1024;
  #define DMA_K(t,slot) glds16(ksrc+(long)(t)*KVBLK*DM,(unsigned)__builtin_amdgcn_readfirstlane(kdst+(slot)))
  #define DMA_V(t,slot) glds16(vsrc+(long)(t)*KVBLK*DM,(unsigned)__builtin_amdgcn_readfirstlane(vdst+(slot)))
  const int vb0=(int)(lds0+LDS_V)+((lane>>4)&1)*32+(lane&3)*8+(4*hi+((lane&15)>>2))*64;
  const char*Kbase=shm+LDS_K; bf16x8 kf[8];
  const lds_cptr kp0=shm3+LDS_K+hi*1024+r32*16; const lds_cptr vp0=shm3+LDS_V+((lane>>4)&1)*32+(lane&3)*8+(4*hi+((lane&15)>>2))*64;
  int NT=(q0+QB)/KVBLK;
  const int ts=__builtin_amdgcn_readfirstlane(ts_in);
  const bf16*ksrc=ksrc0+(long)ts*KVBLK*DM; const bf16*vsrc=vsrc0+(long)ts*KVBLK*DM; NT-=ts;
  const lds_cptr bp0=shm3+LDS_BIAS+r32*8+ts*512;
  bf16x8 qx; { const u32x4 t=(hi==0)?(u32x4){0x3F803F80u,0x00003F80u,0u,0u}:(u32x4){0u,0u,0u,0u}; qx=__builtin_bit_cast(bf16x8,t); }
  #define BIASLD(t,which) ({ const u32x2 w_=*(const __attribute__((address_space(3))) u32x2*)(bp0+(t)*512+(which)*256); const u32x4 t_=(u32x4){w_.x,w_.y,0u,0u}; __builtin_bit_cast(bf16x8,t_); })
  DMA_K(0,0);DMA_V(0,0);DMA_K(1,SLOTB);
  bf16x8 qr[4];
  #pragma unroll
  for(int d0=0;d0<4;++d0)qr[d0]=*reinterpret_cast<const bf16x8*>(&Qw[(long)r32*DM+d0*16+hi*8]);
  float mhat=0.f,l_reg=0.f;f32x16 o[2];o[0]=f32x16{};o[1]=f32x16{};f32x16 negm=f32x16{};asm volatile("":"+v"(negm));
  const int qrel=wid*QBLK+r32;
  #define CMASK(P0,P1,t) do{int jb_=(t)-(NT-4); if(jb_>=0)cmask(P0,P1,jb_,qrel,hi);}while(0)
  bool resc=false;
  #define START(P0,P1) do{ const float rm=rowmax(P0,P1); resc=false; \
    { const float dl=rm; mhat=fadd_s(mhat,dl); \
      _Pragma("unroll") for(int r=0;r<16;++r){P0[r]=fsub_s(P0[r],dl);P1[r]=fsub_s(P1[r],dl);} \
      _Pragma("unroll") for(int r=0;r<16;++r)negm[r]=-mhat; asm volatile("":"+v"(negm)); } \
    _Pragma("unroll") for(int r=0;r<16;++r)P0[r]=__builtin_amdgcn_exp2f(P0[r]); }while(0)
  #define RESC() do{ if(resc){ asm volatile("s_waitcnt lgkmcnt(0)":::"memory"); \
      _Pragma("unroll") for(int d_=0;d_<2;++d_) _Pragma("unroll") for(int r=0;r<16;++r)o[d_][r]*=wsf[crow(r,hi)]; } }while(0)
  f32x16 pA0,pA1,pB0,pB1;
  int sl_prev=0,sl_cur=0,sl_next=SLOTB;
  #define ROT() do{sl_prev=sl_cur;sl_cur=sl_next;sl_next=(sl_next==(NSLOT-1)*SLOTB)?0:sl_next+SLOTB;}while(0)
  DMA_K(2,2*SLOTB);
  { const float cref=cumh[q0]; const int nk=q0+QB;
    float cv[SEQ/(NW*64)];
    #pragma unroll
    for(int k=0;k<SEQ/(NW*64);++k){ const int i=tid+k*NW*64; cv[k]=(i<nk)?cumh[i]:0.f; }
    #pragma unroll
    for(int k=0;k<SEQ/(NW*64);++k){ const int i=tid+k*NW*64; if(i<nk){ const float x=cref-cv[k]; const unsigned u1=__float_as_uint(x)&0xffff0000u; const float r1=x-__uint_as_float(u1);
      const unsigned u2=__float_as_uint(r1)&0xffff0000u; const float r2=r1-__uint_as_float(u2); const unsigned u3=__float_as_uint(r2)&0xffff0000u;
      u32x2 w; w.x=(u1>>16)|u2; w.y=u3>>16; *(__attribute__((address_space(3))) u32x2*)(shm3+LDS_BIAS+i*8)=w; } } }
  WAIT_BAR(3);
  qkt(pA0,pA1,Kbase,qr,negm,r32,hi,BIASLD(0,0),BIASLD(0,1),qx);asm volatile("s_nop 15\n\ts_nop 7":"+v"(pA0),"+v"(pA1));CMASK(pA0,pA1,0);
  START(pA0,pA1);
  _Pragma("unroll") for(int r=0;r<16;++r)pA1[r]=__builtin_amdgcn_exp2f(pA1[r]);
  WAIT_BAR(0);
  DMA_K(3,0);DMA_V(1,SLOTB);
  ROT();
  kload8(kf,kp0+sl_cur);
  WAIT_BAR(2);
  s16x4 vlo[8],vhi[8]; u32x4 pw0,pw1,pw2,pw3;
  #define PKW(P,B) cvtpk_s(P[B],P[B+1])
  #define PAF(k) __builtin_bit_cast(bf16x8,pw##k)
  #define VFR(i) (bf16x8){vlo[i][0],vlo[i][1],vlo[i][2],vlo[i][3],vhi[i][0],vhi[i][1],vhi[i][2],vhi[i][3]}
  #define PIN(x) asm volatile("":"+v"(x))
  #define MX3(a,b,c) __builtin_fmaxf(__builtin_fmaxf((a),(b)),(c))
  #define GAPA(MF,A0,A1,A2,A3,W0,W1,PW) do{ MF; sacc+=A0; sacc+=A1; sacc+=A2; sacc+=A3; PIN(sacc); W0; W1; PIN(PW); SBAR(); }while(0)
  #define EX(v) __builtin_amdgcn_exp2f(v)
  #define GAPB(MF,X,B) do{ MF; X[B]=EX(X[B]); X[B+1]=EX(X[B+1]); X[B+2]=EX(X[B+2]); X[B+3]=EX(X[B+3]); PIN(X); SBAR(); }while(0)
  #define VRD(i) do{ vlo[i]=vtr(vp_+(((i)>>2)*4096+((i)&3)*1024)); vhi[i]=vtr(vp_+(((i)>>2)*4096+((i)&3)*1024+512)); }while(0)
  #define KRD(G,j) do{ if(G){ kload2(kf,kp0+sl_next,j); SBAR(); } }while(0)
  #define STEP(C0,C1,P0,P1,t,GK,GV,GL) do{ SBAR(); \
    const lds_cptr vp_=vp0+sl_prev; \
    C0=__builtin_amdgcn_mfma_f32_32x32x16_bf16(kbx0,qx,negm,0,0,0); C1=__builtin_amdgcn_mfma_f32_32x32x16_bf16(kbx1,qx,negm,0,0,0); SBAR(); \
    VRD(0); SBAR(); float sacc=(P0[0]+P0[1]); \
    GAPA(C0=__builtin_amdgcn_mfma_f32_32x32x16_bf16(kf[0],qr[0],C0,0,0,0), P0[2],P0[3],P0[4],P0[5],     pw0[0]=PKW(P0,0), pw0[1]=PKW(P0,2), pw0); \
    VRD(4); SBAR(); GAPA(C1=__builtin_amdgcn_mfma_f32_32x32x16_bf16(kf[1],qr[0],C1,0,0,0), P0[6],P0[7],P0[8],P0[9],     pw0[2]=PKW(P0,4), pw0[3]=PKW(P0,6), pw0); \
    VRD(1); SBAR(); GAPA(C0=__builtin_amdgcn_mfma_f32_32x32x16_bf16(kf[2],qr[1],C0,0,0,0),   P0[10],P0[11],P0[12],P0[13], pw1[0]=PKW(P0,8), pw1[1]=PKW(P0,10), pw1); \
    VRD(5); SBAR(); GAPA(C1=__builtin_amdgcn_mfma_f32_32x32x16_bf16(kf[3],qr[1],C1,0,0,0),   P0[14],P0[15],P1[0],P1[1],   pw1[2]=PKW(P0,12),pw1[3]=PKW(P0,14), pw1); \
    VRD(2); SBAR(); GAPA(C0=__builtin_amdgcn_mfma_f32_32x32x16_bf16(kf[4],qr[2],C0,0,0,0),   P1[2],P1[3],P1[4],P1[5],     pw2[0]=PKW(P1,0), pw2[1]=PKW(P1,2), pw2); \
    VRD(6); SBAR(); GAPA(C1=__builtin_amdgcn_mfma_f32_32x32x16_bf16(kf[5],qr[2],C1,0,0,0),   P1[6],P1[7],P1[8],P1[9],     pw2[2]=PKW(P1,4), pw2[3]=PKW(P1,6), pw2); \
    VRD(3); SBAR(); GAPA(C0=__builtin_amdgcn_mfma_f32_32x32x16_bf16(kf[6],qr[3],C0,0,0,0),   P1[10],P1[11],P1[12],P1[13], pw3[0]=PKW(P1,8), pw3[1]=PKW(P1,10), pw3); \
    VRD(7); SBAR(); GAPA(C1=__builtin_amdgcn_mfma_f32_32x32x16_bf16(kf[7],qr[3],C1,0,0,0),   P1[14],P1[15],0.f,0.f,       pw3[2]=PKW(P1,12),pw3[3]=PKW(P1,14), pw3); \
    l_reg+=sacc; \
    if(GK){DMA_K((t)+3,sl_cur);} if(GV){DMA_V((t)+1,sl_next);} \
    CMASK(C0,C1,t); \
    { float a=MX3(C0[0],C0[1],C1[0]),b=MX3(C0[2],C0[3],C1[1]); a=MX3(a,C1[2],C1[3]); \
      _Pragma("unroll") for(int r=4;r<16;r+=4){a=MX3(a,C0[r],C0[r+1]);b=MX3(b,C0[r+2],C0[r+3]);a=MX3(a,C1[r],C1[r+1]);b=MX3(b,C1[r+2],C1[r+3]);} \
      float rm=__builtin_fmaxf(a,b); { auto rr=__builtin_amdgcn_permlane32_swap(__float_as_uint(rm),__float_as_uint(rm),false,false); rm=__builtin_fmaxf(__uint_as_float(rr[0]),__uint_as_float(rr[1])); } \
      resc=false; \
      if(__builtin_expect(__any(rm>(float)THRL),0)){ const float dl=__builtin_fmaxf(rm,0.f); mhat+=dl; \
        _Pragma("unroll") for(int r=0;r<16;++r){C0[r]-=dl;C1[r]-=dl;} \
        _Pragma("unroll") for(int r=0;r<16;++r)negm[r]=-mhat; asm volatile("":"+v"(negm)); \
        const float f=__builtin_amdgcn_exp2f(-dl); l_reg*=f; if(hi==0)wsf[r32]=f; resc=true; } } \
    SBAR(); \
    GAPB(o[0]=__builtin_amdgcn_mfma_f32_32x32x16_bf16(PAF(0),VFR(0),o[0],0,0,0), C0,0); \
    GAPB(o[1]=__builtin_amdgcn_mfma_f32_32x32x16_bf16(PAF(0),VFR(4),o[1],0,0,0), C0,4); \
    KRD(GL,0); GAPB(o[0]=__builtin_amdgcn_mfma_f32_32x32x16_bf16(PAF(1),VFR(1),o[0],0,0,0), C0,8); \
    KRD(GL,1); GAPB(o[1]=__builtin_amdgcn_mfma_f32_32x32x16_bf16(PAF(1),VFR(5),o[1],0,0,0), C0,12); \
    KRD(GL,2); GAPB(o[0]=__builtin_amdgcn_mfma_f32_32x32x16_bf16(PAF(2),VFR(2),o[0],0,0,0), C1,0); \
    KRD(GL,3); GAPB(o[1]=__builtin_amdgcn_mfma_f32_32x32x16_bf16(PAF(2),VFR(6),o[1],0,0,0), C1,4); \
    GAPB(o[0]=__builtin_amdgcn_mfma_f32_32x32x16_bf16(PAF(3),VFR(3),o[0],0,0,0), C1,8); \
    GAPB(o[1]=__builtin_amdgcn_mfma_f32_32x32x16_bf16(PAF(3),VFR(7),o[1],0,0,0), C1,12); \
    if(GL){ kbx0=BIASLD((t)+1,0); kbx1=BIASLD((t)+1,1); } \
    }while(0)
  int t=1; bf16x8 kbx0=BIASLD(1,0),kbx1=BIASLD(1,1);
  #undef CMASK
  #define CMASK(P0,P1,t) do{}while(0)
  for(;t+5<NT;t+=2){
    STEP(pB0,pB1,pA0,pA1,t,true,true,true);     WAIT_BAR(2); RESC(); ROT();
    STEP(pA0,pA1,pB0,pB1,t+1,true,true,true);   WAIT_BAR(2); RESC(); ROT();
  }
  #undef CMASK
  #define CMASK(P0,P1,t) do{int jb_=(t)-(NT-4); if(jb_>=0)cmask(P0,P1,jb_,qrel,hi);}while(0)
  #define ENDW(tt) do{ if((tt)+3<NT){WAIT_BAR(2);} else if((tt)+2<NT){WAIT_BAR(1);} else {WAIT_BAR(0);} }while(0)
  for(;t+1<NT;t+=2){
    STEP(pB0,pB1,pA0,pA1,t,(t+3<NT),(t+1<NT),(t+1<NT));       ENDW(t);   RESC(); ROT();
    STEP(pA0,pA1,pB0,pB1,t+1,(t+4<NT),(t+2<NT),(t+2<NT));     ENDW(t+1); RESC(); ROT();
  }
  STEP(pB0,pB1,pA0,pA1,NT-1,false,false,false); RESC();
  { float sacc=pB0[0]+pB0[1]; _Pragma("unroll") for(int r=2;r<16;++r)sacc+=pB0[r]; _Pragma("unroll") for(int r=0;r<16;++r)sacc+=pB1[r]; l_reg+=sacc;
    pw0=(u32x4){PKW(pB0,0),PKW(pB0,2),PKW(pB0,4),PKW(pB0,6)};pw1=(u32x4){PKW(pB0,8),PKW(pB0,10),PKW(pB0,12),PKW(pB0,14)};pw2=(u32x4){PKW(pB1,0),PKW(pB1,2),PKW(pB1,4),PKW(pB1,6)};pw3=(u32x4){PKW(pB1,8),PKW(pB1,10),PKW(pB1,12),PKW(pB1,14)};
    SBAR(); pv(o,vb0+sl_cur,PAF(0),PAF(1),PAF(2),PAF(3)); }
  #undef PKW
  #undef PAF
  #undef VFR
  #undef PIN
  #undef MX3
  #undef GAPA
  #undef GAPB
  #undef EX
  #undef VRD
  #undef KRD
  #undef STEP
  #undef ENDW
  {auto rr=__builtin_amdgcn_permlane32_swap(__float_as_uint(l_reg),__float_as_uint(l_reg),false,false);l_reg=__uint_as_float(rr[0])+__uint_as_float(rr[1]);}
  if(hi==0)wsf[32+r32]=l_reg;asm volatile("s_waitcnt lgkmcnt(0)":::"memory");
  float rli[16];
  #pragma unroll
  for(int r=0;r<16;++r)rli[r]=__builtin_amdgcn_rcpf(wsf[32+crow(r,hi)]);
  bf16*Ow=O+(rowbase+q0+wid*QBLK)*OPITCH+h*D; float*ssw=ssb+(long)h*(BATCH*SEQ)+rowbase+q0+wid*QBLK;
  { bf16*stg=(bf16*)(shm+LDS_OST)+wid*2048;
    #pragma unroll
    for(int r=0;r<16;++r){const int orow=crow(r,hi);
      #pragma unroll
      for(int d0=0;d0<2;++d0)stg[orow*64+d0*32+r32]=__float2bfloat16(o[d0][r]*rli[r]);}
    asm volatile("s_waitcnt lgkmcnt(0)":::"memory");
    #pragma unroll
    for(int i=0;i<4;++i){const int row=i*8+(lane>>3),ch=lane&7; const u32x4 v=*(const u32x4*)(stg+row*64+ch*8); ATTN_STORE16(Ow+(long)row*OPITCH+ch*8,v);
      float q=0.f;
      #pragma unroll
      for(int e=0;e<4;++e){const float lo=__uint_as_float(v[e]<<16),hi2=__uint_as_float(v[e]&0xffff0000u); q+=lo*lo+hi2*hi2;}
      q+=__shfl_xor(q,1);q+=__shfl_xor(q,2);q+=__shfl_xor(q,4); if(ch==0)ssw[row]=q;} }
  asm volatile("s_waitcnt lgkmcnt(0)\n\ts_barrier":::"memory");
  #undef DMA_K
  #undef DMA_V
  #undef BIASLD
  #undef CMASK
  #undef START
  #undef RESC
  #undef ROT
}
constexpr int ATTN_LDS_BYTES=LDS_BYTES;
struct AttnTensors { const bf16* Q; const bf16* K; const bf16* V; bf16* O; const float* cum2; float* ssb; float* kpart; };
struct AttnUnit { int bh; int qb; };
struct StaticOrder {
  int vcu;
  __device__ __forceinline__ explicit StaticOrder(int grid,int block):vcu((block%8)*(grid/8)+block/8){}
  __device__ __forceinline__ bool next(int i,AttnUnit&u)const{ if(i>=4||vcu>=256)return false; const int s=(vcu>>3)&3,h0=vcu&7; u.bh=(vcu>>5)*NHEAD+((h0+2*i)&7); u.qb=(i==0)?s:(i==1)?7-s:(i==2)?8+s:15-s; return true; }
  __device__ __forceinline__ void a_ready(const AttnUnit&)const{}
  __device__ __forceinline__ void done(const AttnUnit&)const{}
};
template<class Sched> __device__ __forceinline__ void attn_pre(char*lds,const AttnTensors&T,const Sched&S){
  AttnUnit u;
  if(!S.next(0,u))return;
  const int tid=otid(),lane=tid&63; const int wid=__builtin_amdgcn_readfirstlane(tid>>6); const int b=u.bh/NHEAD;
  typedef __attribute__((address_space(3))) float ldsf;
  ldsf*red=(ldsf*)((lds_cptr)lds+LDS_RED);
  { const int hk=S.vcu&7,sk=(S.vcu>>3)&3; float mx=0.f; const bf16*Kh=T.K+(long)b*QKV_BPAD+((long)b*SEQ+sk*(SEQ/4))*DM+hk*D;
    for(int r=tid;r<SEQ/4;r+=NW*64){ const u32x4*pr=(const u32x4*)(Kh+(long)r*DM); float q=0.f;
      #pragma unroll
      for(int c=0;c<8;++c){ const u32x4 v=pr[c];
        #pragma unroll
        for(int e=0;e<4;++e){ const float lo=__uint_as_float(v[e]<<16),hi2=__uint_as_float(v[e]&0xffff0000u); q+=lo*lo+hi2*hi2; } }
      mx=fmaxf(mx,q); }
    #pragma unroll
    for(int o=1;o<64;o<<=1)mx=fmaxf(mx,__shfl_xor(mx,o));
    if(lane==0)red[wid]=mx;
    __syncthreads();
    if(tid==0){ float m=0.f;
      #pragma unroll
      for(int w=0;w<NW;++w)m=fmaxf(m,red[w]);
      T.kpart[(b*NHEAD+hk)*4+sk]=m; } }
  for(int ui=0;ui<4;++ui){ AttnUnit uu; if(!S.next(ui,uu))break; const int h=uu.bh%NHEAD;
    const long row=(long)b*SEQ+uu.qb*QB+(tid>>1);
    const u32x4*pr=(const u32x4*)(T.Q+(long)b*QKV_BPAD+row*DM+h*D+(tid&1)*32); const u32x4*pk=(const u32x4*)(T.K+(long)b*QKV_BPAD+row*DM+h*D+(tid&1)*32); float q=0.f,dg=0.f;
    #pragma unroll
    for(int c=0;c<4;++c){ const u32x4 v=pr[c],kv=pk[c];
      #pragma unroll
      for(int e=0;e<4;++e){ const float lo=__uint_as_float(v[e]<<16),hi2=__uint_as_float(v[e]&0xffff0000u); q+=lo*lo+hi2*hi2;
        dg+=lo*__uint_as_float(kv[e]<<16)+hi2*__uint_as_float(kv[e]&0xffff0000u); } }
    q+=__shfl_xor(q,1); dg+=__shfl_xor(dg,1);
    dg+=T.cum2[(long)uu.bh*SEQ+uu.qb*QB]-T.cum2[(long)uu.bh*SEQ+uu.qb*QB+(tid>>1)];
    #pragma unroll
    for(int o=2;o<64;o<<=1){q=fmaxf(q,__shfl_xor(q,o));dg=fminf(dg,__shfl_xor(dg,o));}
    if(lane==0){red[8+ui*8+wid]=q;red[96+ui*8+wid]=dg;} }
  __syncthreads();
}
template<class Sched,int THRL=24> __device__ __forceinline__ void attn_run(char*lds,const AttnTensors&T,const Sched&S){
  AttnUnit u;
  int tsv[4]={0,0,0,0};
  { const int tid=otid(),lane=tid&63; const int wid=__builtin_amdgcn_readfirstlane(tid>>6);
    typedef __attribute__((address_space(3))) float ldsf; ldsf*red=(ldsf*)((lds_cptr)lds+LDS_RED);
    float cv[4][SEQ/(NW*64)],cref[4],bnd[4]; int nk[4];
    #pragma unroll
    for(int i=0;i<4;++i){ AttnUnit uu; if(!S.next(i,uu)){uu=AttnUnit{0,0};nk[i]=0;} else nk[i]=(uu.qb+1)*QB;
      const float*cumh=T.cum2+(long)uu.bh*SEQ; cref[i]=cumh[uu.qb*QB];
      #pragma unroll
      for(int k=0;k<SEQ/(NW*64);++k){ const int j=tid+k*NW*64; cv[i][k]=(j<nk[i])?cumh[j]:0.f; }
      float q2=0.f,dmin=3.0e38f; const float*kp=T.kpart+uu.bh*4; const float k2=fmaxf(fmaxf(kp[0],kp[1]),fmaxf(kp[2],kp[3]));
      #pragma unroll
      for(int w=0;w<NW;++w){q2=fmaxf(q2,red[8+i*8+w]);dmin=fminf(dmin,red[96+i*8+w]);}
      const float qk=sqrtf(k2*q2)*1.001f;
      bnd[i]=qk+32.0f+0.05f-fmaxf(fminf(dmin,0.f),-qk); }
    #pragma unroll
    for(int i=0;i<4;++i){ int cnt=0;
      #pragma unroll
      for(int k=0;k<SEQ/(NW*64);++k){ const int j=tid+k*NW*64; cnt+=(j<nk[i]&&(cref[i]-cv[i][k])<=-bnd[i])?1:0; }
      #pragma unroll
      for(int o=1;o<64;o<<=1)cnt+=__shfl_xor(cnt,o);
      if(lane==0)red[64+i*8+wid]=(float)cnt; }
    __syncthreads();
    #pragma unroll
    for(int i=0;i<4;++i){ float tot=0.f;
      #pragma unroll
      for(int w=0;w<NW;++w)tot+=red[64+i*8+w];
      int ts=((int)tot>>6)&~1; const int ntm=nk[i]/KVBLK-4; if(ts>ntm)ts=ntm; if(ts<0)ts=0; tsv[i]=ts; } }
  for(int i=0;S.next(i,u);++i){ S.a_ready(u);
    const int ts=i==0?tsv[0]:(i==1?tsv[1]:(i==2?tsv[2]:tsv[3]));
    attn_unit<THRL>(u.bh/NHEAD,u.bh%NHEAD,u.qb,T.Q,T.K,T.V,T.O,ts,T.cum2+(long)u.bh*SEQ,T.ssb,lds); S.done(u); }
}
#undef SBAR
#undef WAIT_BAR
}
constexpr int NWAVES = 8;
constexpr int BATCH = 8, SEQ = 4096, DM_ = 1024, DFF = 2816, NIN = 2568, DA = 512, HA = 8, HB = 8;
constexpr int M = BATCH * SEQ;
constexpr float EPS = 1e-6f;
constexpr size_t MiB = 1u << 20;
constexpr size_t WS_MOD = 0;
constexpr size_t WS_LOGF = 1 * MiB;
constexpr size_t WS_CUM = 2 * MiB;
constexpr size_t WS_SS = 3 * MiB;
constexpr size_t WS_SSA = 5 * MiB;
constexpr size_t WS_SSB = 6 * MiB;
constexpr size_t WS_WGU0 = 8 * MiB;
constexpr size_t WS_WGU1 = 20 * MiB;
constexpr size_t WS_WD0 = 32 * MiB;
constexpr size_t WS_WD1 = 38 * MiB;
constexpr size_t WS_WIN = 44 * MiB;
constexpr size_t WS_WOUT = 50 * MiB;
constexpr size_t WS_H = 64 * MiB;
constexpr size_t WS_HD = 128 * MiB;
constexpr size_t WS_ACT = 192 * MiB;
constexpr size_t BSLAB = (size_t)SEQ * DFF * 2;
constexpr size_t WS_ZG = WS_ACT;
constexpr size_t WS_Q = WS_ACT + 8 * MiB, WS_K = WS_ACT + 12 * MiB, WS_V = WS_ACT + 16 * MiB;
constexpr size_t PAD_ZG = (BSLAB - (size_t)SEQ * 1024 * 2) / 2, PAD_QKV = (BSLAB - (size_t)SEQ * 512 * 2) / 2;
static_assert(BSLAB == 22 * MiB && 8 * MiB + 3 * (size_t)SEQ * 512 * 2 <= BSLAB, "slab map");
constexpr size_t WS_Y = WS_H;
constexpr size_t WS_X1 = 416 * MiB;
constexpr size_t WS_END = 480 * MiB;
static_assert(WS_ACT + (size_t)M * DFF * 2 <= 416 * MiB && WS_X1 + (size_t)M * 1024 * 2 <= WS_END, "ws map");
constexpr int LDS_BYTES = 147456;
constexpr int LDS_BARST = LDS_BYTES - 64;
constexpr size_t WS_KPART = 7 * MiB + 65536;
constexpr size_t WS_CTL = 7 * MiB, CTL_BYTES = 16384;

#define GAS __attribute__((address_space(1)))
#define LAS __attribute__((address_space(3)))
typedef unsigned short bf16;
typedef unsigned v4u __attribute__((ext_vector_type(4)));
typedef unsigned v2u __attribute__((ext_vector_type(2)));
typedef float f32x4 __attribute__((ext_vector_type(4)));
typedef short bf16x8 __attribute__((ext_vector_type(8)));
#define LDS_WAIT() asm volatile("s_waitcnt lgkmcnt(0)" ::: "memory")
__device__ __forceinline__ unsigned f2bf(float f) { unsigned u = __builtin_bit_cast(unsigned, f); return (u + 0x7fffu + ((u >> 16) & 1u)) >> 16; }
typedef float pk_f32x2 __attribute__((ext_vector_type(2))); typedef __bf16 pk_bf16x2 __attribute__((ext_vector_type(2)));
__device__ __forceinline__ unsigned pk2(float lo, float hi) { const pk_f32x2 v = {lo, hi}; return __builtin_bit_cast(unsigned, __builtin_convertvector(v, pk_bf16x2)); }
__device__ __forceinline__ float bf_lo(unsigned w) { return __builtin_bit_cast(float, w << 16); }
__device__ __forceinline__ float bf_hi(unsigned w) { return __builtin_bit_cast(float, w & 0xffff0000u); }
template <int CTRL> __device__ __forceinline__ float dpp_f(float v) { return __builtin_bit_cast(float, __builtin_amdgcn_update_dpp(0, __builtin_bit_cast(int, v), CTRL, 0xF, 0xF, false)); }
__device__ __forceinline__ float wave_sum(float v) {
    v += dpp_f<0xB1>(v); v += dpp_f<0x4E>(v); v += dpp_f<0x141>(v); v += dpp_f<0x140>(v);
    const float r0 = __builtin_bit_cast(float, __builtin_amdgcn_readlane(__builtin_bit_cast(int, v), 0)), r1 = __builtin_bit_cast(float, __builtin_amdgcn_readlane(__builtin_bit_cast(int, v), 16));
    const float r2 = __builtin_bit_cast(float, __builtin_amdgcn_readlane(__builtin_bit_cast(int, v), 32)), r3 = __builtin_bit_cast(float, __builtin_amdgcn_readlane(__builtin_bit_cast(int, v), 48));
    return (r0 + r1) + (r2 + r3);
}

#define XB_TMO      128
#define XB_XCNT(j)  (256  + 64 * (j))
#define XB_XSUB(j)  (1280 + 64 * (j))
#define XB_XGEN(j)  (2304 + 64 * (j))
#define XB_TOP      3328
#define XB_TOPGEN   3392
#define XCD_BAR_WORDS 3456
#define XB_SPIN_CAP (1u << 18)

__device__ __forceinline__ unsigned xb_ld(unsigned* p)              { return __hip_atomic_load(p, __ATOMIC_RELAXED, __HIP_MEMORY_SCOPE_AGENT); }
__device__ __forceinline__ unsigned xb_add(unsigned* p, unsigned v) { return __hip_atomic_fetch_add(p, v, __ATOMIC_RELAXED, __HIP_MEMORY_SCOPE_AGENT); }
__device__ __forceinline__ unsigned xb_xcc_id() { return (unsigned)__builtin_amdgcn_s_getreg((3 << 11) | 20) & 0xFu; }
#define XB_SPIN(cond, bar) do { unsigned _sp = 0; while (cond) { __builtin_amdgcn_s_sleep(1); \
    if ((++_sp & 255u) == 0u) { if (xb_ld(&(bar)[XB_TMO])) break; if (_sp > XB_SPIN_CAP) { atomicAdd(&(bar)[XB_TMO], 1u); break; } } } } while (0)

struct XcdBarrier {
    unsigned* bar; unsigned x;
    volatile LAS unsigned* st;
};

__device__ __forceinline__ XcdBarrier xcd_barrier_post(unsigned* bar, volatile LAS unsigned* st) {
    XcdBarrier b; b.bar = bar; b.x = xb_xcc_id(); b.st = st;
    if (threadIdx.x == 0) st[3] = xb_add(&bar[XB_XCNT(b.x)], 1u);
    return b;
}
__device__ __forceinline__ void xcd_barrier_complete(unsigned* bar, unsigned x, unsigned& nloc, unsigned& nx) {
    const unsigned G = gridDim.x * gridDim.y * gridDim.z;
    unsigned sum, cnt, mine, sp = 0u;
    for (;;) {
        sum = 0u; cnt = 0u; mine = 0u;
#pragma unroll
        for (unsigned j = 0; j < 16; ++j) { const unsigned c = xb_ld(&bar[XB_XCNT(j)]); sum += c; cnt += (c > 0u) ? 1u : 0u; mine = (j == x) ? c : mine; }
        if (sum == G) break;
        __builtin_amdgcn_s_sleep(1);
        if ((++sp & 255u) == 0u) { if (xb_ld(&bar[XB_TMO])) break; if (sp > XB_SPIN_CAP) { atomicAdd(&bar[XB_TMO], 1u); break; } }
    }
    nloc = mine > 0u ? mine : 1u; nx = cnt > 0u ? cnt : 1u;
}
__device__ __forceinline__ unsigned xcd_census_uniform(unsigned* bar) {
    unsigned ok = (gridDim.x == 256u) ? 1u : 0u;
#pragma unroll
    for (unsigned j = 0; j < 16; ++j) { const unsigned c = xb_ld(&bar[XB_XCNT(j)]); ok &= (c == (j < 8u ? 32u : 0u)) ? 1u : 0u; }
    return ok;
}

__device__ __forceinline__ void xcd_barrier(const XcdBarrier& b) {
    asm volatile("s_waitcnt vmcnt(0)" ::: "memory");
    __syncthreads();
    if (threadIdx.x == 0) {
        unsigned* bar = b.bar;
        __builtin_amdgcn_s_waitcnt(0);
        unsigned nloc = b.st[0], nx = b.st[1];
        if (nloc == 0u) { xcd_barrier_complete(bar, b.x, nloc, nx); b.st[0] = nloc; b.st[1] = nx; b.st[2] = xcd_census_uniform(bar); }
        const unsigned old = xb_add(&bar[XB_XSUB(b.x)], 1u);
        const unsigned gen = old / nloc;
        if (old + 1u == (gen + 1u) * nloc) {
            __builtin_amdgcn_fence(__ATOMIC_RELEASE, "agent");
            asm volatile("s_waitcnt vmcnt(0)" ::: "memory");
            const unsigned og = xb_add(&bar[XB_TOP], 1u);
            const unsigned tg = og / nx;
            if (og + 1u == (tg + 1u) * nx) xb_add(&bar[XB_TOPGEN], 1u);
            else XB_SPIN(xb_ld(&bar[XB_TOPGEN]) == tg, bar);
            __builtin_amdgcn_fence(__ATOMIC_ACQUIRE, "agent");
            xb_add(&bar[XB_XGEN(b.x)], 1u);
            asm volatile("s_waitcnt vmcnt(0)" ::: "memory");
        } else {
            XB_SPIN(xb_ld(&bar[XB_XGEN(b.x)]) == gen, bar);
            __builtin_amdgcn_fence(__ATOMIC_ACQUIRE, "agent");
            asm volatile("s_waitcnt vmcnt(0)" ::: "memory");
        }
    }
    __syncthreads();
}

__device__ __forceinline__ void xcd_local_barrier(const XcdBarrier& b) {
    asm volatile("s_waitcnt vmcnt(0)" ::: "memory");
    __syncthreads();
    if (threadIdx.x == 0) {
        unsigned* bar = b.bar;
        __builtin_amdgcn_s_waitcnt(0);
        const unsigned nloc = b.st[0];
        const unsigned old = xb_add(&bar[XB_XSUB(b.x)], 1u);
        const unsigned gen = old / nloc;
        if (old + 1u == (gen + 1u) * nloc) xb_add(&bar[XB_XGEN(b.x)], 1u);
        else XB_SPIN(xb_ld(&bar[XB_XGEN(b.x)]) == gen, bar);
        __builtin_amdgcn_fence(__ATOMIC_ACQUIRE, "agent");
        asm volatile("s_waitcnt vmcnt(0)" ::: "memory");
    }
    __syncthreads();
}

struct Params {
    const float *x, *c, *w_ada, *b_ada, *pre_g, *post_g, *w_gate, *w_up, *w_down, *w_in, *ln_g, *ln_b, *sgu_w, *sgu_b, *b_f, *gn_a, *gn_b, *w_out;
    float* out; unsigned char* ws;
};

__device__ __forceinline__ void adaln_item(const Params& p, LAS unsigned char* lds, int cgp, int tid, int lane, int wave) {
    LAS float* sc = (LAS float*)lds;
    LAS float* red = (LAS float*)(lds + 32768);
    for (int idx = tid; idx < 8192; idx += 512) { const int b = idx >> 10, k = idx & 1023; const float v = p.c[idx]; sc[k * 8 + b] = v * pg8::fast_sigmoid(v); }
    __syncthreads();
    float acc[8];
#pragma unroll
    for (int b = 0; b < 8; ++b) acc[b] = 0.f;
    const float* wp = p.w_ada + (size_t)(wave * 128) * 9216 + cgp * 64 + lane;
#pragma unroll 1
    for (int k0 = 0; k0 < 128; k0 += 32) {
        float wv[32];
#pragma unroll
        for (int k = 0; k < 32; ++k) { const float* rowp = p.w_ada + (size_t)(wave * 128 + k0 + k) * 9216 + cgp * 64;
            wv[k] = __builtin_nontemporal_load(rowp + (unsigned)lane); }
        __builtin_amdgcn_sched_barrier(0);
#pragma unroll
        for (int k = 0; k < 32; ++k) { const f32x4 s0 = *(const LAS f32x4*)(sc + (wave * 128 + k0 + k) * 8), s1 = *(const LAS f32x4*)(sc + (wave * 128 + k0 + k) * 8 + 4);
            acc[0] += s0[0] * wv[k]; acc[1] += s0[1] * wv[k]; acc[2] += s0[2] * wv[k]; acc[3] += s0[3] * wv[k]; acc[4] += s1[0] * wv[k]; acc[5] += s1[1] * wv[k]; acc[6] += s1[2] * wv[k]; acc[7] += s1[3] * wv[k];
            if ((k & 7) == 7) __builtin_amdgcn_sched_barrier(0); }
    }
#pragma unroll
    for (int b = 0; b < 8; ++b) red[(wave * 8 + b) * 64 + lane] = acc[b];
    __syncthreads();
    { const int b = wave; float s = 0.f;
#pragma unroll
      for (int w = 0; w < 8; ++w) s += red[(w * 8 + b) * 64 + lane];
      const int j = cgp * 64 + lane; ((float*)(p.ws + WS_MOD))[b * 9216 + j] = s + p.b_ada[j]; }
    __syncthreads();
}
__device__ __forceinline__ void conv_decode(const Params& p, int it, const float*& W, int& ldw, int& k0, int& n0, bf16*& WT, int& K, int& drow0, const float*& kgain) {
    constexpr int I_GU = 16 * 88, I_D = 44 * 32, I_IN = 16 * 80;
    static_assert(I_GU == I_D, "items");
    int r = it; kgain = nullptr;
    if (r < 4 * I_GU) {
        const int which = r / I_GU; r -= which * I_GU; const int f = which >> 1, up = which & 1;
        const int kb = r / 88, nb = r % 88; n0 = nb * 32; k0 = kb * 64; ldw = DFF; K = 1024;
        W = (up ? p.w_up : p.w_gate) + (size_t)f * 1024 * DFF; WT = (bf16*)(p.ws + (f ? WS_WGU1 : WS_WGU0));
        drow0 = 256 * (n0 >> 7) + (n0 & 127) + (up ? 128 : 0); return; }
    r -= 4 * I_GU;
    if (r < 2 * I_D) { const int f = r / I_D; r -= f * I_D; const int kb = r / 32, nb = r % 32;
        W = p.w_down + (size_t)f * DFF * 1024; ldw = 1024; k0 = kb * 64; n0 = nb * 32; WT = (bf16*)(p.ws + (f ? WS_WD1 : WS_WD0)); K = DFF; drow0 = nb * 32; return; }
    r -= 2 * I_D;
    if (r < I_IN) { const int kb = r / 80, nb = r % 80; W = p.w_in; ldw = NIN; k0 = kb * 64; n0 = nb * 32; WT = (bf16*)(p.ws + WS_WIN); K = 1024; drow0 = nb * 32; return; }
    r -= I_IN;
    { const int kb = r / 32, nb = r % 32;
      W = p.w_out; ldw = 1024; k0 = kb * 64; n0 = nb * 32; WT = (bf16*)(p.ws + WS_WOUT); K = 1024; drow0 = nb * 32; kgain = (kb < 8 ? p.gn_a + kb * 64 : p.gn_b + (kb - 8) * 64); }
}
__device__ __forceinline__ void conv_load(const float* W, int ldw, int k0, int n0, const float* kgain, int lane, float (&r)[32]) {
#pragma unroll
    for (int i = 0; i < 32; ++i) { const int kk = 2 * i + (lane >> 5); r[i] = __builtin_nontemporal_load(W + (size_t)(k0 + kk) * ldw + n0 + (lane & 31)); }
    if (kgain) {
#pragma unroll
        for (int i = 0; i < 32; ++i) r[i] *= kgain[2 * i + (lane >> 5)]; }
}
__device__ __forceinline__ void conv_store(const float (&r)[32], bf16* WT, int K, int drow0, int k0, LAS float* scr, int lane) {
#pragma unroll
    for (int i = 0; i < 32; ++i) { const int kk = 2 * i + (lane >> 5); scr[kk * 33 + (lane & 31)] = r[i]; }
    LDS_WAIT(); asm volatile("" ::: "memory");
    const int c = lane & 7;
#pragma unroll
    for (int j = 0; j < 4; ++j) { const int n = (lane >> 3) + 8 * j; const LAS float* s = scr + (8 * c) * 33 + n;
        v4u o; o.x = pk2(s[0 * 33], s[1 * 33]); o.y = pk2(s[2 * 33], s[3 * 33]); o.z = pk2(s[4 * 33], s[5 * 33]); o.w = pk2(s[6 * 33], s[7 * 33]);
        *(GAS v4u*)(WT + (size_t)(drow0 + n) * K + k0 + 8 * c) = o; }
    LDS_WAIT(); asm volatile("" ::: "memory");
}
__device__ __forceinline__ void convert_weights(const Params& p, LAS unsigned char* lds, int gw, int NGW, int lane, int wave) {
    LAS float* scr = (LAS float*)(lds + wave * 16384);
    constexpr int NITEMS = 6 * (16 * 88) + 16 * 80 + 16 * 32;
    int it = gw; if (it >= NITEMS) return;
    const float *Wa, *Wb, *ga, *gb; bf16 *Ta, *Tb; int la, lb, ka, kb_, na, nb_, Ka, Kb, da, db;
    float ra[32], rb[32];
    conv_decode(p, it, Wa, la, ka, na, Ta, Ka, da, ga); conv_load(Wa, la, ka, na, ga, lane, ra);
    for (;;) {
        int itn = it + NGW; bool more = itn < NITEMS;
        if (more) { conv_decode(p, itn, Wb, lb, kb_, nb_, Tb, Kb, db, gb); conv_load(Wb, lb, kb_, nb_, gb, lane, rb); }
        conv_store(ra, Ta, Ka, da, ka, scr, lane);
        if (!more) break;
        it = itn; itn = it + NGW; more = itn < NITEMS;
        if (more) { conv_decode(p, itn, Wa, la, ka, na, Ta, Ka, da, ga); conv_load(Wa, la, ka, na, ga, lane, ra); }
        conv_store(rb, Tb, Kb, db, kb_, scr, lane);
        if (!more) break;
        it = itn;
    }
}

template <int MODE, bool XIN16 = false, bool XOUT16 = false> __device__ __forceinline__ void ew_phase(const Params& p, LAS unsigned char* lds, int gw, int lane, const float* xin, int sub_res, float coef, int sub_next) {
    const int row0 = gw * 16; if (row0 >= M) return;
    asm volatile("" : "+v"(lane));
    const int b = row0 / SEQ;
    const unsigned lo = 4u * (unsigned)lane;
    const float* mod = (const float*)(p.ws + WS_MOD) + (size_t)b * 9216;
    f32x4 G[4], A[4], S[4];
    if (MODE & 1) {
#pragma unroll
        for (int j = 0; j < 4; ++j) { const unsigned col = lo + 256u * j; const f32x4 gt = *(const f32x4*)(mod + sub_res * 3072 + 2048 + col), pg = *(const f32x4*)(p.post_g + sub_res * 1024 + col); G[j] = coef * (1.0f + gt) * pg; }
        asm volatile("" : "+v"(G[0]), "+v"(G[1]), "+v"(G[2]), "+v"(G[3]) :: "memory");
    }
    if (MODE & 2) {
#pragma unroll
        for (int j = 0; j < 4; ++j) { const unsigned col = lo + 256u * j; const f32x4 sh = *(const f32x4*)(mod + sub_next * 3072 + col), scl = *(const f32x4*)(mod + sub_next * 3072 + 1024 + col), pg = *(const f32x4*)(p.pre_g + sub_next * 1024 + col);
            A[j] = pg * (1.0f + scl); S[j] = sh; }
        asm volatile("" : "+v"(A[0]), "+v"(A[1]), "+v"(A[2]), "+v"(A[3]) :: "memory");
        if (!(MODE & 4)) asm volatile("" : "+v"(S[0]), "+v"(S[1]), "+v"(S[2]), "+v"(S[3]));
    }
    const LAS f32x4* wfl = (const LAS f32x4*)lds + lane;
    const bf16* HD = (const bf16*)(p.ws + WS_HD);
    bf16* H = (bf16*)(p.ws + WS_H);
    bf16* X1 = (bf16*)(p.ws + WS_X1);
    float rs4[4] = {0.f, 0.f, 0.f, 0.f};
    if (MODE & 1) {
        const float* ss = (const float*)(p.ws + WS_SS) + row0 + (unsigned)((lane & 15) * M + (lane >> 4));
#pragma unroll
        for (int i = 0; i < 4; ++i) { float q = ss[4 * i]; q += __shfl_xor(q, 1); q += __shfl_xor(q, 2); q += __shfl_xor(q, 4); q += __shfl_xor(q, 8); rs4[i] = __builtin_amdgcn_rsqf(q * (1.0f / 1024.0f) + EPS); }
        asm volatile("" : "+v"(rs4[0]), "+v"(rs4[1]), "+v"(rs4[2]), "+v"(rs4[3]) :: "memory");
    }
    constexpr int NR = (MODE & 4) ? 1 : 2;
#pragma unroll 1
    for (int rp = 0; rp < 16 / NR; ++rp) {
        f32x4 v[NR][4]; v2u hw[NR][4];
#pragma unroll
        for (int k = 0; k < NR; ++k) { const int row = row0 + NR * rp + k;
#pragma unroll
            for (int j = 0; j < 4; ++j) {
                if (XIN16) { const v2u xw = __builtin_nontemporal_load((const v2u*)(X1 + (size_t)row * 1024 + (lo + 256u * j))); v[k][j] = (f32x4){bf_lo(xw.x), bf_hi(xw.x), bf_lo(xw.y), bf_hi(xw.y)}; }
                else v[k][j] = __builtin_nontemporal_load((const f32x4*)(xin + (size_t)row * 1024 + (lo + 256u * j)));
                if (MODE & 1) hw[k][j] = __builtin_nontemporal_load((const v2u*)(HD + (size_t)row * 1024 + (lo + 256u * j))); } }
#pragma unroll
        for (int k = 0; k < NR; ++k) { const int rr = NR * rp + k, row = row0 + rr;
            if (MODE & 1) {
                const int i = rr >> 2; const float sel = i == 0 ? rs4[0] : (i == 1 ? rs4[1] : (i == 2 ? rs4[2] : rs4[3]));
                const float rstd = __shfl(sel, (rr & 3) * 16);
#pragma unroll
                for (int j = 0; j < 4; ++j) { const f32x4 hv = (f32x4){bf_lo(hw[k][j].x), bf_hi(hw[k][j].x), bf_lo(hw[k][j].y), bf_hi(hw[k][j].y)};
                    v[k][j] = v[k][j] + G[j] * hv * rstd;
                    if (XOUT16) { v2u xw; xw.x = pk2(v[k][j][0], v[k][j][1]); xw.y = pk2(v[k][j][2], v[k][j][3]); __builtin_nontemporal_store(xw, (v2u*)(X1 + (size_t)row * 1024 + (lo + 256u * j))); }
                    else __builtin_nontemporal_store(v[k][j], (f32x4*)(p.out + (size_t)row * 1024 + (lo + 256u * j))); }
            }
            if (MODE & 2) {
                float s2 = 0.f;
#pragma unroll
                for (int j = 0; j < 4; ++j) s2 += (v[k][j][0] * v[k][j][0] + v[k][j][1] * v[k][j][1]) + (v[k][j][2] * v[k][j][2] + v[k][j][3] * v[k][j][3]);
                const float r2 = __builtin_amdgcn_rsqf(wave_sum(s2) * (1.0f / 1024.0f) + EPS);
                f32x4 hq[4];
#pragma unroll
                for (int j = 0; j < 4; ++j) { const f32x4 sj = (MODE & 4) ? *(const f32x4*)(mod + sub_next * 3072 + (lo + 256u * j)) : S[j];
                    hq[j] = v[k][j] * r2 * A[j] + sj;
                    v2u w; w.x = pk2(hq[j][0], hq[j][1]); w.y = pk2(hq[j][2], hq[j][3]);
                    *(v2u*)(H + (size_t)row * 1024 + (lo + 256u * j)) = w; }
                if (MODE & 4) {
                    f32x4 d0 = (f32x4){0.f, 0.f, 0.f, 0.f}, d1 = d0;
#pragma unroll
                    for (int j = 0; j < 4; ++j)
#pragma unroll
                        for (int e = 0; e < 4; ++e) { d0 += hq[j][e] * wfl[((j * 4 + e) * 2 + 0) * 64]; d1 += hq[j][e] * wfl[((j * 4 + e) * 2 + 1) * 64]; }
                    const bool b5 = lane & 32, b4 = lane & 16, b3 = lane & 8;
                    const f32x4 snd = b5 ? d0 : d1; f32x4 k4 = b5 ? d1 : d0;
                    k4[0] += __shfl_xor(snd[0], 32); k4[1] += __shfl_xor(snd[1], 32); k4[2] += __shfl_xor(snd[2], 32); k4[3] += __shfl_xor(snd[3], 32);
                    const float s0 = b4 ? k4[0] : k4[2], s1 = b4 ? k4[1] : k4[3]; float k0 = b4 ? k4[2] : k4[0], k1 = b4 ? k4[3] : k4[1];
                    k0 += __shfl_xor(s0, 16); k1 += __shfl_xor(s1, 16);
                    float mine = (b3 ? k1 : k0) + __shfl_xor(b3 ? k0 : k1, 8);
                    mine += dpp_f<0xB1>(mine); mine += dpp_f<0x4E>(mine); mine += dpp_f<0x141>(mine);
                    if ((lane & 7) == 0) { const int hh = lane >> 3; const float z = mine + p.b_f[hh];
                        const float ls = (z < 0.f ? z : 0.f) - 0.6931471805599453f * __builtin_amdgcn_logf(1.0f + __builtin_amdgcn_exp2f(-1.4426950408889634f * fabsf(z)));
                        ((float*)(p.ws + WS_LOGF))[((size_t)(b * 8 + hh)) * SEQ + (row - b * SEQ)] = ls; }
                }
            }
        }
    }
}
__device__ __forceinline__ void ew_fill_wf(const Params& p, LAS unsigned char* lds, int tid) {
    for (int idx = tid; idx < 2048; idx += NWAVES * 64) { const int l = idx & 63, half = (idx >> 6) & 1, e = (idx >> 7) & 3, j = idx >> 9;
        ((LAS f32x4*)lds)[idx] = *(const f32x4*)(p.w_in + (size_t)(4 * l + 256 * j + e) * NIN + 2560 + 4 * half); }
    __syncthreads();
}
__device__ __forceinline__ void scan_seq(const Params& p, int seq, int lane) {
    const float* src = (const float*)(p.ws + WS_LOGF) + (size_t)seq * SEQ + lane * 64;
    float* dst = (float*)(p.ws + WS_CUM) + (size_t)seq * SEQ + lane * 64;
    f32x4 v[16]; float run = 0.f;
#pragma unroll
    for (int i = 0; i < 16; ++i) { v[i] = *(const f32x4*)(src + 4 * i);
        run += v[i][0]; v[i][0] = run; run += v[i][1]; v[i][1] = run; run += v[i][2]; v[i][2] = run; run += v[i][3]; v[i][3] = run; }
    float incl = run;
#pragma unroll
    for (int o = 1; o < 64; o <<= 1) { const float t = __shfl_up(incl, o); if (lane >= o) incl += t; }
    const float excl = incl - run;
#pragma unroll
    for (int i = 0; i < 16; ++i) *(f32x4*)(dst + 4 * i) = (v[i] + excl) * 1.4426950408889634f;
}
constexpr int SGU_PITCH = 1044;
__device__ __forceinline__ void sgu_unit(const Params& p, LAS unsigned char* lds, int unit, int lane, int wave) {
    const int R0 = unit * 128;
    const bf16* ZG = (const bf16*)(p.ws + WS_ZG) + (size_t)(unit >> 5) * PAD_ZG;
    bf16* Y = (bf16*)(p.ws + WS_Y);
    float* ssa = (float*)(p.ws + WS_SSA);
    {
        const f32x4 g0 = *(const f32x4*)(p.ln_g + 8 * lane), g1 = *(const f32x4*)(p.ln_g + 8 * lane + 4), b0 = *(const f32x4*)(p.ln_b + 8 * lane), b1 = *(const f32x4*)(p.ln_b + 8 * lane + 4);
        v4u wv[16];
#pragma unroll
        for (int rr = 0; rr < 16; ++rr) wv[rr] = __builtin_nontemporal_load((const v4u*)(ZG + (size_t)(R0 + wave * 16 + rr) * 1024 + 512 + 8 * lane));
#pragma unroll
        for (int rr = 0; rr < 16; ++rr) { const int r = wave * 16 + rr; const v4u w = wv[rr];
            f32x4 a = (f32x4){bf_lo(w.x), bf_hi(w.x), bf_lo(w.y), bf_hi(w.y)}, c = (f32x4){bf_lo(w.z), bf_hi(w.z), bf_lo(w.w), bf_hi(w.w)};
            const float mean = wave_sum((a[0] + a[1]) + (a[2] + a[3]) + (c[0] + c[1]) + (c[2] + c[3])) * (1.0f / 512.0f);
            a = a - mean; c = c - mean;
            const float var = wave_sum((a[0] * a[0] + a[1] * a[1]) + (a[2] * a[2] + a[3] * a[3]) + (c[0] * c[0] + c[1] * c[1]) + (c[2] * c[2] + c[3] * c[3])) * (1.0f / 512.0f);
            const float rstd = __builtin_amdgcn_rsqf(var + EPS);
            a = a * rstd * g0 + b0; c = c * rstd * g1 + b1;
            LAS unsigned* d = (LAS unsigned*)(lds + r * SGU_PITCH + 16 * lane);
            d[0] = pk2(a[0], a[1]); d[1] = pk2(a[2], a[3]); d[2] = pk2(c[0], c[1]); d[3] = pk2(c[2], c[3]); }
    }
    __syncthreads();
    const int fr = lane & 15, fq = lane >> 4;
    const int h = wave;
    bf16x8 vfr[4][4];
#pragma unroll
    for (int ks = 0; ks < 4; ++ks) { const LAS unsigned short* vb = (const LAS unsigned short*)(lds + (32 * ks + 8 * fq) * SGU_PITCH + (64 * h + fr) * 2);
#pragma unroll
        for (int nt = 0; nt < 4; ++nt) { bf16x8 vf;
#pragma unroll
            for (int e = 0; e < 8; ++e) vf[e] = (short)vb[e * (SGU_PITCH / 2) + 16 * nt];
            vfr[ks][nt] = vf; } }
    const float* Wh = p.sgu_w + (size_t)h * 16384 + (size_t)fr * 128 + 8 * fq;
#pragma unroll 1
    for (int rt2 = 0; rt2 < 8; rt2 += 2) {
        f32x4 wv[2][4][2]; v2u uw[2][4]; float bs[2];
#pragma unroll
        for (int t = 0; t < 2; ++t) { const int i = (rt2 + t) * 16 + fr;
#pragma unroll
            for (int ks = 0; ks < 4; ++ks) { wv[t][ks][0] = *(const f32x4*)(Wh + (size_t)(rt2 + t) * 2048 + 32 * ks); wv[t][ks][1] = *(const f32x4*)(Wh + (size_t)(rt2 + t) * 2048 + 32 * ks + 4); }
#pragma unroll
            for (int nt = 0; nt < 4; ++nt) uw[t][nt] = __builtin_nontemporal_load((const v2u*)(ZG + (size_t)(R0 + i) * 1024 + 64 * h + 16 * nt + 4 * fq));
            bs[t] = p.sgu_b[h * 128 + i]; }
        __builtin_amdgcn_sched_barrier(0);
#pragma unroll
        for (int t = 0; t < 2; ++t) { const int i = (rt2 + t) * 16 + fr; const size_t rowoff = (size_t)(R0 + i) * 1024;
            f32x4 acc[4];
#pragma unroll
            for (int nt = 0; nt < 4; ++nt) acc[nt] = (f32x4){0.f, 0.f, 0.f, 0.f};
#pragma unroll
            for (int ks = 0; ks < 4; ++ks) if (ks < 2 || rt2 >= 4) {
                const f32x4 w0 = wv[t][ks][0], w1 = wv[t][ks][1];
                v4u wu; wu.x = pk2(w0[0], w0[1]); wu.y = pk2(w0[2], w0[3]); wu.z = pk2(w1[0], w1[1]); wu.w = pk2(w1[2], w1[3]);
                const bf16x8 wfrag = __builtin_bit_cast(bf16x8, wu);
#pragma unroll
                for (int nt = 0; nt < 4; ++nt) acc[nt] = __builtin_amdgcn_mfma_f32_16x16x32_bf16(vfr[ks][nt], wfrag, acc[nt], 0, 0, 0);
            }
            float q = 0.f;
#pragma unroll
            for (int nt = 0; nt < 4; ++nt) { const int c = 64 * h + 16 * nt + 4 * fq;
                const f32x4 uv = (f32x4){bf_lo(uw[t][nt].x), bf_hi(uw[t][nt].x), bf_lo(uw[t][nt].y), bf_hi(uw[t][nt].y)};
                const f32x4 y = uv * (acc[nt] + bs[t]);
                v2u o; o.x = pk2(y[0], y[1]); o.y = pk2(y[2], y[3]);
                const f32x4 yr = (f32x4){bf_lo(o.x), bf_hi(o.x), bf_lo(o.y), bf_hi(o.y)};
                q += (yr[0] * yr[0] + yr[1] * yr[1]) + (yr[2] * yr[2] + yr[3] * yr[3]);
                *(v2u*)(Y + rowoff + c) = o; }
            q += __shfl_xor(q, 16); q += __shfl_xor(q, 32);
            if (fq == 0) ssa[(size_t)h * M + R0 + i] = q;
        }
    }
    __syncthreads();
}
__device__ __forceinline__ void ynorm_phase(const Params& p, int gw, int lane) {
    const int row0 = gw * 16; if (row0 >= M) return;
    asm volatile("" : "+v"(lane));
    const f32x4 ga0 = *(const f32x4*)(p.gn_a + 8 * lane), ga1 = *(const f32x4*)(p.gn_a + 8 * lane + 4), gb0 = *(const f32x4*)(p.gn_b + 8 * lane), gb1 = *(const f32x4*)(p.gn_b + 8 * lane + 4);
    const float* ssa = (const float*)(p.ws + WS_SSA); const float* ssb = (const float*)(p.ws + WS_SSB);
    bf16* Y = (bf16*)(p.ws + WS_Y);
    for (int rr = 0; rr < 16; ++rr) { const int row = row0 + rr;
        float qa = 0.f, qb = 0.f;
#pragma unroll
        for (int h = 0; h < 8; ++h) { qa += ssa[(size_t)h * M + row]; qb += ssb[(size_t)h * M + row]; }
        const float ra = __builtin_amdgcn_rsqf(qa * (1.0f / 512.0f) + EPS), rb = __builtin_amdgcn_rsqf(qb * (1.0f / 512.0f) + EPS);
        v4u* pa = (v4u*)(Y + (size_t)row * 1024 + 8 * lane); v4u* pb = (v4u*)(Y + (size_t)row * 1024 + 512 + 8 * lane);
        const v4u wa = *pa, wb = *pb; v4u oa, ob;
        oa.x = pk2(bf_lo(wa.x) * ra * ga0[0], bf_hi(wa.x) * ra * ga0[1]); oa.y = pk2(bf_lo(wa.y) * ra * ga0[2], bf_hi(wa.y) * ra * ga0[3]);
        oa.z = pk2(bf_lo(wa.z) * ra * ga1[0], bf_hi(wa.z) * ra * ga1[1]); oa.w = pk2(bf_lo(wa.w) * ra * ga1[2], bf_hi(wa.w) * ra * ga1[3]);
        ob.x = pk2(bf_lo(wb.x) * rb * gb0[0], bf_hi(wb.x) * rb * gb0[1]); ob.y = pk2(bf_lo(wb.y) * rb * gb0[2], bf_hi(wb.y) * rb * gb0[3]);
        ob.z = pk2(bf_lo(wb.z) * rb * gb1[0], bf_hi(wb.z) * rb * gb1[1]); ob.w = pk2(bf_lo(wb.w) * rb * gb1[2], bf_hi(wb.w) * rb * gb1[3]);
        *pa = oa; *pb = ob; }
}

#ifndef PROBE
#define PROBE 0
#endif
#ifndef STAG_TICKS
#define STAG_TICKS 700
#endif
__device__ __forceinline__ void stagger_start(int bx) {
    const unsigned long long d = (unsigned long long)(((unsigned)bx * 97u) & 255u) * STAG_TICKS / 256u, t0 = __builtin_amdgcn_s_memrealtime();
    while (__builtin_amdgcn_s_memrealtime() - t0 < d) __builtin_amdgcn_s_sleep(8);
}
#define REPS(cond) for (int rep_ = 0; rep_ < ((cond) ? 2 : 1); ++rep_)
__global__ void __launch_bounds__(NWAVES * 64, 2) mega_fwd(Params p) {
    extern __shared__ __attribute__((aligned(16))) unsigned char lds_raw[];
    cg::grid_group grid = cg::this_grid();
    LAS unsigned char* lds = (LAS unsigned char*)lds_raw;
    if (threadIdx.x < 16) ((LAS unsigned*)(lds + LDS_BARST))[threadIdx.x] = 0u;
    __syncthreads();
    const XcdBarrier bar = xcd_barrier_post((unsigned*)(p.ws + WS_CTL), (volatile LAS unsigned*)(lds + LDS_BARST));
    if (p.ws == nullptr) grid.sync();
    const int G = gridDim.x, NGW = G * NWAVES;
    int bx = blockIdx.x;
    int cgx = blockIdx.x;
    int sid = blockIdx.x;
    bool uni = false;
#define GRID_SYNC() do { if (uni) xcd_local_barrier(bar); else xcd_barrier(bar); } while (0)
#define LANEVARS const int tid = otid(), lane = tid & 63, wave = __builtin_amdgcn_readfirstlane(tid >> 6), gw = bx * NWAVES + wave; (void)tid; (void)lane; (void)wave; (void)gw
    bf16* H = (bf16*)(p.ws + WS_H); bf16* HD = (bf16*)(p.ws + WS_HD); bf16* ACT = (bf16*)(p.ws + WS_ACT);
    float* SS = (float*)(p.ws + WS_SS);

    REPS(PROBE == 3) { LANEVARS; for (int it = bx; it < 144; it += G) adaln_item(p, lds, it, tid, lane, wave);
      convert_weights(p, lds, gw, NGW, lane, wave); __syncthreads(); }
    xcd_barrier(bar);
    { volatile LAS unsigned* st = (volatile LAS unsigned*)(lds + LDS_BARST);
      const unsigned u_ = __builtin_amdgcn_readfirstlane(st[2]), r_ = __builtin_amdgcn_readfirstlane(st[3]), x_ = bar.x;
#ifndef FORCE_FALLBACK
#define FORCE_FALLBACK 0
#endif
      if (!FORCE_FALLBACK && u_ != 0u && r_ < 32u && x_ < 8u) { uni = true; bx = (int)(x_ * 32u + r_); cgx = (int)(r_ * 8u + x_); sid = r_ < 8u ? (int)(x_ * 8u + r_) : (1 << 20); } }
    REPS(PROBE == 5) { LANEVARS; for (int g = gw; g * 16 < M; g += NGW) ew_phase<2>(p, lds, g, lane, p.x, 0, 0.f, 0); }
    GRID_SYNC();
    REPS(PROBE == 4 || PROBE >= 6) { pg8::Gemm g{H, (const bf16*)(p.ws + WS_WGU0), M, 2 * DFF, 1024}; pg8::StaticOrder S; S.init(M, 2 * DFF, G, cgx);
      pg8::EpiSwiGLU E{ACT, DFF, (rep_ == 1 && PROBE >= 6) ? PROBE - 6 : 0}; pg8::gemm_phase<pg8::EpiSwiGLU, pg8::StaticOrder, true, true>(lds, g, S, E); }
    GRID_SYNC();
    REPS(PROBE == 4) { pg8::Gemm g{ACT, (const bf16*)(p.ws + WS_WD0), M, 1024, DFF}; pg8::StaticOrder S; S.init(M, 1024, G, cgx);
      pg8::EpiBf16Ss E{HD, 1024, SS, M}; pg8::gemm_phase<pg8::EpiBf16Ss, pg8::StaticOrder, true, true>(lds, g, S, E); }
    GRID_SYNC();
    REPS(PROBE == 5) { LANEVARS; __syncthreads(); ew_fill_wf(p, lds, tid); for (int g = gw; g * 16 < M; g += NGW) ew_phase<7, false, true>(p, lds, g, lane, p.x, 0, 0.5f, 1); }
    GRID_SYNC();
    { LANEVARS; if (wave == 0) for (int s = sid; s < BATCH * HB; s += G) scan_seq(p, s, lane); }
    REPS(PROBE == 4) { pg8::Gemm g{H, (const bf16*)(p.ws + WS_WIN), M, 2560, 1024}; pg8::StaticOrder S; S.init(M, 2560, G, cgx);
      static_assert(WS_K - WS_Q == WS_V - WS_K, "qkv stride");
      pg8::EpiMixIn E{(bf16*)(p.ws + WS_ZG), (bf16*)(p.ws + WS_Q), (WS_K - WS_Q) / 2, attn_body::C2, PAD_ZG, PAD_QKV};
      pg8::gemm_phase<pg8::EpiMixIn, pg8::StaticOrder, true, true>(lds, g, S, E); }
    GRID_SYNC();
    { const attn_body::AttnTensors AT{(const attn_body::bf16*)(p.ws + WS_Q), (const attn_body::bf16*)(p.ws + WS_K), (const attn_body::bf16*)(p.ws + WS_V),
                                      (attn_body::bf16*)(p.ws + WS_Y) + 512, (const float*)(p.ws + WS_CUM), (float*)(p.ws + WS_SSB), (float*)(p.ws + WS_KPART)};
      const attn_body::StaticOrder S(G, cgx);
      attn_body::attn_pre<attn_body::StaticOrder>((char*)lds_raw, AT, S);
      { LANEVARS; for (int u = bx; u < M / 128; u += G) sgu_unit(p, lds, u, lane, wave); }
      GRID_SYNC();
      attn_body::attn_run<attn_body::StaticOrder>((char*)lds_raw, AT, S); }
    GRID_SYNC();
    { pg8::Gemm g{(const bf16*)(p.ws + WS_Y), (const bf16*)(p.ws + WS_WOUT), M, 1024, 1024}; pg8::StaticOrder S; S.init(M, 1024, G, cgx);
      LAS pg8::f32x2* tab = (LAS pg8::f32x2*)(lds + 131072);
      pg8::Unit u0{0, 0}, u1{0, 0}; const bool has0 = S.next(0, u0), has1 = S.next(1, u1); pg8::Unit u2; const bool has2 = S.next(2, u2);
      { LANEVARS; const int ui = tid >> 8, r = tid & 255; const int pmu = ui ? u1.pm : u0.pm;
        if (ui ? has1 : has0) { const float* ssa = (const float*)(p.ws + WS_SSA) + (size_t)pmu * 256 + r; const float* ssb = (const float*)(p.ws + WS_SSB) + (size_t)pmu * 256 + r; float qa = 0.f, qb = 0.f;
#pragma unroll
          for (int h = 0; h < 8; ++h) { qa += ssa[(size_t)h * M]; qb += ssb[(size_t)h * M]; }
          const float ra = __builtin_amdgcn_rsqf(qa * (1.0f / 512.0f) + EPS), rb = __builtin_amdgcn_rsqf(qb * (1.0f / 512.0f) + EPS);
          tab[ui * 256 + r] = (pg8::f32x2){ra / rb, rb}; }
        __syncthreads(); }
      if (!has2 && (!has1 || u1.pm != u0.pm)) {
        pg8::EpiRowScaleSs E{HD, 1024, SS, M, tab, u0.pm}; pg8::gemm_phase<pg8::EpiRowScaleSs, pg8::StaticOrder, true, true>(lds, g, S, E); }
    }
    GRID_SYNC();
    { LANEVARS; for (int g = gw; g * 16 < M; g += NGW) ew_phase<3, true, true>(p, lds, g, lane, p.x, 1, 1.0f, 2); }
    GRID_SYNC();
    REPS(PROBE == 4) { pg8::Gemm g{H, (const bf16*)(p.ws + WS_WGU1), M, 2 * DFF, 1024}; pg8::StaticOrder S; S.init(M, 2 * DFF, G, cgx);
      pg8::EpiSwiGLU E{ACT, DFF, 0}; pg8::gemm_phase<pg8::EpiSwiGLU, pg8::StaticOrder, true, true>(lds, g, S, E); }
    GRID_SYNC();
    REPS(PROBE == 4) { pg8::Gemm g{ACT, (const bf16*)(p.ws + WS_WD1), M, 1024, DFF}; pg8::StaticOrder S; S.init(M, 1024, G, cgx);
      pg8::EpiBf16Ss E{HD, 1024, SS, M}; pg8::gemm_phase<pg8::EpiBf16Ss, pg8::StaticOrder, true, true>(lds, g, S, E); }
    GRID_SYNC();
    { LANEVARS; for (int g = gw; g * 16 < M; g += NGW) ew_phase<1, true, false>(p, lds, g, lane, p.x, 2, 0.5f, 0); }
}

extern "C" void kernel_launch(void* const* d_in, const int* in_sizes, int n_in, void* d_out, int out_size, void* d_ws, size_t ws_size, hipStream_t stream) {
    static int grid = 0;
    if (grid == 0) {
        if (n_in != 18 || out_size != M * 1024 || ws_size < WS_END) { fprintf(stderr, "kernel_launch: unexpected problem shape (n_in %d out %d ws %zu)\n", n_in, out_size, ws_size); grid = -1; return; }
        int dev = 0, cus = 0, per_cu = 0;
        (void)hipGetDevice(&dev); (void)hipDeviceGetAttribute(&cus, hipDeviceAttributeMultiprocessorCount, dev);
        if (hipFuncSetAttribute((const void*)mega_fwd, hipFuncAttributeMaxDynamicSharedMemorySize, LDS_BYTES) != hipSuccess) { fprintf(stderr, "kernel_launch: hipFuncSetAttribute failed\n"); grid = -1; return; }
        if (hipOccupancyMaxActiveBlocksPerMultiprocessor(&per_cu, (const void*)mega_fwd, NWAVES * 64, LDS_BYTES) != hipSuccess || per_cu < 1) { fprintf(stderr, "kernel_launch: occupancy query says %d\n", per_cu); per_cu = 1; }
        (void)hipGetLastError();
        grid = cus * 1;
        if (grid <= 0) grid = 256;
    }
    if (grid < 0) return;
    if (hipMemsetAsync((char*)d_ws + WS_CTL, 0, CTL_BYTES, stream) != hipSuccess) { fprintf(stderr, "kernel_launch: memset failed\n"); return; }
    Params p{};
    p.x = (const float*)d_in[0]; p.c = (const float*)d_in[1]; p.w_ada = (const float*)d_in[2]; p.b_ada = (const float*)d_in[3]; p.pre_g = (const float*)d_in[4]; p.post_g = (const float*)d_in[5];
    p.w_gate = (const float*)d_in[6]; p.w_up = (const float*)d_in[7]; p.w_down = (const float*)d_in[8]; p.w_in = (const float*)d_in[9]; p.ln_g = (const float*)d_in[10]; p.ln_b = (const float*)d_in[11];
    p.sgu_w = (const float*)d_in[12]; p.sgu_b = (const float*)d_in[13]; p.b_f = (const float*)d_in[14]; p.gn_a = (const float*)d_in[15]; p.gn_b = (const float*)d_in[16]; p.w_out = (const float*)d_in[17];
    p.out = (float*)d_out; p.ws = (unsigned char*)d_ws;
    void* args[] = {&p};
    hipError_t e = hipLaunchCooperativeKernel((const void*)mega_fwd, dim3(grid), dim3(NWAVES * 64), args, LDS_BYTES, stream);
    if (e != hipSuccess) fprintf(stderr, "kernel_launch: cooperative launch failed: %s (grid %d)\n", hipGetErrorString(e), grid);
}
```

```cpp
#include <hip/hip_runtime.h>
#include <hip/hip_cooperative_groups.h>
#include <hip/hip_bf16.h>
#include <cstdio>
#include <cstdint>
#include <cmath>
namespace cg = cooperative_groups;
__device__ __forceinline__ int otid() { int t = threadIdx.x; asm volatile("" : "+v"(t)); return t; }
namespace pg8 {
#define PG8_LAS __attribute__((address_space(3)))
typedef unsigned short bf16_t;
typedef short bf16x8 __attribute__((ext_vector_type(8)));
typedef float f32x4 __attribute__((ext_vector_type(4)));
typedef unsigned u32x4 __attribute__((ext_vector_type(4)));
constexpr int BM = 256, BK = 64, HALF = 128, HTB = HALF * BK * 2  , STAGE_BYTES = 8 * HTB, NXCD = 8, WGM = 8;

__host__ __device__ __forceinline__ int lds_byte(int r, int c) { const int st = (r >> 4) * 2 + (c >> 5), rr = r & 15, cc = c & 31, ob = rr * 64 + cc * 2; return st * 1024 + (ob ^ (((ob >> 9) & 1) << 5)); }
__host__ __device__ __forceinline__ void stage_rc(int b, int& R, int& C) { const int st = b / 1024, sb = b % 1024, swz = sb ^ (((sb >> 9) & 1) << 5); R = (st >> 1) * 16 + swz / 64; C = (st & 1) * 32 + (swz % 64) / 2; }
__host__ __device__ __forceinline__ int perm32(int rho) { const int n = rho >> 4, i = rho & 15; return 8 * (i >> 2) + 4 * n + (i & 3); }

struct Unit { int pm, pn; };
struct Gemm { const bf16_t* A; const bf16_t* Bt; int M, N, K; };

struct StaticOrder {
    int nM, nN, nwg, G, c;
    __host__ __device__ __forceinline__ void init(int M, int N, int G_, int c_) { nM = M / BM; nN = N / BM; nwg = nM * nN; G = G_; c = c_; }
    __host__ __device__ __forceinline__ bool next(int i, Unit& u) const {
        const long L = (long)i * G + c; if (L >= nwg) return false;
        int wgid = (int)L; { const int q = nwg / NXCD, r = nwg % NXCD, xcd = wgid % NXCD, off = wgid / NXCD; wgid = (xcd < r ? xcd * (q + 1) : r * (q + 1) + (xcd - r) * q) + off; }
        const int nig = WGM * nN, gid = wgid / nig, fm = gid * WGM, gsz = (nM - fm) < WGM ? (nM - fm) : WGM;
        u.pm = fm + ((wgid % nig) % gsz); u.pn = (wgid % nig) / gsz; return true;
    }
    __device__ __forceinline__ void a_ready(const Unit&) const {}
    __device__ __forceinline__ void done(const Unit&) const {}
};

__device__ __forceinline__ unsigned cvt_pk_bf16(float lo, float hi) { unsigned r; asm volatile("v_cvt_pk_bf16_f32 %0, %1, %2" : "=v"(r) : "v"(lo), "v"(hi)); return r; }
typedef float f32x2 __attribute__((ext_vector_type(2)));
__device__ __forceinline__ float fast_sigmoid(float t) { return __builtin_amdgcn_rcpf(1.0f + __builtin_amdgcn_exp2f(-1.4426950408889634f * t)); }
struct EpiSwiGLU {
    static constexpr bool PERM = true, AFTER_DRAIN = false, HAS_MID = false;
    bf16_t* O; int ldc; int mode;
    __device__ __forceinline__ void operator()(const f32x4 (&acc)[2][2][4][2], const Unit& u, int wr, int wc, int fr, int fq) const {
        if (mode == 2) return;
        const int row0 = u.pm * BM + wr * 64 + fr; const int col0 = u.pn * HALF + wc * 32 + 8 * fq;
#pragma unroll
        for (int ai = 0; ai < 2; ++ai)
#pragma unroll
            for (int m = 0; m < 4; ++m) { bf16_t* rowp = O + (size_t)(row0 + ai * HALF + m * 16) * ldc + col0;
                float o[8];
#pragma unroll
                for (int n = 0; n < 2; ++n)
#pragma unroll
                    for (int e = 0; e < 4; ++e) { const float g = acc[ai][0][m][n][e], up = acc[ai][1][m][n][e]; o[n * 4 + e] = g * fast_sigmoid(g) * up; }
                u32x4 w; w.x = cvt_pk_bf16(o[0], o[1]); w.y = cvt_pk_bf16(o[2], o[3]); w.z = cvt_pk_bf16(o[4], o[5]); w.w = cvt_pk_bf16(o[6], o[7]);
                if (mode == 0) *(u32x4*)rowp = w; else if (w.x == 0x12345678u && w.y == 0x9abcdef0u) *(u32x4*)rowp = w; }
    }
};
struct EpiBf16Ss {
    static constexpr bool PERM = true, AFTER_DRAIN = false, HAS_MID = false;
    bf16_t* O; int ldc; float* ss; int M;
    __device__ __forceinline__ void operator()(const f32x4 (&acc)[2][2][4][2], const Unit& u, int wr, int wc, int fr, int fq) const {
        const int row0 = u.pm * BM + wr * 64 + fr; const int col0 = u.pn * BM + wc * 32 + 8 * fq;
        float* ssp = ss + (size_t)(u.pn * 4 + wc) * M;
#pragma unroll
        for (int ai = 0; ai < 2; ++ai)
#pragma unroll
            for (int m = 0; m < 4; ++m) { const int row = row0 + ai * HALF + m * 16; bf16_t* rowp = O + (size_t)row * ldc + col0; float q = 0.f;
#pragma unroll
                for (int bj = 0; bj < 2; ++bj) { const f32x4 v0 = acc[ai][bj][m][0], v1 = acc[ai][bj][m][1];
                    q += (v0[0] * v0[0] + v0[1] * v0[1]) + (v0[2] * v0[2] + v0[3] * v0[3]) + (v1[0] * v1[0] + v1[1] * v1[1]) + (v1[2] * v1[2] + v1[3] * v1[3]);
                    u32x4 w; w.x = cvt_pk_bf16(v0[0], v0[1]); w.y = cvt_pk_bf16(v0[2], v0[3]); w.z = cvt_pk_bf16(v1[0], v1[1]); w.w = cvt_pk_bf16(v1[2], v1[3]);
                    *(u32x4*)(rowp + bj * HALF) = w; }
                q += __shfl_xor(q, 16); q += __shfl_xor(q, 32);
                if (fq == 0) ssp[row] = q; }
    }
};
struct EpiRowScaleSs {
    static constexpr bool PERM = true, AFTER_DRAIN = false, HAS_MID = true;
    bf16_t* O; int ldc; float* ss; int M; const PG8_LAS f32x2* tab; int pm0;
    __device__ __forceinline__ void mid(f32x4 (&acc)[2][2][4][2], const Unit& u, int wr, int fr) const {
        const PG8_LAS f32x2* t = tab + (u.pm == pm0 ? 0 : 256) + wr * 64 + fr;
#pragma unroll
        for (int ai = 0; ai < 2; ++ai)
#pragma unroll
            for (int m = 0; m < 4; ++m) { const float f = t[ai * HALF + m * 16].x;
#pragma unroll
                for (int bj = 0; bj < 2; ++bj)
#pragma unroll
                    for (int n = 0; n < 2; ++n) acc[ai][bj][m][n] = acc[ai][bj][m][n] * f; }
    }
    __device__ __forceinline__ void operator()(const f32x4 (&acc)[2][2][4][2], const Unit& u, int wr, int wc, int fr, int fq) const {
        const int row0 = u.pm * BM + wr * 64 + fr; const int col0 = u.pn * BM + wc * 32 + 8 * fq;
        float* ssp = ss + (size_t)(u.pn * 4 + wc) * M;
        const PG8_LAS f32x2* t = tab + (u.pm == pm0 ? 0 : 256) + wr * 64 + fr;
#pragma unroll
        for (int ai = 0; ai < 2; ++ai)
#pragma unroll
            for (int m = 0; m < 4; ++m) { const int row = row0 + ai * HALF + m * 16; bf16_t* rowp = O + (size_t)row * ldc + col0; float q = 0.f; const float f = t[ai * HALF + m * 16].y;
#pragma unroll
                for (int bj = 0; bj < 2; ++bj) { const f32x4 v0 = acc[ai][bj][m][0] * f, v1 = acc[ai][bj][m][1] * f;
                    q += (v0[0] * v0[0] + v0[1] * v0[1]) + (v0[2] * v0[2] + v0[3] * v0[3]) + (v1[0] * v1[0] + v1[1] * v1[1]) + (v1[2] * v1[2] + v1[3] * v1[3]);
                    u32x4 w; w.x = cvt_pk_bf16(v0[0], v0[1]); w.y = cvt_pk_bf16(v0[2], v0[3]); w.z = cvt_pk_bf16(v1[0], v1[1]); w.w = cvt_pk_bf16(v1[2], v1[3]);
                    *(u32x4*)(rowp + bj * HALF) = w; }
                q += __shfl_xor(q, 16); q += __shfl_xor(q, 32);
                if (fq == 0) ssp[row] = q; }
    }
};
struct EpiMixIn {
    static constexpr bool PERM = true, AFTER_DRAIN = false, HAS_MID = false;
    bf16_t* ZG; bf16_t* Q; size_t qkv_stride; float qscale; size_t pad_zg, pad_qkv;
    __device__ __forceinline__ void operator()(const f32x4 (&acc)[2][2][4][2], const Unit& u, int wr, int wc, int fr, int fq) const {
        const int row0 = u.pm * BM + wr * 64 + fr;
        bf16_t* base; int ldc, colt; float sc = 1.f; const bool gelu = u.pn < 4;
        if (u.pn < 4) { base = ZG + (size_t)(u.pm >> 4) * pad_zg; ldc = 1024; colt = u.pn * BM; }
        else { const int t = (u.pn - 4) >> 1; base = Q + (size_t)t * qkv_stride + (size_t)(u.pm >> 4) * pad_qkv; ldc = 512; colt = ((u.pn - 4) & 1) * BM; if (t == 0) sc = qscale; }
        const int col0 = colt + wc * 32 + 8 * fq;
#pragma unroll
        for (int ai = 0; ai < 2; ++ai)
#pragma unroll
            for (int m = 0; m < 4; ++m) { bf16_t* rowp = base + (size_t)(row0 + ai * HALF + m * 16) * ldc + col0;
#pragma unroll
                for (int bj = 0; bj < 2; ++bj) { float o[8];
#pragma unroll
                    for (int n = 0; n < 2; ++n)
#pragma unroll
                        for (int e = 0; e < 4; ++e) { float x = acc[ai][bj][m][n][e];
                            if (gelu) { const float t = 1.5957691216057308f * (x + 0.044715f * x * x * x); x = x * fast_sigmoid(t); } else x *= sc;
                            o[n * 4 + e] = x; }
                    u32x4 w; w.x = cvt_pk_bf16(o[0], o[1]); w.y = cvt_pk_bf16(o[2], o[3]); w.z = cvt_pk_bf16(o[4], o[5]); w.w = cvt_pk_bf16(o[6], o[7]);
                    *(u32x4*)(rowp + bj * HALF) = w; } }
    }
};

template <class Epi, class Sched, bool ALIGN_EPI = false, bool SP2 = false>
__device__ __forceinline__ void gemm_phase(PG8_LAS unsigned char* lds, const Gemm g, const Sched& S, const Epi& E) {
    const int tid = otid(), wid = __builtin_amdgcn_readfirstlane(tid >> 6), lane = tid & 63, wr = wid >> 2, wc = wid & 3, fr = lane & 15, fq = lane >> 4;
    const int K = g.K, nt = K / BK;
    unsigned voffA[2], voffB[2];
#pragma unroll
    for (int i = 0; i < 2; ++i) { int R, C; stage_rc(tid * 16 + i * 8192, R, C); const int Rb = Epi::PERM ? ((R & ~31) + perm32(R & 31)) : R;
        voffA[i] = (unsigned)(R * K + C) * 2u; voffB[i] = (unsigned)(Rb * K + C) * 2u; }
    const size_t kstep = (size_t)(BK * 2);
    const size_t hstep = (size_t)HALF * K * 2;
    const size_t tstep = 2 * hstep;
    const unsigned ldsw = (unsigned)wid * 1024u;
    const int aoff = lds_byte(wr * 64 + fr, fq * 8), boff = lds_byte(wc * 32 + fr, fq * 8);
#define PG8_SA(b, h) (((b) * 2 + (h)) * HTB)
#define PG8_SB(b, h) ((4 + (b) * 2 + (h)) * HTB)
#define PG8_STAGE(bufoff, gbase, voff) do { _Pragma("unroll") for (int _i = 0; _i < 2; ++_i) \
        __builtin_amdgcn_global_load_lds((const unsigned*)((const char*)(gbase) + (voff)[_i]), (PG8_LAS unsigned*)(lds + (bufoff) + ldsw + _i * 8192), 16, 0, 0); } while (0)
#define PG8_LDA(dst, b, h) do { _Pragma("unroll") for (int m = 0; m < 4; ++m) _Pragma("unroll") for (int k = 0; k < 2; ++k) dst[m][k] = *(const PG8_LAS bf16x8*)(lds + PG8_SA(b, h) + aoff + m * 2048 + k * 1024); } while (0)
#define PG8_LDB(dst, b, h) do { _Pragma("unroll") for (int n = 0; n < 2; ++n) _Pragma("unroll") for (int k = 0; k < 2; ++k) dst[n][k] = *(const PG8_LAS bf16x8*)(lds + PG8_SB(b, h) + boff + n * 2048 + k * 1024); } while (0)
#define PG8_MMA(ai, bj, At, Bt) do { __builtin_amdgcn_s_setprio(1); _Pragma("unroll") for (int m = 0; m < 4; ++m) _Pragma("unroll") for (int n = 0; n < 2; ++n) _Pragma("unroll") for (int k = 0; k < 2; ++k) \
        acc[ai][bj][m][n] = __builtin_amdgcn_mfma_f32_16x16x32_bf16(Bt[n][k], At[m][k], acc[ai][bj][m][n], 0, 0, 0); __builtin_amdgcn_s_setprio(0); } while (0)
#define PG8_WAIT_V(n) asm volatile("s_waitcnt vmcnt(" #n ")" ::: "memory")
#define PG8_WAIT_L(n) asm volatile("s_waitcnt lgkmcnt(" #n ")" ::: "memory")
#define PG8_BAR __builtin_amdgcn_s_barrier()
#define PG8_SCHED __builtin_amdgcn_sched_barrier(0)
    Unit cur, nxt; int ui = 0;
    if (!S.next(0, cur)) return;
    f32x4 acc[2][2][4][2];
#pragma unroll
    for (int a = 0; a < 2; ++a)
#pragma unroll
        for (int b = 0; b < 2; ++b)
#pragma unroll
            for (int m = 0; m < 4; ++m)
#pragma unroll
                for (int n = 0; n < 2; ++n) acc[a][b][m][n] = (f32x4){0.f, 0.f, 0.f, 0.f};
    bf16x8 At[4][2], B0[2][2], B1[2][2];
    const char* cA = (const char*)g.A + (size_t)cur.pm * tstep; const char* cB = (const char*)g.Bt + (size_t)cur.pn * tstep;
    S.a_ready(cur);
    if constexpr (SP2) {
        PG8_STAGE(PG8_SB(0, 0), cB, voffB); PG8_STAGE(PG8_SB(0, 1), cB + hstep, voffB); PG8_STAGE(PG8_SA(0, 0), cA, voffA); PG8_STAGE(PG8_SA(0, 1), cA + hstep, voffA);
        if (wr == 1) PG8_BAR;
        PG8_WAIT_V(2); PG8_BAR;
        PG8_STAGE(PG8_SB(1, 0), cB + kstep, voffB); PG8_STAGE(PG8_SA(1, 0), cA + kstep, voffA); PG8_STAGE(PG8_SB(1, 1), cB + hstep + kstep, voffB);
        PG8_WAIT_V(6); PG8_BAR;
    } else {
        PG8_STAGE(PG8_SB(0, 0), cB, voffB); PG8_STAGE(PG8_SA(0, 0), cA, voffA); PG8_STAGE(PG8_SB(0, 1), cB + hstep, voffB); PG8_STAGE(PG8_SA(0, 1), cA + hstep, voffA);
        if (wr == 1) PG8_BAR;
        PG8_WAIT_V(4); PG8_BAR;
        PG8_STAGE(PG8_SB(1, 0), cB + kstep, voffB); PG8_STAGE(PG8_SA(1, 0), cA + kstep, voffA); PG8_STAGE(PG8_SB(1, 1), cB + hstep + kstep, voffB);
        PG8_WAIT_V(6); PG8_BAR;
    }
    for (;;) {
        const bool has_next = S.next(ui + 1, nxt);
        const char* nA = has_next ? (const char*)g.A + (size_t)nxt.pm * tstep : cA; const char* nB = has_next ? (const char*)g.Bt + (size_t)nxt.pn * tstep : cB;
        for (int t = 0; t < nt; t += 2) {
            const bool last = (t == nt - 2);
            const char* a1 = cA + (size_t)(t + 1) * kstep;
            const char* a2 = last ? nA : cA + (size_t)(t + 2) * kstep; const char* b2 = last ? nB : cB + (size_t)(t + 2) * kstep;
            const char* a3 = a2 + kstep; const char* b3 = b2 + kstep;
            if (last && has_next) S.a_ready(nxt);
            if constexpr (Epi::HAS_MID) { if (t == nt / 2) E.mid(acc, cur, wr, fr); }
            if constexpr (SP2) {
            PG8_LDB(B0, 0, 0); PG8_LDB(B1, 0, 1); PG8_SCHED; PG8_LDA(At, 0, 0); PG8_STAGE(PG8_SA(1, 1), a1 + hstep, voffA);
            PG8_WAIT_V(8); PG8_WAIT_L(0); PG8_BAR; PG8_MMA(0, 0, At, B0); PG8_MMA(0, 1, At, B1); PG8_BAR; PG8_SCHED;
            PG8_LDA(At, 0, 1); PG8_STAGE(PG8_SB(0, 0), b2, voffB); PG8_STAGE(PG8_SB(0, 1), b2 + hstep, voffB); PG8_STAGE(PG8_SA(0, 0), a2, voffA);
            PG8_WAIT_V(8); PG8_WAIT_L(0); PG8_BAR; PG8_MMA(1, 0, At, B0); PG8_MMA(1, 1, At, B1); PG8_BAR; PG8_SCHED;
            PG8_LDB(B0, 1, 0); PG8_LDB(B1, 1, 1); PG8_SCHED; PG8_LDA(At, 1, 0); PG8_STAGE(PG8_SA(0, 1), a2 + hstep, voffA);
            PG8_WAIT_V(8); PG8_WAIT_L(0); PG8_BAR; PG8_MMA(0, 0, At, B0); PG8_MMA(0, 1, At, B1); PG8_BAR; PG8_SCHED;
            PG8_LDA(At, 1, 1); PG8_STAGE(PG8_SB(1, 0), b3, voffB); PG8_STAGE(PG8_SB(1, 1), b3 + hstep, voffB); PG8_STAGE(PG8_SA(1, 0), a3, voffA);
            PG8_WAIT_V(8); PG8_WAIT_L(0); PG8_BAR; PG8_MMA(1, 0, At, B0); PG8_MMA(1, 1, At, B1); PG8_BAR; PG8_SCHED;
            } else {
            PG8_LDB(B0, 0, 0); PG8_SCHED; PG8_LDA(At, 0, 0); PG8_STAGE(PG8_SA(1, 1), a1 + hstep, voffA);
            PG8_WAIT_L(8); PG8_BAR; PG8_WAIT_L(0); PG8_MMA(0, 0, At, B0); PG8_BAR; PG8_SCHED;
            PG8_LDB(B1, 0, 1); PG8_STAGE(PG8_SB(0, 0), b2, voffB);
            PG8_BAR; PG8_WAIT_L(0); PG8_MMA(0, 1, At, B1); PG8_BAR;
            PG8_LDA(At, 0, 1); PG8_STAGE(PG8_SA(0, 0), a2, voffA);
            PG8_BAR; PG8_WAIT_L(0); PG8_MMA(1, 0, At, B0); PG8_BAR; PG8_SCHED;
            PG8_STAGE(PG8_SB(0, 1), b2 + hstep, voffB);
            PG8_WAIT_V(6); PG8_BAR; PG8_MMA(1, 1, At, B1); PG8_BAR;
            PG8_LDB(B0, 1, 0); PG8_SCHED; PG8_LDA(At, 1, 0); PG8_STAGE(PG8_SA(0, 1), a2 + hstep, voffA);
            PG8_WAIT_L(8); PG8_BAR; PG8_WAIT_L(0); PG8_MMA(0, 0, At, B0); PG8_BAR; PG8_SCHED;
            PG8_LDB(B1, 1, 1); PG8_STAGE(PG8_SB(1, 0), b3, voffB);
            PG8_BAR; PG8_WAIT_L(0); PG8_MMA(0, 1, At, B1); PG8_BAR;
            PG8_LDA(At, 1, 1); PG8_STAGE(PG8_SA(1, 0), a3, voffA);
            PG8_BAR; PG8_WAIT_L(0); PG8_MMA(1, 0, At, B0); PG8_BAR; PG8_SCHED;
            PG8_STAGE(PG8_SB(1, 1), b3 + hstep, voffB);
            PG8_WAIT_V(6); PG8_BAR; PG8_MMA(1, 1, At, B1); PG8_BAR;
            }
        }
        if constexpr (ALIGN_EPI) { if (wr == 0) PG8_BAR; }
        if constexpr (!Epi::AFTER_DRAIN) { E(acc, cur, wr, wc, fr, fq); S.done(cur); }
        if (!has_next) break;
#pragma unroll
        for (int a = 0; a < 2; ++a)
#pragma unroll
            for (int b = 0; b < 2; ++b)
#pragma unroll
                for (int m = 0; m < 4; ++m)
#pragma unroll
                    for (int n = 0; n < 2; ++n) acc[a][b][m][n] = (f32x4){0.f, 0.f, 0.f, 0.f};
        cur = nxt; cA = nA; cB = nB; ++ui;
        if constexpr (ALIGN_EPI) { if (wr == 1) PG8_BAR; }
    }
    PG8_WAIT_V(0);
    if constexpr (!ALIGN_EPI) { if (wr == 0) PG8_BAR; }
    PG8_BAR;
    if constexpr (Epi::AFTER_DRAIN) { E.fused(acc, cur, wr, wc, fr, fq, lds, wid, lane); S.done(cur); }
#undef PG8_SA
#undef PG8_SB
#undef PG8_STAGE
#undef PG8_LDA
#undef PG8_LDB
#undef PG8_MMA
#undef PG8_WAIT_V
#undef PG8_WAIT_L
#undef PG8_BAR
#undef PG8_SCHED
}
}

#ifndef PG8_SP2
#define PG8_SP2 true
#endif
#ifndef PG8_ALIGN
#define PG8_ALIGN true
#endif
#include <hip/hip_bf16.h>
#include <cmath>
namespace attn_body {
using bf16=__hip_bfloat16;
using bf16x8=__attribute__((ext_vector_type(8)))short;
using s16x4=__attribute__((ext_vector_type(4)))short;
using f32x16=__attribute__((ext_vector_type(16)))float;
using u32x4=__attribute__((ext_vector_type(4)))unsigned;
using u32x2=__attribute__((ext_vector_type(2)))unsigned;
using f32x4v=__attribute__((ext_vector_type(4)))float;
constexpr int BATCH=8,NHEAD=8,SEQ=4096,D=64,DM=NHEAD*D,OPITCH=1024;
constexpr long QKV_BPAD=((long)SEQ*2816*2-(long)SEQ*DM*2)/2;
constexpr int NW=8,QBLK=32,QB=QBLK*NW,KVBLK=64,NQB=SEQ/QB;
constexpr int ATTN_PITCH=DM, ATTN_UNIT_ROWS=QB;
__device__ __forceinline__ int crow(int r,int hi){return (r&3)+8*(r>>2)+4*hi;}
#define SBAR() __builtin_amdgcn_sched_barrier(0)
__device__ __forceinline__ void cmask(f32x16&p0,f32x16&p1,int jb,int qrel,int hi){
  const float NEG=-INFINITY; int kb=64*jb+4*hi;
  #pragma unroll
  for(int r=0;r<16;++r){int kv=kb+(r&3)+8*(r>>2); if(kv>qrel)p0[r]=NEG; if(kv+32>qrel)p1[r]=NEG;}
}

constexpr int NSLOT=3, SLOTB=8192;
constexpr int LDS_K=0, LDS_V=NSLOT*SLOTB, LDS_WS=2*NSLOT*SLOTB, LDS_OST=LDS_WS+NW*64*4, LDS_BIAS=LDS_OST+NW*4096, LDS_RED=135168, LDS_BYTES=LDS_RED+1024;   static_assert(LDS_BIAS+SEQ*8<=LDS_RED,"attn lds");
constexpr float C2=0.125f*1.4426950408889634f;
__device__ __forceinline__ void glds16(const void*gsrc,unsigned lds_dst){unsigned keep;
  asm volatile("s_mov_b32 %0, m0\n\ts_mov_b32 m0, %2\n\ts_nop 0\n\tglobal_load_lds_dwordx4 %1, off\n\ts_mov_b32 m0, %0":"=&s"(keep):"v"(gsrc),"s"(lds_dst):"memory");}
__device__ __forceinline__ float max3f(float a,float b,float c){float r;asm("v_max3_f32 %0, %1, %2, %3":"=v"(r):"v"(a),"v"(b),"v"(c));return r;}
__device__ __forceinline__ float max2f(float a,float b){float r;asm("v_max_f32_e32 %0, %1, %2":"=v"(r):"v"(a),"v"(b));return r;}
__device__ __forceinline__ float fadd_s(float a,float b){float r;asm("v_add_f32_e32 %0, %1, %2":"=v"(r):"v"(a),"v"(b));return r;}
__device__ __forceinline__ float fsub_s(float a,float b){float r;asm("v_sub_f32_e32 %0, %1, %2":"=v"(r):"v"(a),"v"(b));return r;}
typedef float f32x2_t __attribute__((ext_vector_type(2))); typedef __bf16 bf16x2_t __attribute__((ext_vector_type(2)));
__device__ __forceinline__ unsigned cvtpk_s(float lo,float hi){f32x2_t v={lo,hi};bf16x2_t b=__builtin_convertvector(v,bf16x2_t);return __builtin_bit_cast(unsigned,b);}
#define WAIT_BAR(N) asm volatile("s_waitcnt vmcnt(" #N ") lgkmcnt(0)\n\ts_barrier":::"memory")

__device__ __forceinline__ void qkt(f32x16&p0,f32x16&p1,const char*Kslot,const bf16x8*qr,const f32x16&negm,int r32,int hi,bf16x8 kx0,bf16x8 kx1,bf16x8 qx){
  const char*kb=Kslot+hi*1024+r32*16;
  p0=__builtin_amdgcn_mfma_f32_32x32x16_bf16(kx0,qx,negm,0,0,0);p1=__builtin_amdgcn_mfma_f32_32x32x16_bf16(kx1,qx,negm,0,0,0);
  #pragma unroll
  for(int d0=0;d0<4;++d0){
    const bf16x8 b0=*reinterpret_cast<const bf16x8*>(kb+d0*2048);
    const bf16x8 b1=*reinterpret_cast<const bf16x8*>(kb+d0*2048+512);
    p0=__builtin_amdgcn_mfma_f32_32x32x16_bf16(b0,qr[d0],p0,0,0,0);p1=__builtin_amdgcn_mfma_f32_32x32x16_bf16(b1,qr[d0],p1,0,0,0);}
}
typedef __attribute__((address_space(3))) const char* lds_cptr;
typedef short v4i16_t __attribute__((ext_vector_type(4)));
__device__ __forceinline__ void kload8(bf16x8*kf,lds_cptr kp){
  kf[0]=*(const __attribute__((address_space(3))) bf16x8*)(kp);      kf[1]=*(const __attribute__((address_space(3))) bf16x8*)(kp+512);
  kf[2]=*(const __attribute__((address_space(3))) bf16x8*)(kp+2048); kf[3]=*(const __attribute__((address_space(3))) bf16x8*)(kp+2560);
  kf[4]=*(const __attribute__((address_space(3))) bf16x8*)(kp+4096); kf[5]=*(const __attribute__((address_space(3))) bf16x8*)(kp+4608);
  kf[6]=*(const __attribute__((address_space(3))) bf16x8*)(kp+6144); kf[7]=*(const __attribute__((address_space(3))) bf16x8*)(kp+6656);
}
__device__ __forceinline__ void kload2(bf16x8*kf,lds_cptr kp,int j){ kf[2*j]=*(const __attribute__((address_space(3))) bf16x8*)(kp+j*2048); kf[2*j+1]=*(const __attribute__((address_space(3))) bf16x8*)(kp+j*2048+512); }
__device__ __forceinline__ s16x4 vtr(lds_cptr p){ return __builtin_bit_cast(s16x4,__builtin_amdgcn_ds_read_tr16_b64_v4i16((__attribute__((address_space(3))) v4i16_t*)p)); }
__device__ __forceinline__ float rowmax(const f32x16&p0,const f32x16&p1){
  float a=max3f(p0[0],p0[1],p1[0]),b=max3f(p0[2],p0[3],p1[1]);a=max3f(a,p1[2],p1[3]);
  #pragma unroll
  for(int r=4;r<16;r+=4){a=max3f(a,p0[r],p0[r+1]);b=max3f(b,p0[r+2],p0[r+3]);a=max3f(a,p1[r],p1[r+1]);b=max3f(b,p1[r+2],p1[r+3]);}
  const float m=max2f(a,b);
  auto rr=__builtin_amdgcn_permlane32_swap(__float_as_uint(m),__float_as_uint(m),false,false);
  return max2f(__uint_as_float(rr[0]),__uint_as_float(rr[1]));
}
__device__ __forceinline__ void pv(f32x16*o,int vb,bf16x8 pa0,bf16x8 pa1,bf16x8 pa2,bf16x8 pa3){
  #pragma unroll
  for(int d0=0;d0<2;++d0){s16x4 lo[4],hi[4];
    #pragma unroll
    for(int ks=0;ks<4;++ks){
      asm volatile("ds_read_b64_tr_b16 %0,%1 offset:%c2":"=&v"(lo[ks]):"v"(vb),"i"(d0*4096+ks*1024):"memory");
      asm volatile("ds_read_b64_tr_b16 %0,%1 offset:%c2":"=&v"(hi[ks]):"v"(vb),"i"(d0*4096+ks*1024+512):"memory");}
    asm volatile("s_waitcnt lgkmcnt(0)":::"memory");SBAR();
    #define PK(k) (bf16x8){lo[k][0],lo[k][1],lo[k][2],lo[k][3],hi[k][0],hi[k][1],hi[k][2],hi[k][3]}
    o[d0]=__builtin_amdgcn_mfma_f32_32x32x16_bf16(pa0,PK(0),o[d0],0,0,0);
    o[d0]=__builtin_amdgcn_mfma_f32_32x32x16_bf16(pa1,PK(1),o[d0],0,0,0);
    o[d0]=__builtin_amdgcn_mfma_f32_32x32x16_bf16(pa2,PK(2),o[d0],0,0,0);
    o[d0]=__builtin_amdgcn_mfma_f32_32x32x16_bf16(pa3,PK(3),o[d0],0,0,0);
    #undef PK
  }
}

#ifndef ATTN_STORE16
#define ATTN_STORE16(p,v) (*(u32x4*)(p)=(v))
#endif
template<int THRL> __device__ __forceinline__ void attn_unit(int b,int h,int qb,const bf16*Q,const bf16*__restrict__ K,const bf16*__restrict__ V,bf16*O,float bound,int ui,const float*__restrict__ cumh,float*ssb,char*shm){
  const int tid=otid(),lane=tid&63,r32=lane&31,hi=lane>>5; const int wid=__builtin_amdgcn_readfirstlane(tid>>6);
  const long rowbase=(long)b*SEQ; const int q0=qb*QB;
  const bf16*Qw=Q+(long)b*QKV_BPAD+(rowbase+q0+wid*QBLK)*DM+h*D;
  const bf16*Kh=K+(long)b*QKV_BPAD+rowbase*DM+h*D,*Vh=V+(long)b*QKV_BPAD+rowbase*DM+h*D;
  const lds_cptr shm3=(lds_cptr)shm;
  const unsigned lds0=(unsigned)(uintptr_t)shm;
  float*wsf=(float*)(shm+LDS_WS)+wid*64;
  const bf16*ksrc0=Kh+(long)lane*DM+wid*8;
  const bf16*vsrc0=Vh+(long)(16*(wid&3)+(lane>>2))*DM+(wid>>2)*32+(lane&3)*8;
  const unsigned kdst=lds0+LDS_K+wid*1024, vdst=lds0+LDS_V+wid*1024;
  #define DMA_K(t,slot) glds16(ksrc+(long)(t)*KVBLK*DM,(unsigned)__builtin_amdgcn_readfirstlane(kdst+(slot)))
  #define DMA_V(t,slot) glds16(vsrc+(long)(t)*KVBLK*DM,(unsigned)__builtin_amdgcn_readfirstlane(vdst+(slot)))
  const int vb0=(int)(lds0+LDS_V)+((lane>>4)&1)*32+(lane&3)*8+(4*hi+((lane&15)>>2))*64;
  const char*Kbase=shm+LDS_K; bf16x8 kf[8];
  const lds_cptr kp0=shm3+LDS_K+hi*1024+r32*16; const lds_cptr vp0=shm3+LDS_V+((lane>>4)&1)*32+(lane&3)*8+(4*hi+((lane&15)>>2))*64;
  int NT=(q0+QB)/KVBLK;
  int ts;
  { __attribute__((address_space(3))) float*red=(__attribute__((address_space(3))) float*)(shm3+LDS_RED);
    const float cref=cumh[q0]; int cnt=0; const int nk=q0+QB;
    float cv[SEQ/(NW*64)];
    #pragma unroll
    for(int k=0;k<SEQ/(NW*64);++k){ const int i=tid+k*NW*64; cv[k]=(i<nk)?cumh[i]:0.f; }
    #pragma unroll
    for(int k=0;k<SEQ/(NW*64);++k){ const int i=tid+k*NW*64; if(i<nk){ const float x=cref-cv[k]; cnt+=(x<=-bound)?1:0; const unsigned u1=__float_as_uint(x)&0xffff0000u; const float r1=x-__uint_as_float(u1);
      const unsigned u2=__float_as_uint(r1)&0xffff0000u; const float r2=r1-__uint_as_float(u2); const unsigned u3=__float_as_uint(r2)&0xffff0000u;
      u32x2 w; w.x=(u1>>16)|u2; w.y=u3>>16; *(__attribute__((address_space(3))) u32x2*)(shm3+LDS_BIAS+i*8)=w; } }
    #pragma unroll
    for(int o=1;o<64;o<<=1)cnt+=__shfl_xor(cnt,o);
    if(lane==0)red[64+ui*8+wid]=(float)cnt;
    asm volatile("s_waitcnt lgkmcnt(0)\n\ts_barrier":::"memory");
    float tot=0.f;
    #pragma unroll
    for(int w=0;w<NW;++w)tot+=red[64+ui*8+w];
    ts=((int)tot>>6)&~1; if(ts>NT-4)ts=NT-4;
    ts=__builtin_amdgcn_readfirstlane(ts); }
  const bf16*ksrc=ksrc0+(long)ts*KVBLK*DM; const bf16*vsrc=vsrc0+(long)ts*KVBLK*DM; NT-=ts;
  const lds_cptr bp0=shm3+LDS_BIAS+r32*8+ts*512;
  bf16x8 qx; { const u32x4 t=(hi==0)?(u32x4){0x3F803F80u,0x00003F80u,0u,0u}:(u32x4){0u,0u,0u,0u}; qx=__builtin_bit_cast(bf16x8,t); }
  #define BIASLD(t,which) ({ const u32x2 w_=*(const __attribute__((address_space(3))) u32x2*)(bp0+(t)*512+(which)*256); const u32x4 t_=(u32x4){w_.x,w_.y,0u,0u}; __builtin_bit_cast(bf16x8,t_); })
  DMA_K(0,0);DMA_V(0,0);DMA_K(1,SLOTB);
  bf16x8 qr[4];
  #pragma unroll
  for(int d0=0;d0<4;++d0)qr[d0]=*reinterpret_cast<const bf16x8*>(&Qw[(long)r32*DM+d0*16+hi*8]);
  float mhat=0.f,l_reg=0.f;f32x16 o[2];o[0]=f32x16{};o[1]=f32x16{};f32x16 negm=f32x16{};asm volatile("":"+v"(negm));
  const int qrel=wid*QBLK+r32;
  #define CMASK(P0,P1,t) do{int jb_=(t)-(NT-4); if(jb_>=0)cmask(P0,P1,jb_,qrel,hi);}while(0)
  bool resc=false;
  #define START(P0,P1) do{ const float rm=rowmax(P0,P1); resc=false; \
    { const float dl=rm; mhat=fadd_s(mhat,dl); \
      _Pragma("unroll") for(int r=0;r<16;++r){P0[r]=fsub_s(P0[r],dl);P1[r]=fsub_s(P1[r],dl);} \
      _Pragma("unroll") for(int r=0;r<16;++r)negm[r]=-mhat; asm volatile("":"+v"(negm)); } \
    _Pragma("unroll") for(int r=0;r<16;++r)P0[r]=__builtin_amdgcn_exp2f(P0[r]); }while(0)
  #define RESC() do{ if(resc){ asm volatile("s_waitcnt lgkmcnt(0)":::"memory"); \
      _Pragma("unroll") for(int d_=0;d_<2;++d_) _Pragma("unroll") for(int r=0;r<16;++r)o[d_][r]*=wsf[crow(r,hi)]; } }while(0)
  f32x16 pA0,pA1,pB0,pB1;
  int sl_prev=0,sl_cur=0,sl_next=SLOTB;
  #define ROT() do{sl_prev=sl_cur;sl_cur=sl_next;sl_next=(sl_next==(NSLOT-1)*SLOTB)?0:sl_next+SLOTB;}while(0)
  DMA_K(2,2*SLOTB);
  WAIT_BAR(3);
  qkt(pA0,pA1,Kbase,qr,negm,r32,hi,BIASLD(0,0),BIASLD(0,1),qx);asm volatile("s_nop 15\n\ts_nop 7":"+v"(pA0),"+v"(pA1));CMASK(pA0,pA1,0);
  START(pA0,pA1);
  _Pragma("unroll") for(int r=0;r<16;++r)pA1[r]=__builtin_amdgcn_exp2f(pA1[r]);
  WAIT_BAR(0);
  DMA_K(3,0);DMA_V(1,SLOTB);
  ROT();
  kload8(kf,kp0+sl_cur);
  WAIT_BAR(2);
  s16x4 vlo[8],vhi[8]; u32x4 pw0,pw1,pw2,pw3;
  #define PKW(P,B) cvtpk_s(P[B],P[B+1])
  #define PAF(k) __builtin_bit_cast(bf16x8,pw##k)
  #define VFR(i) (bf16x8){vlo[i][0],vlo[i][1],vlo[i][2],vlo[i][3],vhi[i][0],vhi[i][1],vhi[i][2],vhi[i][3]}
  #define PIN(x) asm volatile("":"+v"(x))
  #define MX3(a,b,c) __builtin_fmaxf(__builtin_fmaxf((a),(b)),(c))
  #define GAPA(MF,A0,A1,A2,A3,W0,W1,PW) do{ MF; sacc+=A0; sacc+=A1; sacc+=A2; sacc+=A3; PIN(sacc); W0; W1; PIN(PW); SBAR(); }while(0)
  #define EX(v) __builtin_amdgcn_exp2f(v)
  #define GAPB(MF,X,B) do{ MF; X[B]=EX(X[B]); X[B+1]=EX(X[B+1]); X[B+2]=EX(X[B+2]); X[B+3]=EX(X[B+3]); PIN(X); SBAR(); }while(0)
  #define VRD(i) do{ vlo[i]=vtr(vp_+(((i)>>2)*4096+((i)&3)*1024)); vhi[i]=vtr(vp_+(((i)>>2)*4096+((i)&3)*1024+512)); }while(0)
  #define KRD(G,j) do{ if(G){ kload2(kf,kp0+sl_next,j); SBAR(); } }while(0)
  #define STEP(C0,C1,P0,P1,t,GK,GV,GL) do{ SBAR(); \
    const lds_cptr vp_=vp0+sl_prev; \
    C0=__builtin_amdgcn_mfma_f32_32x32x16_bf16(kbx0,qx,negm,0,0,0); C1=__builtin_amdgcn_mfma_f32_32x32x16_bf16(kbx1,qx,negm,0,0,0); SBAR(); \
    VRD(0); SBAR(); float sacc=(P0[0]+P0[1]); \
    GAPA(C0=__builtin_amdgcn_mfma_f32_32x32x16_bf16(kf[0],qr[0],C0,0,0,0), P0[2],P0[3],P0[4],P0[5],     pw0[0]=PKW(P0,0), pw0[1]=PKW(P0,2), pw0); \
    VRD(4); SBAR(); GAPA(C1=__builtin_amdgcn_mfma_f32_32x32x16_bf16(kf[1],qr[0],C1,0,0,0), P0[6],P0[7],P0[8],P0[9],     pw0[2]=PKW(P0,4), pw0[3]=PKW(P0,6), pw0); \
    VRD(1); SBAR(); GAPA(C0=__builtin_amdgcn_mfma_f32_32x32x16_bf16(kf[2],qr[1],C0,0,0,0),   P0[10],P0[11],P0[12],P0[13], pw1[0]=PKW(P0,8), pw1[1]=PKW(P0,10), pw1); \
    VRD(5); SBAR(); GAPA(C1=__builtin_amdgcn_mfma_f32_32x32x16_bf16(kf[3],qr[1],C1,0,0,0),   P0[14],P0[15],P1[0],P1[1],   pw1[2]=PKW(P0,12),pw1[3]=PKW(P0,14), pw1); \
    VRD(2); SBAR(); GAPA(C0=__builtin_amdgcn_mfma_f32_32x32x16_bf16(kf[4],qr[2],C0,0,0,0),   P1[2],P1[3],P1[4],P1[5],     pw2[0]=PKW(P1,0), pw2[1]=PKW(P1,2), pw2); \
    VRD(6); SBAR(); GAPA(C1=__builtin_amdgcn_mfma_f32_32x32x16_bf16(kf[5],qr[2],C1,0,0,0),   P1[6],P1[7],P1[8],P1[9],     pw2[2]=PKW(P1,4), pw2[3]=PKW(P1,6), pw2); \
    VRD(3); SBAR(); GAPA(C0=__builtin_amdgcn_mfma_f32_32x32x16_bf16(kf[6],qr[3],C0,0,0,0),   P1[10],P1[11],P1[12],P1[13], pw3[0]=PKW(P1,8), pw3[1]=PKW(P1,10), pw3); \
    VRD(7); SBAR(); GAPA(C1=__builtin_amdgcn_mfma_f32_32x32x16_bf16(kf[7],qr[3],C1,0,0,0),   P1[14],P1[15],0.f,0.f,       pw3[2]=PKW(P1,12),pw3[3]=PKW(P1,14), pw3); \
    l_reg+=sacc; \
    if(GK){DMA_K((t)+3,sl_cur);} if(GV){DMA_V((t)+1,sl_next);} \
    CMASK(C0,C1,t); \
    { float a=MX3(C0[0],C0[1],C1[0]),b=MX3(C0[2],C0[3],C1[1]); a=MX3(a,C1[2],C1[3]); \
      _Pragma("unroll") for(int r=4;r<16;r+=4){a=MX3(a,C0[r],C0[r+1]);b=MX3(b,C0[r+2],C0[r+3]);a=MX3(a,C1[r],C1[r+1]);b=MX3(b,C1[r+2],C1[r+3]);} \
      float rm=__builtin_fmaxf(a,b); { auto rr=__builtin_amdgcn_permlane32_swap(__float_as_uint(rm),__float_as_uint(rm),false,false); rm=__builtin_fmaxf(__uint_as_float(rr[0]),__uint_as_float(rr[1])); } \
      resc=false; \
      if(__builtin_expect(__any(rm>(float)THRL),0)){ const float dl=__builtin_fmaxf(rm,0.f); mhat+=dl; \
        _Pragma("unroll") for(int r=0;r<16;++r){C0[r]-=dl;C1[r]-=dl;} \
        _Pragma("unroll") for(int r=0;r<16;++r)negm[r]=-mhat; asm volatile("":"+v"(negm)); \
        const float f=__builtin_amdgcn_exp2f(-dl); l_reg*=f; if(hi==0)wsf[r32]=f; resc=true; } } \
    SBAR(); \
    GAPB(o[0]=__builtin_amdgcn_mfma_f32_32x32x16_bf16(PAF(0),VFR(0),o[0],0,0,0), C0,0); \
    GAPB(o[1]=__builtin_amdgcn_mfma_f32_32x32x16_bf16(PAF(0),VFR(4),o[1],0,0,0), C0,4); \
    KRD(GL,0); GAPB(o[0]=__builtin_amdgcn_mfma_f32_32x32x16_bf16(PAF(1),VFR(1),o[0],0,0,0), C0,8); \
    KRD(GL,1); GAPB(o[1]=__builtin_amdgcn_mfma_f32_32x32x16_bf16(PAF(1),VFR(5),o[1],0,0,0), C0,12); \
    KRD(GL,2); GAPB(o[0]=__builtin_amdgcn_mfma_f32_32x32x16_bf16(PAF(2),VFR(2),o[0],0,0,0), C1,0); \
    KRD(GL,3); GAPB(o[1]=__builtin_amdgcn_mfma_f32_32x32x16_bf16(PAF(2),VFR(6),o[1],0,0,0), C1,4); \
    GAPB(o[0]=__builtin_amdgcn_mfma_f32_32x32x16_bf16(PAF(3),VFR(3),o[0],0,0,0), C1,8); \
    GAPB(o[1]=__builtin_amdgcn_mfma_f32_32x32x16_bf16(PAF(3),VFR(7),o[1],0,0,0), C1,12); \
    if(GL){ kbx0=BIASLD((t)+1,0); kbx1=BIASLD((t)+1,1); } \
    }while(0)
  int t=1; bf16x8 kbx0=BIASLD(1,0),kbx1=BIASLD(1,1);
  #undef CMASK
  #define CMASK(P0,P1,t) do{}while(0)
  for(;t+5<NT;t+=2){
    STEP(pB0,pB1,pA0,pA1,t,true,true,true);     WAIT_BAR(2); RESC(); ROT();
    STEP(pA0,pA1,pB0,pB1,t+1,true,true,true);   WAIT_BAR(2); RESC(); ROT();
  }
  #undef CMASK
  #define CMASK(P0,P1,t) do{int jb_=(t)-(NT-4); if(jb_>=0)cmask(P0,P1,jb_,qrel,hi);}while(0)
  #define ENDW(tt) do{ if((tt)+3<NT){WAIT_BAR(2);} else if((tt)+2<NT){WAIT_BAR(1);} else {WAIT_BAR(0);} }while(0)
  for(;t+1<NT;t+=2){
    STEP(pB0,pB1,pA0,pA1,t,(t+3<NT),(t+1<NT),(t+1<NT));       ENDW(t);   RESC(); ROT();
    STEP(pA0,pA1,pB0,pB1,t+1,(t+4<NT),(t+2<NT),(t+2<NT));     ENDW(t+1); RESC(); ROT();
  }
  STEP(pB0,pB1,pA0,pA1,NT-1,false,false,false); RESC();
  { float sacc=pB0[0]+pB0[1]; _Pragma("unroll") for(int r=2;r<16;++r)sacc+=pB0[r]; _Pragma("unroll") for(int r=0;r<16;++r)sacc+=pB1[r]; l_reg+=sacc;
    pw0=(u32x4){PKW(pB0,0),PKW(pB0,2),PKW(pB0,4),PKW(pB0,6)};pw1=(u32x4){PKW(pB0,8),PKW(pB0,10),PKW(pB0,12),PKW(pB0,14)};pw2=(u32x4){PKW(pB1,0),PKW(pB1,2),PKW(pB1,4),PKW(pB1,6)};pw3=(u32x4){PKW(pB1,8),PKW(pB1,10),PKW(pB1,12),PKW(pB1,14)};
    SBAR(); pv(o,vb0+sl_cur,PAF(0),PAF(1),PAF(2),PAF(3)); }
  #undef PKW
  #undef PAF
  #undef VFR
  #undef PIN
  #undef MX3
  #undef GAPA
  #undef GAPB
  #undef EX
  #undef VRD
  #undef KRD
  #undef STEP
  #undef ENDW
  {auto rr=__builtin_amdgcn_permlane32_swap(__float_as_uint(l_reg),__float_as_uint(l_reg),false,false);l_reg=__uint_as_float(rr[0])+__uint_as_float(rr[1]);}
  if(hi==0)wsf[32+r32]=l_reg;asm volatile("s_waitcnt lgkmcnt(0)":::"memory");
  float rli[16];
  #pragma unroll
  for(int r=0;r<16;++r)rli[r]=__builtin_amdgcn_rcpf(wsf[32+crow(r,hi)]);
  bf16*Ow=O+(rowbase+q0+wid*QBLK)*OPITCH+h*D; float*ssw=ssb+(long)h*(BATCH*SEQ)+rowbase+q0+wid*QBLK;
  { bf16*stg=(bf16*)(shm+LDS_OST)+wid*2048;
    #pragma unroll
    for(int r=0;r<16;++r){const int orow=crow(r,hi);
      #pragma unroll
      for(int d0=0;d0<2;++d0)stg[orow*64+d0*32+r32]=__float2bfloat16(o[d0][r]*rli[r]);}
    asm volatile("s_waitcnt lgkmcnt(0)":::"memory");
    #pragma unroll
    for(int i=0;i<4;++i){const int row=i*8+(lane>>3),ch=lane&7; const u32x4 v=*(const u32x4*)(stg+row*64+ch*8); ATTN_STORE16(Ow+(long)row*OPITCH+ch*8,v);
      float q=0.f;
      #pragma unroll
      for(int e=0;e<4;++e){const float lo=__uint_as_float(v[e]<<16),hi2=__uint_as_float(v[e]&0xffff0000u); q+=lo*lo+hi2*hi2;}
      q+=__shfl_xor(q,1);q+=__shfl_xor(q,2);q+=__shfl_xor(q,4); if(ch==0)ssw[row]=q;} }
  asm volatile("s_waitcnt lgkmcnt(0)\n\ts_barrier":::"memory");
  #undef DMA_K
  #undef DMA_V
  #undef BIASLD
  #undef CMASK
  #undef START
  #undef RESC
  #undef ROT
}
constexpr int ATTN_LDS_BYTES=LDS_BYTES;
struct AttnTensors { const bf16* Q; const bf16* K; const bf16* V; bf16* O; const float* cum2; float* ssb; float* kpart; };
struct AttnUnit { int bh; int qb; };
struct StaticOrder {
  int vcu;
  __device__ __forceinline__ explicit StaticOrder(int grid,int block):vcu((block%8)*(grid/8)+block/8){}
  __device__ __forceinline__ bool next(int i,AttnUnit&u)const{ if(i>=4||vcu>=256)return false; const int s=(vcu>>3)&3,h0=vcu&7; u.bh=(vcu>>5)*NHEAD+((h0+2*i)&7); u.qb=(i==0)?s:(i==1)?7-s:(i==2)?8+s:15-s; return true; }
  __device__ __forceinline__ void a_ready(const AttnUnit&)const{}
  __device__ __forceinline__ void done(const AttnUnit&)const{}
};
template<class Sched> __device__ __forceinline__ void attn_pre(char*lds,const AttnTensors&T,const Sched&S){
  AttnUnit u;
  if(!S.next(0,u))return;
  const int tid=otid(),lane=tid&63; const int wid=__builtin_amdgcn_readfirstlane(tid>>6); const int b=u.bh/NHEAD;
  typedef __attribute__((address_space(3))) float ldsf;
  ldsf*red=(ldsf*)((lds_cptr)lds+LDS_RED);
  { const int hk=S.vcu&7,sk=(S.vcu>>3)&3; float mx=0.f; const bf16*Kh=T.K+(long)b*QKV_BPAD+((long)b*SEQ+sk*(SEQ/4))*DM+hk*D;
    for(int r=tid;r<SEQ/4;r+=NW*64){ const u32x4*pr=(const u32x4*)(Kh+(long)r*DM); float q=0.f;
      #pragma unroll
      for(int c=0;c<8;++c){ const u32x4 v=pr[c];
        #pragma unroll
        for(int e=0;e<4;++e){ const float lo=__uint_as_float(v[e]<<16),hi2=__uint_as_float(v[e]&0xffff0000u); q+=lo*lo+hi2*hi2; } }
      mx=fmaxf(mx,q); }
    #pragma unroll
    for(int o=1;o<64;o<<=1)mx=fmaxf(mx,__shfl_xor(mx,o));
    if(lane==0)red[wid]=mx;
    __syncthreads();
    if(tid==0){ float m=0.f;
      #pragma unroll
      for(int w=0;w<NW;++w)m=fmaxf(m,red[w]);
      T.kpart[(b*NHEAD+hk)*4+sk]=m; } }
  for(int ui=0;ui<4;++ui){ AttnUnit uu; if(!S.next(ui,uu))break; const int h=uu.bh%NHEAD;
    const long row=(long)b*SEQ+uu.qb*QB+(tid>>1);
    const u32x4*pr=(const u32x4*)(T.Q+(long)b*QKV_BPAD+row*DM+h*D+(tid&1)*32); const u32x4*pk=(const u32x4*)(T.K+(long)b*QKV_BPAD+row*DM+h*D+(tid&1)*32); float q=0.f,dg=0.f;
    #pragma unroll
    for(int c=0;c<4;++c){ const u32x4 v=pr[c],kv=pk[c];
      #pragma unroll
      for(int e=0;e<4;++e){ const float lo=__uint_as_float(v[e]<<16),hi2=__uint_as_float(v[e]&0xffff0000u); q+=lo*lo+hi2*hi2;
        dg+=lo*__uint_as_float(kv[e]<<16)+hi2*__uint_as_float(kv[e]&0xffff0000u); } }
    q+=__shfl_xor(q,1); dg+=__shfl_xor(dg,1);
    dg+=T.cum2[(long)uu.bh*SEQ+uu.qb*QB]-T.cum2[(long)uu.bh*SEQ+uu.qb*QB+(tid>>1)];
    #pragma unroll
    for(int o=2;o<64;o<<=1){q=fmaxf(q,__shfl_xor(q,o));dg=fminf(dg,__shfl_xor(dg,o));}
    if(lane==0){red[8+ui*8+wid]=q;red[96+ui*8+wid]=dg;} }
  __syncthreads();
}
template<class Sched,int THRL=24> __device__ __forceinline__ void attn_run(char*lds,const AttnTensors&T,const Sched&S){
  AttnUnit u;
  for(int i=0;S.next(i,u);++i){ S.a_ready(u);
    float bound;
    { typedef __attribute__((address_space(3))) float ldsf; const ldsf*red=(const ldsf*)((lds_cptr)lds+LDS_RED); float q2=0.f,dmin=3.0e38f;
      const float*kp=T.kpart+u.bh*4; const float k2=fmaxf(fmaxf(kp[0],kp[1]),fmaxf(kp[2],kp[3]));
      #pragma unroll
      for(int w=0;w<NW;++w){q2=fmaxf(q2,red[8+i*8+w]);dmin=fminf(dmin,red[96+i*8+w]);}
      const float qk=sqrtf(k2*q2)*1.001f;
      bound=qk+32.0f+0.05f-fmaxf(fminf(dmin,0.f),-qk); }
    attn_unit<THRL>(u.bh/NHEAD,u.bh%NHEAD,u.qb,T.Q,T.K,T.V,T.O,bound,i,T.cum2+(long)u.bh*SEQ,T.ssb,lds); S.done(u); }
}
#undef SBAR
#undef WAIT_BAR
}
constexpr int NWAVES = 8;
constexpr int BATCH = 8, SEQ = 4096, DM_ = 1024, DFF = 2816, NIN = 2568, DA = 512, HA = 8, HB = 8;
constexpr int M = BATCH * SEQ;
constexpr float EPS = 1e-6f;
constexpr size_t MiB = 1u << 20;
constexpr size_t WS_MOD = 0;
constexpr size_t WS_LOGF = 1 * MiB;
constexpr size_t WS_CUM = 2 * MiB;
constexpr size_t WS_SS = 3 * MiB;
constexpr size_t WS_SSA = 5 * MiB;
constexpr size_t WS_SSB = 6 * MiB;
constexpr size_t WS_WGU0 = 8 * MiB;
constexpr size_t WS_WGU1 = 20 * MiB;
constexpr size_t WS_WD0 = 32 * MiB;
constexpr size_t WS_WD1 = 38 * MiB;
constexpr size_t WS_WIN = 44 * MiB;
constexpr size_t WS_WOUT = 50 * MiB;
constexpr size_t WS_H = 64 * MiB;
constexpr size_t WS_HD = 128 * MiB;
constexpr size_t WS_ACT = 192 * MiB;
constexpr size_t BSLAB = (size_t)SEQ * DFF * 2;
constexpr size_t WS_ZG = WS_ACT;
constexpr size_t WS_Q = WS_ACT + 8 * MiB, WS_K = WS_ACT + 12 * MiB, WS_V = WS_ACT + 16 * MiB;
constexpr size_t PAD_ZG = (BSLAB - (size_t)SEQ * 1024 * 2) / 2, PAD_QKV = (BSLAB - (size_t)SEQ * 512 * 2) / 2;
static_assert(BSLAB == 22 * MiB && 8 * MiB + 3 * (size_t)SEQ * 512 * 2 <= BSLAB, "slab map");
constexpr size_t WS_Y = WS_H;
constexpr size_t WS_X1 = 416 * MiB;
constexpr size_t WS_END = 480 * MiB;
static_assert(WS_ACT + (size_t)M * DFF * 2 <= 416 * MiB && WS_X1 + (size_t)M * 1024 * 2 <= WS_END, "ws map");
constexpr int LDS_BYTES = 147456;
constexpr int LDS_BARST = LDS_BYTES - 64;
constexpr size_t WS_KPART = 7 * MiB + 65536;
constexpr size_t WS_CTL = 7 * MiB, CTL_BYTES = 16384;

#define GAS __attribute__((address_space(1)))
#define LAS __attribute__((address_space(3)))
typedef unsigned short bf16;
typedef unsigned v4u __attribute__((ext_vector_type(4)));
typedef unsigned v2u __attribute__((ext_vector_type(2)));
typedef float f32x4 __attribute__((ext_vector_type(4)));
typedef short bf16x8 __attribute__((ext_vector_type(8)));
#define LDS_WAIT() asm volatile("s_waitcnt lgkmcnt(0)" ::: "memory")
__device__ __forceinline__ unsigned f2bf(float f) { unsigned u = __builtin_bit_cast(unsigned, f); return (u + 0x7fffu + ((u >> 16) & 1u)) >> 16; }
typedef float pk_f32x2 __attribute__((ext_vector_type(2))); typedef __bf16 pk_bf16x2 __attribute__((ext_vector_type(2)));
__device__ __forceinline__ unsigned pk2(float lo, float hi) { const pk_f32x2 v = {lo, hi}; return __builtin_bit_cast(unsigned, __builtin_convertvector(v, pk_bf16x2)); }
__device__ __forceinline__ float bf_lo(unsigned w) { return __builtin_bit_cast(float, w << 16); }
__device__ __forceinline__ float bf_hi(unsigned w) { return __builtin_bit_cast(float, w & 0xffff0000u); }
template <int CTRL> __device__ __forceinline__ float dpp_f(float v) { return __builtin_bit_cast(float, __builtin_amdgcn_update_dpp(0, __builtin_bit_cast(int, v), CTRL, 0xF, 0xF, false)); }
__device__ __forceinline__ float wave_sum(float v) {
    v += dpp_f<0xB1>(v); v += dpp_f<0x4E>(v); v += dpp_f<0x141>(v); v += dpp_f<0x140>(v);
    const float r0 = __builtin_bit_cast(float, __builtin_amdgcn_readlane(__builtin_bit_cast(int, v), 0)), r1 = __builtin_bit_cast(float, __builtin_amdgcn_readlane(__builtin_bit_cast(int, v), 16));
    const float r2 = __builtin_bit_cast(float, __builtin_amdgcn_readlane(__builtin_bit_cast(int, v), 32)), r3 = __builtin_bit_cast(float, __builtin_amdgcn_readlane(__builtin_bit_cast(int, v), 48));
    return (r0 + r1) + (r2 + r3);
}

#define XB_TMO      128
#define XB_XCNT(j)  (256  + 64 * (j))
#define XB_XSUB(j)  (1280 + 64 * (j))
#define XB_XGEN(j)  (2304 + 64 * (j))
#define XB_TOP      3328
#define XB_TOPGEN   3392
#define XCD_BAR_WORDS 3456
#define XB_SPIN_CAP (1u << 18)

__device__ __forceinline__ unsigned xb_ld(unsigned* p)              { return __hip_atomic_load(p, __ATOMIC_RELAXED, __HIP_MEMORY_SCOPE_AGENT); }
__device__ __forceinline__ unsigned xb_add(unsigned* p, unsigned v) { return __hip_atomic_fetch_add(p, v, __ATOMIC_RELAXED, __HIP_MEMORY_SCOPE_AGENT); }
__device__ __forceinline__ unsigned xb_xcc_id() { return (unsigned)__builtin_amdgcn_s_getreg((3 << 11) | 20) & 0xFu; }
#define XB_SPIN(cond, bar) do { unsigned _sp = 0; while (cond) { __builtin_amdgcn_s_sleep(1); \
    if ((++_sp & 255u) == 0u) { if (xb_ld(&(bar)[XB_TMO])) break; if (_sp > XB_SPIN_CAP) { atomicAdd(&(bar)[XB_TMO], 1u); break; } } } } while (0)

struct XcdBarrier {
    unsigned* bar; unsigned x;
    volatile LAS unsigned* st;
};

__device__ __forceinline__ XcdBarrier xcd_barrier_post(unsigned* bar, volatile LAS unsigned* st) {
    XcdBarrier b; b.bar = bar; b.x = xb_xcc_id(); b.st = st;
    if (threadIdx.x == 0) st[3] = xb_add(&bar[XB_XCNT(b.x)], 1u);
    return b;
}
__device__ __forceinline__ void xcd_barrier_complete(unsigned* bar, unsigned x, unsigned& nloc, unsigned& nx) {
    const unsigned G = gridDim.x * gridDim.y * gridDim.z;
    unsigned sum, cnt, mine, sp = 0u;
    for (;;) {
        sum = 0u; cnt = 0u; mine = 0u;
#pragma unroll
        for (unsigned j = 0; j < 16; ++j) { const unsigned c = xb_ld(&bar[XB_XCNT(j)]); sum += c; cnt += (c > 0u) ? 1u : 0u; mine = (j == x) ? c : mine; }
        if (sum == G) break;
        __builtin_amdgcn_s_sleep(1);
        if ((++sp & 255u) == 0u) { if (xb_ld(&bar[XB_TMO])) break; if (sp > XB_SPIN_CAP) { atomicAdd(&bar[XB_TMO], 1u); break; } }
    }
    nloc = mine > 0u ? mine : 1u; nx = cnt > 0u ? cnt : 1u;
}
__device__ __forceinline__ unsigned xcd_census_uniform(unsigned* bar) {
    unsigned ok = (gridDim.x == 256u) ? 1u : 0u;
#pragma unroll
    for (unsigned j = 0; j < 16; ++j) { const unsigned c = xb_ld(&bar[XB_XCNT(j)]); ok &= (c == (j < 8u ? 32u : 0u)) ? 1u : 0u; }
    return ok;
}

__device__ __forceinline__ void xcd_barrier(const XcdBarrier& b) {
    asm volatile("s_waitcnt vmcnt(0)" ::: "memory");
    __syncthreads();
    if (threadIdx.x == 0) {
        unsigned* bar = b.bar;
        __builtin_amdgcn_s_waitcnt(0);
        unsigned nloc = b.st[0], nx = b.st[1];
        if (nloc == 0u) { xcd_barrier_complete(bar, b.x, nloc, nx); b.st[0] = nloc; b.st[1] = nx; b.st[2] = xcd_census_uniform(bar); }
        const unsigned old = xb_add(&bar[XB_XSUB(b.x)], 1u);
        const unsigned gen = old / nloc;
        if (old + 1u == (gen + 1u) * nloc) {
            __builtin_amdgcn_fence(__ATOMIC_RELEASE, "agent");
            asm volatile("s_waitcnt vmcnt(0)" ::: "memory");
            const unsigned og = xb_add(&bar[XB_TOP], 1u);
            const unsigned tg = og / nx;
            if (og + 1u == (tg + 1u) * nx) xb_add(&bar[XB_TOPGEN], 1u);
            else XB_SPIN(xb_ld(&bar[XB_TOPGEN]) == tg, bar);
            __builtin_amdgcn_fence(__ATOMIC_ACQUIRE, "agent");
            xb_add(&bar[XB_XGEN(b.x)], 1u);
            asm volatile("s_waitcnt vmcnt(0)" ::: "memory");
        } else {
            XB_SPIN(xb_ld(&bar[XB_XGEN(b.x)]) == gen, bar);
            __builtin_amdgcn_fence(__ATOMIC_ACQUIRE, "agent");
            asm volatile("s_waitcnt vmcnt(0)" ::: "memory");
        }
    }
    __syncthreads();
}

__device__ __forceinline__ void xcd_local_barrier(const XcdBarrier& b) {
    asm volatile("s_waitcnt vmcnt(0)" ::: "memory");
    __syncthreads();
    if (threadIdx.x == 0) {
        unsigned* bar = b.bar;
        __builtin_amdgcn_s_waitcnt(0);
        const unsigned nloc = b.st[0];
        const unsigned old = xb_add(&bar[XB_XSUB(b.x)], 1u);
        const unsigned gen = old / nloc;
        if (old + 1u == (gen + 1u) * nloc) xb_add(&bar[XB_XGEN(b.x)], 1u);
        else XB_SPIN(xb_ld(&bar[XB_XGEN(b.x)]) == gen, bar);
        __builtin_amdgcn_fence(__ATOMIC_ACQUIRE, "agent");
        asm volatile("s_waitcnt vmcnt(0)" ::: "memory");
    }
    __syncthreads();
}

struct Params {
    const float *x, *c, *w_ada, *b_ada, *pre_g, *post_g, *w_gate, *w_up, *w_down, *w_in, *ln_g, *ln_b, *sgu_w, *sgu_b, *b_f, *gn_a, *gn_b, *w_out;
    float* out; unsigned char* ws;
};

__device__ __forceinline__ void adaln_item(const Params& p, LAS unsigned char* lds, int cgp, int tid, int lane, int wave) {
    LAS float* sc = (LAS float*)lds;
    LAS float* red = (LAS float*)(lds + 32768);
    for (int idx = tid; idx < 8192; idx += 512) { const int b = idx >> 10, k = idx & 1023; const float v = p.c[idx]; sc[k * 8 + b] = v * pg8::fast_sigmoid(v); }
    __syncthreads();
    float acc[8];
#pragma unroll
    for (int b = 0; b < 8; ++b) acc[b] = 0.f;
    const float* wp = p.w_ada + (size_t)(wave * 128) * 9216 + cgp * 64 + lane;
#pragma unroll 1
    for (int k0 = 0; k0 < 128; k0 += 32) {
        float wv[32];
#pragma unroll
        for (int k = 0; k < 32; ++k) { const float* rowp = p.w_ada + (size_t)(wave * 128 + k0 + k) * 9216 + cgp * 64;
            wv[k] = __builtin_nontemporal_load(rowp + (unsigned)lane); }
        __builtin_amdgcn_sched_barrier(0);
#pragma unroll
        for (int k = 0; k < 32; ++k) { const f32x4 s0 = *(const LAS f32x4*)(sc + (wave * 128 + k0 + k) * 8), s1 = *(const LAS f32x4*)(sc + (wave * 128 + k0 + k) * 8 + 4);
            acc[0] += s0[0] * wv[k]; acc[1] += s0[1] * wv[k]; acc[2] += s0[2] * wv[k]; acc[3] += s0[3] * wv[k]; acc[4] += s1[0] * wv[k]; acc[5] += s1[1] * wv[k]; acc[6] += s1[2] * wv[k]; acc[7] += s1[3] * wv[k];
            if ((k & 7) == 7) __builtin_amdgcn_sched_barrier(0); }
    }
#pragma unroll
    for (int b = 0; b < 8; ++b) red[(wave * 8 + b) * 64 + lane] = acc[b];
    __syncthreads();
    { const int b = wave; float s = 0.f;
#pragma unroll
      for (int w = 0; w < 8; ++w) s += red[(w * 8 + b) * 64 + lane];
      const int j = cgp * 64 + lane; ((float*)(p.ws + WS_MOD))[b * 9216 + j] = s + p.b_ada[j]; }
    __syncthreads();
}
__device__ __forceinline__ void conv_decode(const Params& p, int it, const float*& W, int& ldw, int& k0, int& n0, bf16*& WT, int& K, int& drow0, const float*& kgain) {
    constexpr int I_GU = 16 * 88, I_D = 44 * 32, I_IN = 16 * 80;
    static_assert(I_GU == I_D, "items");
    int r = it; kgain = nullptr;
    if (r < 4 * I_GU) {
        const int which = r / I_GU; r -= which * I_GU; const int f = which >> 1, up = which & 1;
        const int kb = r / 88, nb = r % 88; n0 = nb * 32; k0 = kb * 64; ldw = DFF; K = 1024;
        W = (up ? p.w_up : p.w_gate) + (size_t)f * 1024 * DFF; WT = (bf16*)(p.ws + (f ? WS_WGU1 : WS_WGU0));
        drow0 = 256 * (n0 >> 7) + (n0 & 127) + (up ? 128 : 0); return; }
    r -= 4 * I_GU;
    if (r < 2 * I_D) { const int f = r / I_D; r -= f * I_D; const int kb = r / 32, nb = r % 32;
        W = p.w_down + (size_t)f * DFF * 1024; ldw = 1024; k0 = kb * 64; n0 = nb * 32; WT = (bf16*)(p.ws + (f ? WS_WD1 : WS_WD0)); K = DFF; drow0 = nb * 32; return; }
    r -= 2 * I_D;
    if (r < I_IN) { const int kb = r / 80, nb = r % 80; W = p.w_in; ldw = NIN; k0 = kb * 64; n0 = nb * 32; WT = (bf16*)(p.ws + WS_WIN); K = 1024; drow0 = nb * 32; return; }
    r -= I_IN;
    { const int kb = r / 32, nb = r % 32;
      W = p.w_out; ldw = 1024; k0 = kb * 64; n0 = nb * 32; WT = (bf16*)(p.ws + WS_WOUT); K = 1024; drow0 = nb * 32; kgain = (kb < 8 ? p.gn_a + kb * 64 : p.gn_b + (kb - 8) * 64); }
}
__device__ __forceinline__ void conv_load(const float* W, int ldw, int k0, int n0, const float* kgain, int lane, float (&r)[32]) {
#pragma unroll
    for (int i = 0; i < 32; ++i) { const int kk = 2 * i + (lane >> 5); r[i] = __builtin_nontemporal_load(W + (size_t)(k0 + kk) * ldw + n0 + (lane & 31)); }
    if (kgain) {
#pragma unroll
        for (int i = 0; i < 32; ++i) r[i] *= kgain[2 * i + (lane >> 5)]; }
}
__device__ __forceinline__ void conv_store(const float (&r)[32], bf16* WT, int K, int drow0, int k0, LAS float* scr, int lane) {
#pragma unroll
    for (int i = 0; i < 32; ++i) { const int kk = 2 * i + (lane >> 5); scr[kk * 33 + (lane & 31)] = r[i]; }
    LDS_WAIT(); asm volatile("" ::: "memory");
    const int c = lane & 7;
#pragma unroll
    for (int j = 0; j < 4; ++j) { const int n = (lane >> 3) + 8 * j; const LAS float* s = scr + (8 * c) * 33 + n;
        v4u o; o.x = pk2(s[0 * 33], s[1 * 33]); o.y = pk2(s[2 * 33], s[3 * 33]); o.z = pk2(s[4 * 33], s[5 * 33]); o.w = pk2(s[6 * 33], s[7 * 33]);
        *(GAS v4u*)(WT + (size_t)(drow0 + n) * K + k0 + 8 * c) = o; }
    LDS_WAIT(); asm volatile("" ::: "memory");
}
__device__ __forceinline__ void convert_weights(const Params& p, LAS unsigned char* lds, int gw, int NGW, int lane, int wave) {
    LAS float* scr = (LAS float*)(lds + wave * 16384);
    constexpr int NITEMS = 6 * (16 * 88) + 16 * 80 + 16 * 32;
    int it = gw; if (it >= NITEMS) return;
    const float *Wa, *Wb, *ga, *gb; bf16 *Ta, *Tb; int la, lb, ka, kb_, na, nb_, Ka, Kb, da, db;
    float ra[32], rb[32];
    conv_decode(p, it, Wa, la, ka, na, Ta, Ka, da, ga); conv_load(Wa, la, ka, na, ga, lane, ra);
    for (;;) {
        int itn = it + NGW; bool more = itn < NITEMS;
        if (more) { conv_decode(p, itn, Wb, lb, kb_, nb_, Tb, Kb, db, gb); conv_load(Wb, lb, kb_, nb_, gb, lane, rb); }
        conv_store(ra, Ta, Ka, da, ka, scr, lane);
        if (!more) break;
        it = itn; itn = it + NGW; more = itn < NITEMS;
        if (more) { conv_decode(p, itn, Wa, la, ka, na, Ta, Ka, da, ga); conv_load(Wa, la, ka, na, ga, lane, ra); }
        conv_store(rb, Tb, Kb, db, kb_, scr, lane);
        if (!more) break;
        it = itn;
    }
}

template <int MODE, bool XIN16 = false, bool XOUT16 = false> __device__ __forceinline__ void ew_phase(const Params& p, LAS unsigned char* lds, int gw, int lane, const float* xin, int sub_res, float coef, int sub_next) {
    const int row0 = gw * 16; if (row0 >= M) return;
    asm volatile("" : "+v"(lane));
    const int b = row0 / SEQ;
    const unsigned lo = 4u * (unsigned)lane;
    const float* mod = (const float*)(p.ws + WS_MOD) + (size_t)b * 9216;
    f32x4 G[4], A[4], S[4];
    if (MODE & 1) {
#pragma unroll
        for (int j = 0; j < 4; ++j) { const unsigned col = lo + 256u * j; const f32x4 gt = *(const f32x4*)(mod + sub_res * 3072 + 2048 + col), pg = *(const f32x4*)(p.post_g + sub_res * 1024 + col); G[j] = coef * (1.0f + gt) * pg; }
        asm volatile("" : "+v"(G[0]), "+v"(G[1]), "+v"(G[2]), "+v"(G[3]) :: "memory");
    }
    if (MODE & 2) {
#pragma unroll
        for (int j = 0; j < 4; ++j) { const unsigned col = lo + 256u * j; const f32x4 sh = *(const f32x4*)(mod + sub_next * 3072 + col), scl = *(const f32x4*)(mod + sub_next * 3072 + 1024 + col), pg = *(const f32x4*)(p.pre_g + sub_next * 1024 + col);
            A[j] = pg * (1.0f + scl); S[j] = sh; }
        asm volatile("" : "+v"(A[0]), "+v"(A[1]), "+v"(A[2]), "+v"(A[3]) :: "memory");
        if (!(MODE & 4)) asm volatile("" : "+v"(S[0]), "+v"(S[1]), "+v"(S[2]), "+v"(S[3]));
    }
    const LAS f32x4* wfl = (const LAS f32x4*)lds + lane;
    const bf16* HD = (const bf16*)(p.ws + WS_HD);
    bf16* H = (bf16*)(p.ws + WS_H);
    bf16* X1 = (bf16*)(p.ws + WS_X1);
    float rs4[4] = {0.f, 0.f, 0.f, 0.f};
    if (MODE & 1) {
        const float* ss = (const float*)(p.ws + WS_SS) + row0 + (unsigned)((lane & 15) * M + (lane >> 4));
#pragma unroll
        for (int i = 0; i < 4; ++i) { float q = ss[4 * i]; q += __shfl_xor(q, 1); q += __shfl_xor(q, 2); q += __shfl_xor(q, 4); q += __shfl_xor(q, 8); rs4[i] = __builtin_amdgcn_rsqf(q * (1.0f / 1024.0f) + EPS); }
        asm volatile("" : "+v"(rs4[0]), "+v"(rs4[1]), "+v"(rs4[2]), "+v"(rs4[3]) :: "memory");
    }
    constexpr int NR = (MODE & 4) ? 1 : (MODE == 1 ? 4 : 2);
#pragma unroll 1
    for (int rp = 0; rp < 16 / NR; ++rp) {
        f32x4 v[NR][4]; v2u hw[NR][4];
#pragma unroll
        for (int k = 0; k < NR; ++k) { const int row = row0 + NR * rp + k;
#pragma unroll
            for (int j = 0; j < 4; ++j) {
                if (XIN16) { const v2u xw = __builtin_nontemporal_load((const v2u*)(X1 + (size_t)row * 1024 + (lo + 256u * j))); v[k][j] = (f32x4){bf_lo(xw.x), bf_hi(xw.x), bf_lo(xw.y), bf_hi(xw.y)}; }
                else v[k][j] = __builtin_nontemporal_load((const f32x4*)(xin + (size_t)row * 1024 + (lo + 256u * j)));
                if (MODE & 1) hw[k][j] = __builtin_nontemporal_load((const v2u*)(HD + (size_t)row * 1024 + (lo + 256u * j))); } }
#pragma unroll
        for (int k = 0; k < NR; ++k) { const int rr = NR * rp + k, row = row0 + rr;
            if (MODE & 1) {
                const int i = rr >> 2; const float sel = i == 0 ? rs4[0] : (i == 1 ? rs4[1] : (i == 2 ? rs4[2] : rs4[3]));
                const float rstd = __shfl(sel, (rr & 3) * 16);
#pragma unroll
                for (int j = 0; j < 4; ++j) { const f32x4 hv = (f32x4){bf_lo(hw[k][j].x), bf_hi(hw[k][j].x), bf_lo(hw[k][j].y), bf_hi(hw[k][j].y)};
                    v[k][j] = v[k][j] + G[j] * hv * rstd;
                    if (XOUT16) { v2u xw; xw.x = pk2(v[k][j][0], v[k][j][1]); xw.y = pk2(v[k][j][2], v[k][j][3]); __builtin_nontemporal_store(xw, (v2u*)(X1 + (size_t)row * 1024 + (lo + 256u * j))); }
                    else __builtin_nontemporal_store(v[k][j], (f32x4*)(p.out + (size_t)row * 1024 + (lo + 256u * j))); }
            }
            if (MODE & 2) {
                float s2 = 0.f;
#pragma unroll
                for (int j = 0; j < 4; ++j) s2 += (v[k][j][0] * v[k][j][0] + v[k][j][1] * v[k][j][1]) + (v[k][j][2] * v[k][j][2] + v[k][j][3] * v[k][j][3]);
                const float r2 = __builtin_amdgcn_rsqf(wave_sum(s2) * (1.0f / 1024.0f) + EPS);
                f32x4 hq[4];
#pragma unroll
                for (int j = 0; j < 4; ++j) { const f32x4 sj = (MODE & 4) ? *(const f32x4*)(mod + sub_next * 3072 + (lo + 256u * j)) : S[j];
                    hq[j] = v[k][j] * r2 * A[j] + sj;
                    v2u w; w.x = pk2(hq[j][0], hq[j][1]); w.y = pk2(hq[j][2], hq[j][3]);
                    *(v2u*)(H + (size_t)row * 1024 + (lo + 256u * j)) = w; }
                if (MODE & 4) {
                    f32x4 d0 = (f32x4){0.f, 0.f, 0.f, 0.f}, d1 = d0;
#pragma unroll
                    for (int j = 0; j < 4; ++j)
#pragma unroll
                        for (int e = 0; e < 4; ++e) { d0 += hq[j][e] * wfl[((j * 4 + e) * 2 + 0) * 64]; d1 += hq[j][e] * wfl[((j * 4 + e) * 2 + 1) * 64]; }
                    const bool b5 = lane & 32, b4 = lane & 16, b3 = lane & 8;
                    const f32x4 snd = b5 ? d0 : d1; f32x4 k4 = b5 ? d1 : d0;
                    k4[0] += __shfl_xor(snd[0], 32); k4[1] += __shfl_xor(snd[1], 32); k4[2] += __shfl_xor(snd[2], 32); k4[3] += __shfl_xor(snd[3], 32);
                    const float s0 = b4 ? k4[0] : k4[2], s1 = b4 ? k4[1] : k4[3]; float k0 = b4 ? k4[2] : k4[0], k1 = b4 ? k4[3] : k4[1];
                    k0 += __shfl_xor(s0, 16); k1 += __shfl_xor(s1, 16);
                    float mine = (b3 ? k1 : k0) + __shfl_xor(b3 ? k0 : k1, 8);
                    mine += dpp_f<0xB1>(mine); mine += dpp_f<0x4E>(mine); mine += dpp_f<0x141>(mine);
                    if ((lane & 7) == 0) { const int hh = lane >> 3; const float z = mine + p.b_f[hh];
                        const float ls = (z < 0.f ? z : 0.f) - 0.6931471805599453f * __builtin_amdgcn_logf(1.0f + __builtin_amdgcn_exp2f(-1.4426950408889634f * fabsf(z)));
                        ((float*)(p.ws + WS_LOGF))[((size_t)(b * 8 + hh)) * SEQ + (row - b * SEQ)] = ls; }
                }
            }
        }
    }
}
__device__ __forceinline__ void ew_fill_wf(const Params& p, LAS unsigned char* lds, int tid) {
    for (int idx = tid; idx < 2048; idx += NWAVES * 64) { const int l = idx & 63, half = (idx >> 6) & 1, e = (idx >> 7) & 3, j = idx >> 9;
        ((LAS f32x4*)lds)[idx] = *(const f32x4*)(p.w_in + (size_t)(4 * l + 256 * j + e) * NIN + 2560 + 4 * half); }
    __syncthreads();
}
__device__ __forceinline__ void scan_seq(const Params& p, int seq, int lane) {
    const float* src = (const float*)(p.ws + WS_LOGF) + (size_t)seq * SEQ + lane * 64;
    float* dst = (float*)(p.ws + WS_CUM) + (size_t)seq * SEQ + lane * 64;
    f32x4 v[16]; float run = 0.f;
#pragma unroll
    for (int i = 0; i < 16; ++i) { v[i] = *(const f32x4*)(src + 4 * i);
        run += v[i][0]; v[i][0] = run; run += v[i][1]; v[i][1] = run; run += v[i][2]; v[i][2] = run; run += v[i][3]; v[i][3] = run; }
    float incl = run;
#pragma unroll
    for (int o = 1; o < 64; o <<= 1) { const float t = __shfl_up(incl, o); if (lane >= o) incl += t; }
    const float excl = incl - run;
#pragma unroll
    for (int i = 0; i < 16; ++i) *(f32x4*)(dst + 4 * i) = (v[i] + excl) * 1.4426950408889634f;
}
constexpr int SGU_PITCH = 1044;
__device__ __forceinline__ void sgu_unit(const Params& p, LAS unsigned char* lds, int unit, int lane, int wave) {
    const int R0 = unit * 128;
    const bf16* ZG = (const bf16*)(p.ws + WS_ZG) + (size_t)(unit >> 5) * PAD_ZG;
    bf16* Y = (bf16*)(p.ws + WS_Y);
    float* ssa = (float*)(p.ws + WS_SSA);
    {
        const f32x4 g0 = *(const f32x4*)(p.ln_g + 8 * lane), g1 = *(const f32x4*)(p.ln_g + 8 * lane + 4), b0 = *(const f32x4*)(p.ln_b + 8 * lane), b1 = *(const f32x4*)(p.ln_b + 8 * lane + 4);
        v4u wv[16];
#pragma unroll
        for (int rr = 0; rr < 16; ++rr) wv[rr] = __builtin_nontemporal_load((const v4u*)(ZG + (size_t)(R0 + wave * 16 + rr) * 1024 + 512 + 8 * lane));
#pragma unroll
        for (int rr = 0; rr < 16; ++rr) { const int r = wave * 16 + rr; const v4u w = wv[rr];
            f32x4 a = (f32x4){bf_lo(w.x), bf_hi(w.x), bf_lo(w.y), bf_hi(w.y)}, c = (f32x4){bf_lo(w.z), bf_hi(w.z), bf_lo(w.w), bf_hi(w.w)};
            const float mean = wave_sum((a[0] + a[1]) + (a[2] + a[3]) + (c[0] + c[1]) + (c[2] + c[3])) * (1.0f / 512.0f);
            a = a - mean; c = c - mean;
            const float var = wave_sum((a[0] * a[0] + a[1] * a[1]) + (a[2] * a[2] + a[3] * a[3]) + (c[0] * c[0] + c[1] * c[1]) + (c[2] * c[2] + c[3] * c[3])) * (1.0f / 512.0f);
            const float rstd = __builtin_amdgcn_rsqf(var + EPS);
            a = a * rstd * g0 + b0; c = c * rstd * g1 + b1;
            LAS unsigned* d = (LAS unsigned*)(lds + r * SGU_PITCH + 16 * lane);
            d[0] = pk2(a[0], a[1]); d[1] = pk2(a[2], a[3]); d[2] = pk2(c[0], c[1]); d[3] = pk2(c[2], c[3]); }
    }
    __syncthreads();
    const int fr = lane & 15, fq = lane >> 4;
    const int h = wave;
    bf16x8 vfr[4][4];
#pragma unroll
    for (int ks = 0; ks < 4; ++ks) { const LAS unsigned short* vb = (const LAS unsigned short*)(lds + (32 * ks + 8 * fq) * SGU_PITCH + (64 * h + fr) * 2);
#pragma unroll
        for (int nt = 0; nt < 4; ++nt) { bf16x8 vf;
#pragma unroll
            for (int e = 0; e < 8; ++e) vf[e] = (short)vb[e * (SGU_PITCH / 2) + 16 * nt];
            vfr[ks][nt] = vf; } }
    const float* Wh = p.sgu_w + (size_t)h * 16384 + (size_t)fr * 128 + 8 * fq;
#pragma unroll 1
    for (int rt2 = 0; rt2 < 8; rt2 += 2) {
        f32x4 wv[2][4][2]; v2u uw[2][4]; float bs[2];
#pragma unroll
        for (int t = 0; t < 2; ++t) { const int i = (rt2 + t) * 16 + fr;
#pragma unroll
            for (int ks = 0; ks < 4; ++ks) { wv[t][ks][0] = *(const f32x4*)(Wh + (size_t)(rt2 + t) * 2048 + 32 * ks); wv[t][ks][1] = *(const f32x4*)(Wh + (size_t)(rt2 + t) * 2048 + 32 * ks + 4); }
#pragma unroll
            for (int nt = 0; nt < 4; ++nt) uw[t][nt] = __builtin_nontemporal_load((const v2u*)(ZG + (size_t)(R0 + i) * 1024 + 64 * h + 16 * nt + 4 * fq));
            bs[t] = p.sgu_b[h * 128 + i]; }
        __builtin_amdgcn_sched_barrier(0);
#pragma unroll
        for (int t = 0; t < 2; ++t) { const int i = (rt2 + t) * 16 + fr; const size_t rowoff = (size_t)(R0 + i) * 1024;
            f32x4 acc[4];
#pragma unroll
            for (int nt = 0; nt < 4; ++nt) acc[nt] = (f32x4){0.f, 0.f, 0.f, 0.f};
#pragma unroll
            for (int ks = 0; ks < 4; ++ks) if (ks < 2 || rt2 >= 4) {
                const f32x4 w0 = wv[t][ks][0], w1 = wv[t][ks][1];
                v4u wu; wu.x = pk2(w0[0], w0[1]); wu.y = pk2(w0[2], w0[3]); wu.z = pk2(w1[0], w1[1]); wu.w = pk2(w1[2], w1[3]);
                const bf16x8 wfrag = __builtin_bit_cast(bf16x8, wu);
#pragma unroll
                for (int nt = 0; nt < 4; ++nt) acc[nt] = __builtin_amdgcn_mfma_f32_16x16x32_bf16(vfr[ks][nt], wfrag, acc[nt], 0, 0, 0);
            }
            float q = 0.f;
#pragma unroll
            for (int nt = 0; nt < 4; ++nt) { const int c = 64 * h + 16 * nt + 4 * fq;
                const f32x4 uv = (f32x4){bf_lo(uw[t][nt].x), bf_hi(uw[t][nt].x), bf_lo(uw[t][nt].y), bf_hi(uw[t][nt].y)};
                const f32x4 y = uv * (acc[nt] + bs[t]);
                v2u o; o.x = pk2(y[0], y[1]); o.y = pk2(y[2], y[3]);
                const f32x4 yr = (f32x4){bf_lo(o.x), bf_hi(o.x), bf_lo(o.y), bf_hi(o.y)};
                q += (yr[0] * yr[0] + yr[1] * yr[1]) + (yr[2] * yr[2] + yr[3] * yr[3]);
                *(v2u*)(Y + rowoff + c) = o; }
            q += __shfl_xor(q, 16); q += __shfl_xor(q, 32);
            if (fq == 0) ssa[(size_t)h * M + R0 + i] = q;
        }
    }
    __syncthreads();
}
__device__ __forceinline__ void ynorm_phase(const Params& p, int gw, int lane) {
    const int row0 = gw * 16; if (row0 >= M) return;
    asm volatile("" : "+v"(lane));
    const f32x4 ga0 = *(const f32x4*)(p.gn_a + 8 * lane), ga1 = *(const f32x4*)(p.gn_a + 8 * lane + 4), gb0 = *(const f32x4*)(p.gn_b + 8 * lane), gb1 = *(const f32x4*)(p.gn_b + 8 * lane + 4);
    const float* ssa = (const float*)(p.ws + WS_SSA); const float* ssb = (const float*)(p.ws + WS_SSB);
    bf16* Y = (bf16*)(p.ws + WS_Y);
    for (int rr = 0; rr < 16; ++rr) { const int row = row0 + rr;
        float qa = 0.f, qb = 0.f;
#pragma unroll
        for (int h = 0; h < 8; ++h) { qa += ssa[(size_t)h * M + row]; qb += ssb[(size_t)h * M + row]; }
        const float ra = __builtin_amdgcn_rsqf(qa * (1.0f / 512.0f) + EPS), rb = __builtin_amdgcn_rsqf(qb * (1.0f / 512.0f) + EPS);
        v4u* pa = (v4u*)(Y + (size_t)row * 1024 + 8 * lane); v4u* pb = (v4u*)(Y + (size_t)row * 1024 + 512 + 8 * lane);
        const v4u wa = *pa, wb = *pb; v4u oa, ob;
        oa.x = pk2(bf_lo(wa.x) * ra * ga0[0], bf_hi(wa.x) * ra * ga0[1]); oa.y = pk2(bf_lo(wa.y) * ra * ga0[2], bf_hi(wa.y) * ra * ga0[3]);
        oa.z = pk2(bf_lo(wa.z) * ra * ga1[0], bf_hi(wa.z) * ra * ga1[1]); oa.w = pk2(bf_lo(wa.w) * ra * ga1[2], bf_hi(wa.w) * ra * ga1[3]);
        ob.x = pk2(bf_lo(wb.x) * rb * gb0[0], bf_hi(wb.x) * rb * gb0[1]); ob.y = pk2(bf_lo(wb.y) * rb * gb0[2], bf_hi(wb.y) * rb * gb0[3]);
        ob.z = pk2(bf_lo(wb.z) * rb * gb1[0], bf_hi(wb.z) * rb * gb1[1]); ob.w = pk2(bf_lo(wb.w) * rb * gb1[2], bf_hi(wb.w) * rb * gb1[3]);
        *pa = oa; *pb = ob; }
}

#ifndef PROBE
#define PROBE 0
#endif
#ifndef STAG_TICKS
#define STAG_TICKS 700
#endif
__device__ __forceinline__ void stagger_start(int bx) {
    const unsigned long long d = (unsigned long long)(((unsigned)bx * 97u) & 255u) * STAG_TICKS / 256u, t0 = __builtin_amdgcn_s_memrealtime();
    while (__builtin_amdgcn_s_memrealtime() - t0 < d) __builtin_amdgcn_s_sleep(8);
}
#define REPS(cond) for (int rep_ = 0; rep_ < ((cond) ? 2 : 1); ++rep_)
__global__ void __launch_bounds__(NWAVES * 64, 2) mega_fwd(Params p) {
    extern __shared__ __attribute__((aligned(16))) unsigned char lds_raw[];
    cg::grid_group grid = cg::this_grid();
    LAS unsigned char* lds = (LAS unsigned char*)lds_raw;
    if (threadIdx.x < 16) ((LAS unsigned*)(lds + LDS_BARST))[threadIdx.x] = 0u;
    __syncthreads();
    const XcdBarrier bar = xcd_barrier_post((unsigned*)(p.ws + WS_CTL), (volatile LAS unsigned*)(lds + LDS_BARST));
    if (p.ws == nullptr) grid.sync();
    const int G = gridDim.x, NGW = G * NWAVES;
    int bx = blockIdx.x;
    int cgx = blockIdx.x;
    int sid = blockIdx.x;
    bool uni = false;
#define GRID_SYNC() do { if (uni) xcd_local_barrier(bar); else xcd_barrier(bar); } while (0)
#define LANEVARS const int tid = otid(), lane = tid & 63, wave = __builtin_amdgcn_readfirstlane(tid >> 6), gw = bx * NWAVES + wave; (void)tid; (void)lane; (void)wave; (void)gw
    bf16* H = (bf16*)(p.ws + WS_H); bf16* HD = (bf16*)(p.ws + WS_HD); bf16* ACT = (bf16*)(p.ws + WS_ACT);
    float* SS = (float*)(p.ws + WS_SS);

    REPS(PROBE == 3) { LANEVARS; for (int it = bx; it < 144; it += G) adaln_item(p, lds, it, tid, lane, wave);
      convert_weights(p, lds, gw, NGW, lane, wave); __syncthreads(); }
    xcd_barrier(bar);
    { volatile LAS unsigned* st = (volatile LAS unsigned*)(lds + LDS_BARST);
      const unsigned u_ = __builtin_amdgcn_readfirstlane(st[2]), r_ = __builtin_amdgcn_readfirstlane(st[3]), x_ = bar.x;
#ifndef FORCE_FALLBACK
#define FORCE_FALLBACK 0
#endif
      if (!FORCE_FALLBACK && u_ != 0u && r_ < 32u && x_ < 8u) { uni = true; bx = (int)(x_ * 32u + r_); cgx = (int)(r_ * 8u + x_); sid = r_ < 8u ? (int)(x_ * 8u + r_) : (1 << 20); } }
    REPS(PROBE == 5) { LANEVARS; for (int g = gw; g * 16 < M; g += NGW) ew_phase<2>(p, lds, g, lane, p.x, 0, 0.f, 0); }
    GRID_SYNC();
    REPS(PROBE == 4 || PROBE >= 6) { pg8::Gemm g{H, (const bf16*)(p.ws + WS_WGU0), M, 2 * DFF, 1024}; pg8::StaticOrder S; S.init(M, 2 * DFF, G, cgx);
      pg8::EpiSwiGLU E{ACT, DFF, (rep_ == 1 && PROBE >= 6) ? PROBE - 6 : 0}; pg8::gemm_phase<pg8::EpiSwiGLU, pg8::StaticOrder, true, true>(lds, g, S, E); }
    GRID_SYNC();
    REPS(PROBE == 4) { pg8::Gemm g{ACT, (const bf16*)(p.ws + WS_WD0), M, 1024, DFF}; pg8::StaticOrder S; S.init(M, 1024, G, cgx);
      pg8::EpiBf16Ss E{HD, 1024, SS, M}; pg8::gemm_phase<pg8::EpiBf16Ss, pg8::StaticOrder, true, true>(lds, g, S, E); }
    GRID_SYNC();
    REPS(PROBE == 5) { LANEVARS; __syncthreads(); ew_fill_wf(p, lds, tid); for (int g = gw; g * 16 < M; g += NGW) ew_phase<7, false, true>(p, lds, g, lane, p.x, 0, 0.5f, 1); }
    GRID_SYNC();
    { LANEVARS; if (wave == 0) for (int s = sid; s < BATCH * HB; s += G) scan_seq(p, s, lane); }
    REPS(PROBE == 4) { pg8::Gemm g{H, (const bf16*)(p.ws + WS_WIN), M, 2560, 1024}; pg8::StaticOrder S; S.init(M, 2560, G, cgx);
      static_assert(WS_K - WS_Q == WS_V - WS_K, "qkv stride");
      pg8::EpiMixIn E{(bf16*)(p.ws + WS_ZG), (bf16*)(p.ws + WS_Q), (WS_K - WS_Q) / 2, attn_body::C2, PAD_ZG, PAD_QKV};
      pg8::gemm_phase<pg8::EpiMixIn, pg8::StaticOrder, true, true>(lds, g, S, E); }
    GRID_SYNC();
    { const attn_body::AttnTensors AT{(const attn_body::bf16*)(p.ws + WS_Q), (const attn_body::bf16*)(p.ws + WS_K), (const attn_body::bf16*)(p.ws + WS_V),
                                      (attn_body::bf16*)(p.ws + WS_Y) + 512, (const float*)(p.ws + WS_CUM), (float*)(p.ws + WS_SSB), (float*)(p.ws + WS_KPART)};
      const attn_body::StaticOrder S(G, cgx);
      attn_body::attn_pre<attn_body::StaticOrder>((char*)lds_raw, AT, S);
      { LANEVARS; for (int u = bx; u < M / 128; u += G) sgu_unit(p, lds, u, lane, wave); }
      GRID_SYNC();
      attn_body::attn_run<attn_body::StaticOrder>((char*)lds_raw, AT, S); }
    GRID_SYNC();
    { pg8::Gemm g{(const bf16*)(p.ws + WS_Y), (const bf16*)(p.ws + WS_WOUT), M, 1024, 1024}; pg8::StaticOrder S; S.init(M, 1024, G, cgx);
      LAS pg8::f32x2* tab = (LAS pg8::f32x2*)(lds + 131072);
      pg8::Unit u0{0, 0}, u1{0, 0}; const bool has0 = S.next(0, u0), has1 = S.next(1, u1); pg8::Unit u2; const bool has2 = S.next(2, u2);
      { LANEVARS; const int ui = tid >> 8, r = tid & 255; const int pmu = ui ? u1.pm : u0.pm;
        if (ui ? has1 : has0) { const float* ssa = (const float*)(p.ws + WS_SSA) + (size_t)pmu * 256 + r; const float* ssb = (const float*)(p.ws + WS_SSB) + (size_t)pmu * 256 + r; float qa = 0.f, qb = 0.f;
#pragma unroll
          for (int h = 0; h < 8; ++h) { qa += ssa[(size_t)h * M]; qb += ssb[(size_t)h * M]; }
          const float ra = __builtin_amdgcn_rsqf(qa * (1.0f / 512.0f) + EPS), rb = __builtin_amdgcn_rsqf(qb * (1.0f / 512.0f) + EPS);
          tab[ui * 256 + r] = (pg8::f32x2){ra / rb, rb}; }
        __syncthreads(); }
      if (!has2 && (!has1 || u1.pm != u0.pm)) {
        pg8::EpiRowScaleSs E{HD, 1024, SS, M, tab, u0.pm}; pg8::gemm_phase<pg8::EpiRowScaleSs, pg8::StaticOrder, true, true>(lds, g, S, E); }
    }
    GRID_SYNC();
    { LANEVARS; for (int g = gw; g * 16 < M; g += NGW) ew_phase<3, true, true>(p, lds, g, lane, p.x, 1, 1.0f, 2); }
    GRID_SYNC();
    REPS(PROBE == 4) { pg8::Gemm g{H, (const bf16*)(p.ws + WS_WGU1), M, 2 * DFF, 1024}; pg8::StaticOrder S; S.init(M, 2 * DFF, G, cgx);
      pg8::EpiSwiGLU E{ACT, DFF, 0}; pg8::gemm_phase<pg8::EpiSwiGLU, pg8::StaticOrder, true, true>(lds, g, S, E); }
    GRID_SYNC();
    REPS(PROBE == 4) { pg8::Gemm g{ACT, (const bf16*)(p.ws + WS_WD1), M, 1024, DFF}; pg8::StaticOrder S; S.init(M, 1024, G, cgx);
      pg8::EpiBf16Ss E{HD, 1024, SS, M}; pg8::gemm_phase<pg8::EpiBf16Ss, pg8::StaticOrder, true, true>(lds, g, S, E); }
    GRID_SYNC();
    { LANEVARS; for (int g = gw; g * 16 < M; g += NGW) ew_phase<1, true, false>(p, lds, g, lane, p.x, 2, 0.5f, 0); }
}

extern "C" void kernel_launch(void* const* d_in, const int* in_sizes, int n_in, void* d_out, int out_size, void* d_ws, size_t ws_size, hipStream_t stream) {
    static int grid = 0;
    if (grid == 0) {
        if (n_in != 18 || out_size != M * 1024 || ws_size < WS_END) { fprintf(stderr, "kernel_launch: unexpected problem shape (n_in %d out %d ws %zu)\n", n_in, out_size, ws_size); grid = -1; return; }
        int dev = 0, cus = 0, per_cu = 0;
        (void)hipGetDevice(&dev); (void)hipDeviceGetAttribute(&cus, hipDeviceAttributeMultiprocessorCount, dev);
        if (hipFuncSetAttribute((const void*)mega_fwd, hipFuncAttributeMaxDynamicSharedMemorySize, LDS_BYTES) != hipSuccess) { fprintf(stderr, "kernel_launch: hipFuncSetAttribute failed\n"); grid = -1; return; }
        if (hipOccupancyMaxActiveBlocksPerMultiprocessor(&per_cu, (const void*)mega_fwd, NWAVES * 64, LDS_BYTES) != hipSuccess || per_cu < 1) { fprintf(stderr, "kernel_launch: occupancy query says %d\n", per_cu); per_cu = 1; }
        (void)hipGetLastError();
        grid = cus * 1;
        if (grid <= 0) grid = 256;
    }
    if (grid < 0) return;
    if (hipMemsetAsync((char*)d_ws + WS_CTL, 0, CTL_BYTES, stream) != hipSuccess) { fprintf(stderr, "kernel_launch: memset failed\n"); return; }
    Params p{};
    p.x = (const float*)d_in[0]; p.c = (const float*)d_in[1]; p.w_ada = (const float*)d_in[2]; p.b_ada = (const float*)d_in[3]; p.pre_g = (const float*)d_in[4]; p.post_g = (const float*)d_in[5];
    p.w_gate = (const float*)d_in[6]; p.w_up = (const float*)d_in[7]; p.w_down = (const float*)d_in[8]; p.w_in = (const float*)d_in[9]; p.ln_g = (const float*)d_in[10]; p.ln_b = (const float*)d_in[11];
    p.sgu_w = (const float*)d_in[12]; p.sgu_b = (const float*)d_in[13]; p.b_f = (const float*)d_in[14]; p.gn_a = (const float*)d_in[15]; p.gn_b = (const float*)d_in[16]; p.w_out = (const float*)d_in[17];
    p.out = (float*)d_out; p.ws = (unsigned char*)d_ws;
    void* args[] = {&p};
    hipError_t e = hipLaunchCooperativeKernel((const void*)mega_fwd, dim3(grid), dim3(NWAVES * 64), args, LDS_BYTES, stream);
    if (e != hipSuccess) fprintf(stderr, "kernel_launch: cooperative launch failed: %s (grid %d)\n", hipGetErrorString(e), grid);
}
```

```cpp
#include <hip/hip_runtime.h>
#include <hip/hip_cooperative_groups.h>
#include <hip/hip_bf16.h>
#include <cstdio>
#include <cstdint>
#include <cmath>
namespace cg = cooperative_groups;
__device__ __forceinline__ int otid() { int t = threadIdx.x; asm volatile("" : "+v"(t)); return t; }
namespace pg8 {
#define PG8_LAS __attribute__((address_space(3)))
typedef unsigned short bf16_t;
typedef short bf16x8 __attribute__((ext_vector_type(8)));
typedef float f32x4 __attribute__((ext_vector_type(4)));
typedef unsigned u32x4 __attribute__((ext_vector_type(4)));
constexpr int BM = 256, BK = 64, HALF = 128, HTB = HALF * BK * 2  , STAGE_BYTES = 8 * HTB, NXCD = 8, WGM = 8;

__host__ __device__ __forceinline__ int lds_byte(int r, int c) { const int st = (r >> 4) * 2 + (c >> 5), rr = r & 15, cc = c & 31, ob = rr * 64 + cc * 2; return st * 1024 + (ob ^ (((ob >> 9) & 1) << 5)); }
__host__ __device__ __forceinline__ void stage_rc(int b, int& R, int& C) { const int st = b / 1024, sb = b % 1024, swz = sb ^ (((sb >> 9) & 1) << 5); R = (st >> 1) * 16 + swz / 64; C = (st & 1) * 32 + (swz % 64) / 2; }
__host__ __device__ __forceinline__ int perm32(int rho) { const int n = rho >> 4, i = rho & 15; return 8 * (i >> 2) + 4 * n + (i & 3); }

struct Unit { int pm, pn; };
struct Gemm { const bf16_t* A; const bf16_t* Bt; int M, N, K; };

struct StaticOrder {
    int nM, nN, nwg, G, c;
    __host__ __device__ __forceinline__ void init(int M, int N, int G_, int c_) { nM = M / BM; nN = N / BM; nwg = nM * nN; G = G_; c = c_; }
    __host__ __device__ __forceinline__ bool next(int i, Unit& u) const {
        const long L = (long)i * G + c; if (L >= nwg) return false;
        int wgid = (int)L; { const int q = nwg / NXCD, r = nwg % NXCD, xcd = wgid % NXCD, off = wgid / NXCD; wgid = (xcd < r ? xcd * (q + 1) : r * (q + 1) + (xcd - r) * q) + off; }
        const int nig = WGM * nN, gid = wgid / nig, fm = gid * WGM, gsz = (nM - fm) < WGM ? (nM - fm) : WGM;
        u.pm = fm + ((wgid % nig) % gsz); u.pn = (wgid % nig) / gsz; return true;
    }
    __device__ __forceinline__ void a_ready(const Unit&) const {}
    __device__ __forceinline__ void done(const Unit&) const {}
};

__device__ __forceinline__ unsigned cvt_pk_bf16(float lo, float hi) { unsigned r; asm volatile("v_cvt_pk_bf16_f32 %0, %1, %2" : "=v"(r) : "v"(lo), "v"(hi)); return r; }
typedef float f32x2 __attribute__((ext_vector_type(2)));
__device__ __forceinline__ float fast_sigmoid(float t) { return __builtin_amdgcn_rcpf(1.0f + __builtin_amdgcn_exp2f(-1.4426950408889634f * t)); }
struct EpiSwiGLU {
    static constexpr bool PERM = true, AFTER_DRAIN = false, HAS_MID = false;
    bf16_t* O; int ldc; int mode;
    __device__ __forceinline__ void operator()(const f32x4 (&acc)[2][2][4][2], const Unit& u, int wr, int wc, int fr, int fq) const {
        if (mode == 2) return;
        const int row0 = u.pm * BM + wr * 64 + fr; const int col0 = u.pn * HALF + wc * 32 + 8 * fq;
#pragma unroll
        for (int ai = 0; ai < 2; ++ai)
#pragma unroll
            for (int m = 0; m < 4; ++m) { bf16_t* rowp = O + (size_t)(row0 + ai * HALF + m * 16) * ldc + col0;
                float o[8];
#pragma unroll
                for (int n = 0; n < 2; ++n)
#pragma unroll
                    for (int e = 0; e < 4; ++e) { const float g = acc[ai][0][m][n][e], up = acc[ai][1][m][n][e]; o[n * 4 + e] = g * fast_sigmoid(g) * up; }
                u32x4 w; w.x = cvt_pk_bf16(o[0], o[1]); w.y = cvt_pk_bf16(o[2], o[3]); w.z = cvt_pk_bf16(o[4], o[5]); w.w = cvt_pk_bf16(o[6], o[7]);
                if (mode == 0) *(u32x4*)rowp = w; else if (w.x == 0x12345678u && w.y == 0x9abcdef0u) *(u32x4*)rowp = w; }
    }
};
struct EpiBf16Ss {
    static constexpr bool PERM = true, AFTER_DRAIN = false, HAS_MID = false;
    bf16_t* O; int ldc; float* ss; int M;
    __device__ __forceinline__ void operator()(const f32x4 (&acc)[2][2][4][2], const Unit& u, int wr, int wc, int fr, int fq) const {
        const int row0 = u.pm * BM + wr * 64 + fr; const int col0 = u.pn * BM + wc * 32 + 8 * fq;
        float* ssp = ss + (size_t)(u.pn * 4 + wc) * M;
#pragma unroll
        for (int ai = 0; ai < 2; ++ai)
#pragma unroll
            for (int m = 0; m < 4; ++m) { const int row = row0 + ai * HALF + m * 16; bf16_t* rowp = O + (size_t)row * ldc + col0; float q = 0.f;
#pragma unroll
                for (int bj = 0; bj < 2; ++bj) { const f32x4 v0 = acc[ai][bj][m][0], v1 = acc[ai][bj][m][1];
                    q += (v0[0] * v0[0] + v0[1] * v0[1]) + (v0[2] * v0[2] + v0[3] * v0[3]) + (v1[0] * v1[0] + v1[1] * v1[1]) + (v1[2] * v1[2] + v1[3] * v1[3]);
                    u32x4 w; w.x = cvt_pk_bf16(v0[0], v0[1]); w.y = cvt_pk_bf16(v0[2], v0[3]); w.z = cvt_pk_bf16(v1[0], v1[1]); w.w = cvt_pk_bf16(v1[2], v1[3]);
                    *(u32x4*)(rowp + bj * HALF) = w; }
                q += __shfl_xor(q, 16); q += __shfl_xor(q, 32);
                if (fq == 0) ssp[row] = q; }
    }
};
struct EpiRowScaleSs {
    static constexpr bool PERM = true, AFTER_DRAIN = false, HAS_MID = true;
    bf16_t* O; int ldc; float* ss; int M; const PG8_LAS f32x2* tab; int pm0;
    __device__ __forceinline__ void mid(f32x4 (&acc)[2][2][4][2], const Unit& u, int wr, int fr) const {
        const PG8_LAS f32x2* t = tab + (u.pm == pm0 ? 0 : 256) + wr * 64 + fr;
#pragma unroll
        for (int ai = 0; ai < 2; ++ai)
#pragma unroll
            for (int m = 0; m < 4; ++m) { const float f = t[ai * HALF + m * 16].x;
#pragma unroll
                for (int bj = 0; bj < 2; ++bj)
#pragma unroll
                    for (int n = 0; n < 2; ++n) acc[ai][bj][m][n] = acc[ai][bj][m][n] * f; }
    }
    __device__ __forceinline__ void operator()(const f32x4 (&acc)[2][2][4][2], const Unit& u, int wr, int wc, int fr, int fq) const {
        const int row0 = u.pm * BM + wr * 64 + fr; const int col0 = u.pn * BM + wc * 32 + 8 * fq;
        float* ssp = ss + (size_t)(u.pn * 4 + wc) * M;
        const PG8_LAS f32x2* t = tab + (u.pm == pm0 ? 0 : 256) + wr * 64 + fr;
#pragma unroll
        for (int ai = 0; ai < 2; ++ai)
#pragma unroll
            for (int m = 0; m < 4; ++m) { const int row = row0 + ai * HALF + m * 16; bf16_t* rowp = O + (size_t)row * ldc + col0; float q = 0.f; const float f = t[ai * HALF + m * 16].y;
#pragma unroll
                for (int bj = 0; bj < 2; ++bj) { const f32x4 v0 = acc[ai][bj][m][0] * f, v1 = acc[ai][bj][m][1] * f;
                    q += (v0[0] * v0[0] + v0[1] * v0[1]) + (v0[2] * v0[2] + v0[3] * v0[3]) + (v1[0] * v1[0] + v1[1] * v1[1]) + (v1[2] * v1[2] + v1[3] * v1[3]);
                    u32x4 w; w.x = cvt_pk_bf16(v0[0], v0[1]); w.y = cvt_pk_bf16(v0[2], v0[3]); w.z = cvt_pk_bf16(v1[0], v1[1]); w.w = cvt_pk_bf16(v1[2], v1[3]);
                    *(u32x4*)(rowp + bj * HALF) = w; }
                q += __shfl_xor(q, 16); q += __shfl_xor(q, 32);
                if (fq == 0) ssp[row] = q; }
    }
};
struct EpiMixIn {
    static constexpr bool PERM = true, AFTER_DRAIN = false, HAS_MID = false;
    bf16_t* ZG; bf16_t* Q; size_t qkv_stride; float qscale; size_t pad_zg, pad_qkv;
    __device__ __forceinline__ void operator()(const f32x4 (&acc)[2][2][4][2], const Unit& u, int wr, int wc, int fr, int fq) const {
        const int row0 = u.pm * BM + wr * 64 + fr;
        bf16_t* base; int ldc, colt; float sc = 1.f; const bool gelu = u.pn < 4;
        if (u.pn < 4) { base = ZG + (size_t)(u.pm >> 4) * pad_zg; ldc = 1024; colt = u.pn * BM; }
        else { const int t = (u.pn - 4) >> 1; base = Q + (size_t)t * qkv_stride + (size_t)(u.pm >> 4) * pad_qkv; ldc = 512; colt = ((u.pn - 4) & 1) * BM; if (t == 0) sc = qscale; }
        const int col0 = colt + wc * 32 + 8 * fq;
#pragma unroll
        for (int ai = 0; ai < 2; ++ai)
#pragma unroll
            for (int m = 0; m < 4; ++m) { bf16_t* rowp = base + (size_t)(row0 + ai * HALF + m * 16) * ldc + col0;
#pragma unroll
                for (int bj = 0; bj < 2; ++bj) { float o[8];
#pragma unroll
                    for (int n = 0; n < 2; ++n)
#pragma unroll
                        for (int e = 0; e < 4; ++e) { float x = acc[ai][bj][m][n][e];
                            if (gelu) { const float t = 1.5957691216057308f * (x + 0.044715f * x * x * x); x = x * fast_sigmoid(t); } else x *= sc;
                            o[n * 4 + e] = x; }
                    u32x4 w; w.x = cvt_pk_bf16(o[0], o[1]); w.y = cvt_pk_bf16(o[2], o[3]); w.z = cvt_pk_bf16(o[4], o[5]); w.w = cvt_pk_bf16(o[6], o[7]);
                    *(u32x4*)(rowp + bj * HALF) = w; } }
    }
};

template <class Epi, class Sched, bool ALIGN_EPI = false, bool SP2 = false>
__device__ __forceinline__ void gemm_phase(PG8_LAS unsigned char* lds, const Gemm g, const Sched& S, const Epi& E) {
    const int tid = otid(), wid = __builtin_amdgcn_readfirstlane(tid >> 6), lane = tid & 63, wr = wid >> 2, wc = wid & 3, fr = lane & 15, fq = lane >> 4;
    const int K = g.K, nt = K / BK;
    unsigned voffA[2], voffB[2];
#pragma unroll
    for (int i = 0; i < 2; ++i) { int R, C; stage_rc(tid * 16 + i * 8192, R, C); const int Rb = Epi::PERM ? ((R & ~31) + perm32(R & 31)) : R;
        voffA[i] = (unsigned)(R * K + C) * 2u; voffB[i] = (unsigned)(Rb * K + C) * 2u; }
    const size_t kstep = (size_t)(BK * 2);
    const size_t hstep = (size_t)HALF * K * 2;
    const size_t tstep = 2 * hstep;
    const unsigned ldsw = (unsigned)wid * 1024u;
    const int aoff = lds_byte(wr * 64 + fr, fq * 8), boff = lds_byte(wc * 32 + fr, fq * 8);
#define PG8_SA(b, h) (((b) * 2 + (h)) * HTB)
#define PG8_SB(b, h) ((4 + (b) * 2 + (h)) * HTB)
#define PG8_STAGE(bufoff, gbase, voff) do { _Pragma("unroll") for (int _i = 0; _i < 2; ++_i) \
        __builtin_amdgcn_global_load_lds((const unsigned*)((const char*)(gbase) + (voff)[_i]), (PG8_LAS unsigned*)(lds + (bufoff) + ldsw + _i * 8192), 16, 0, 0); } while (0)
#define PG8_LDA(dst, b, h) do { _Pragma("unroll") for (int m = 0; m < 4; ++m) _Pragma("unroll") for (int k = 0; k < 2; ++k) dst[m][k] = *(const PG8_LAS bf16x8*)(lds + PG8_SA(b, h) + aoff + m * 2048 + k * 1024); } while (0)
#define PG8_LDB(dst, b, h) do { _Pragma("unroll") for (int n = 0; n < 2; ++n) _Pragma("unroll") for (int k = 0; k < 2; ++k) dst[n][k] = *(const PG8_LAS bf16x8*)(lds + PG8_SB(b, h) + boff + n * 2048 + k * 1024); } while (0)
#define PG8_MMA(ai, bj, At, Bt) do { __builtin_amdgcn_s_setprio(1); _Pragma("unroll") for (int m = 0; m < 4; ++m) _Pragma("unroll") for (int n = 0; n < 2; ++n) _Pragma("unroll") for (int k = 0; k < 2; ++k) \
        acc[ai][bj][m][n] = __builtin_amdgcn_mfma_f32_16x16x32_bf16(Bt[n][k], At[m][k], acc[ai][bj][m][n], 0, 0, 0); __builtin_amdgcn_s_setprio(0); } while (0)
#define PG8_WAIT_V(n) asm volatile("s_waitcnt vmcnt(" #n ")" ::: "memory")
#define PG8_WAIT_L(n) asm volatile("s_waitcnt lgkmcnt(" #n ")" ::: "memory")
#define PG8_BAR __builtin_amdgcn_s_barrier()
#define PG8_SCHED __builtin_amdgcn_sched_barrier(0)
    Unit cur, nxt; int ui = 0;
    if (!S.next(0, cur)) return;
    f32x4 acc[2][2][4][2];
#pragma unroll
    for (int a = 0; a < 2; ++a)
#pragma unroll
        for (int b = 0; b < 2; ++b)
#pragma unroll
            for (int m = 0; m < 4; ++m)
#pragma unroll
                for (int n = 0; n < 2; ++n) acc[a][b][m][n] = (f32x4){0.f, 0.f, 0.f, 0.f};
    bf16x8 At[4][2], B0[2][2], B1[2][2];
    const char* cA = (const char*)g.A + (size_t)cur.pm * tstep; const char* cB = (const char*)g.Bt + (size_t)cur.pn * tstep;
    S.a_ready(cur);
    if constexpr (SP2) {
        PG8_STAGE(PG8_SB(0, 0), cB, voffB); PG8_STAGE(PG8_SB(0, 1), cB + hstep, voffB); PG8_STAGE(PG8_SA(0, 0), cA, voffA); PG8_STAGE(PG8_SA(0, 1), cA + hstep, voffA);
        if (wr == 1) PG8_BAR;
        PG8_WAIT_V(2); PG8_BAR;
        PG8_STAGE(PG8_SB(1, 0), cB + kstep, voffB); PG8_STAGE(PG8_SA(1, 0), cA + kstep, voffA); PG8_STAGE(PG8_SB(1, 1), cB + hstep + kstep, voffB);
        PG8_WAIT_V(6); PG8_BAR;
    } else {
        PG8_STAGE(PG8_SB(0, 0), cB, voffB); PG8_STAGE(PG8_SA(0, 0), cA, voffA); PG8_STAGE(PG8_SB(0, 1), cB + hstep, voffB); PG8_STAGE(PG8_SA(0, 1), cA + hstep, voffA);
        if (wr == 1) PG8_BAR;
        PG8_WAIT_V(4); PG8_BAR;
        PG8_STAGE(PG8_SB(1, 0), cB + kstep, voffB); PG8_STAGE(PG8_SA(1, 0), cA + kstep, voffA); PG8_STAGE(PG8_SB(1, 1), cB + hstep + kstep, voffB);
        PG8_WAIT_V(6); PG8_BAR;
    }
    for (;;) {
        const bool has_next = S.next(ui + 1, nxt);
        const char* nA = has_next ? (const char*)g.A + (size_t)nxt.pm * tstep : cA; const char* nB = has_next ? (const char*)g.Bt + (size_t)nxt.pn * tstep : cB;
        for (int t = 0; t < nt; t += 2) {
            const bool last = (t == nt - 2);
            const char* a1 = cA + (size_t)(t + 1) * kstep;
            const char* a2 = last ? nA : cA + (size_t)(t + 2) * kstep; const char* b2 = last ? nB : cB + (size_t)(t + 2) * kstep;
            const char* a3 = a2 + kstep; const char* b3 = b2 + kstep;
            if (last && has_next) S.a_ready(nxt);
            if constexpr (Epi::HAS_MID) { if (t == nt / 2) E.mid(acc, cur, wr, fr); }
            if constexpr (SP2) {
            PG8_LDB(B0, 0, 0); PG8_LDB(B1, 0, 1); PG8_SCHED; PG8_LDA(At, 0, 0); PG8_STAGE(PG8_SA(1, 1), a1 + hstep, voffA);
            PG8_WAIT_V(8); PG8_WAIT_L(0); PG8_BAR; PG8_MMA(0, 0, At, B0); PG8_MMA(0, 1, At, B1); PG8_BAR; PG8_SCHED;
            PG8_LDA(At, 0, 1); PG8_STAGE(PG8_SB(0, 0), b2, voffB); PG8_STAGE(PG8_SB(0, 1), b2 + hstep, voffB); PG8_STAGE(PG8_SA(0, 0), a2, voffA);
            PG8_WAIT_V(8); PG8_WAIT_L(0); PG8_BAR; PG8_MMA(1, 0, At, B0); PG8_MMA(1, 1, At, B1); PG8_BAR; PG8_SCHED;
            PG8_LDB(B0, 1, 0); PG8_LDB(B1, 1, 1); PG8_SCHED; PG8_LDA(At, 1, 0); PG8_STAGE(PG8_SA(0, 1), a2 + hstep, voffA);
            PG8_WAIT_V(8); PG8_WAIT_L(0); PG8_BAR; PG8_MMA(0, 0, At, B0); PG8_MMA(0, 1, At, B1); PG8_BAR; PG8_SCHED;
            PG8_LDA(At, 1, 1); PG8_STAGE(PG8_SB(1, 0), b3, voffB); PG8_STAGE(PG8_SB(1, 1), b3 + hstep, voffB); PG8_STAGE(PG8_SA(1, 0), a3, voffA);
            PG8_WAIT_V(8); PG8_WAIT_L(0); PG8_BAR; PG8_MMA(1, 0, At, B0); PG8_MMA(1, 1, At, B1); PG8_BAR; PG8_SCHED;
            } else {
            PG8_LDB(B0, 0, 0); PG8_SCHED; PG8_LDA(At, 0, 0); PG8_STAGE(PG8_SA(1, 1), a1 + hstep, voffA);
            PG8_WAIT_L(8); PG8_BAR; PG8_WAIT_L(0); PG8_MMA(0, 0, At, B0); PG8_BAR; PG8_SCHED;
            PG8_LDB(B1, 0, 1); PG8_STAGE(PG8_SB(0, 0), b2, voffB);
            PG8_BAR; PG8_WAIT_L(0); PG8_MMA(0, 1, At, B1); PG8_BAR;
            PG8_LDA(At, 0, 1); PG8_STAGE(PG8_SA(0, 0), a2, voffA);
            PG8_BAR; PG8_WAIT_L(0); PG8_MMA(1, 0, At, B0); PG8_BAR; PG8_SCHED;
            PG8_STAGE(PG8_SB(0, 1), b2 + hstep, voffB);
            PG8_WAIT_V(6); PG8_BAR; PG8_MMA(1, 1, At, B1); PG8_BAR;
            PG8_LDB(B0, 1, 0); PG8_SCHED; PG8_LDA(At, 1, 0); PG8_STAGE(PG8_SA(0, 1), a2 + hstep, voffA);
            PG8_WAIT_L(8); PG8_BAR; PG8_WAIT_L(0); PG8_MMA(0, 0, At, B0); PG8_BAR; PG8_SCHED;
            PG8_LDB(B1, 1, 1); PG8_STAGE(PG8_SB(1, 0), b3, voffB);
            PG8_BAR; PG8_WAIT_L(0); PG8_MMA(0, 1, At, B1); PG8_BAR;
            PG8_LDA(At, 1, 1); PG8_STAGE(PG8_SA(1, 0), a3, voffA);
            PG8_BAR; PG8_WAIT_L(0); PG8_MMA(1, 0, At, B0); PG8_BAR; PG8_SCHED;
            PG8_STAGE(PG8_SB(1, 1), b3 + hstep, voffB);
            PG8_WAIT_V(6); PG8_BAR; PG8_MMA(1, 1, At, B1); PG8_BAR;
            }
        }
        if constexpr (ALIGN_EPI) { if (wr == 0) PG8_BAR; }
        if constexpr (!Epi::AFTER_DRAIN) { E(acc, cur, wr, wc, fr, fq); S.done(cur); }
        if (!has_next) break;
#pragma unroll
        for (int a = 0; a < 2; ++a)
#pragma unroll
            for (int b = 0; b < 2; ++b)
#pragma unroll
                for (int m = 0; m < 4; ++m)
#pragma unroll
                    for (int n = 0; n < 2; ++n) acc[a][b][m][n] = (f32x4){0.f, 0.f, 0.f, 0.f};
        cur = nxt; cA = nA; cB = nB; ++ui;
        if constexpr (ALIGN_EPI) { if (wr == 1) PG8_BAR; }
    }
    PG8_WAIT_V(0);
    if constexpr (!ALIGN_EPI) { if (wr == 0) PG8_BAR; }
    PG8_BAR;
    if constexpr (Epi::AFTER_DRAIN) { E.fused(acc, cur, wr, wc, fr, fq, lds, wid, lane); S.done(cur); }
#undef PG8_SA
#undef PG8_SB
#undef PG8_STAGE
#undef PG8_LDA
#undef PG8_LDB
#undef PG8_MMA
#undef PG8_WAIT_V
#undef PG8_WAIT_L
#undef PG8_BAR
#undef PG8_SCHED
}
}

#ifndef PG8_SP2
#define PG8_SP2 true
#endif
#ifndef PG8_ALIGN
#define PG8_ALIGN true
#endif
#include <hip/hip_bf16.h>
#include <cmath>
namespace attn_body {
using bf16=__hip_bfloat16;
using bf16x8=__attribute__((ext_vector_type(8)))short;
using s16x4=__attribute__((ext_vector_type(4)))short;
using f32x16=__attribute__((ext_vector_type(16)))float;
using u32x4=__attribute__((ext_vector_type(4)))unsigned;
using u32x2=__attribute__((ext_vector_type(2)))unsigned;
using f32x4v=__attribute__((ext_vector_type(4)))float;
constexpr int BATCH=8,NHEAD=8,SEQ=4096,D=64,DM=NHEAD*D,OPITCH=1024;
constexpr long QKV_BPAD=((long)SEQ*2816*2-(long)SEQ*DM*2)/2;
constexpr int NW=8,QBLK=32,QB=QBLK*NW,KVBLK=64,NQB=SEQ/QB;
constexpr int ATTN_PITCH=DM, ATTN_UNIT_ROWS=QB;
__device__ __forceinline__ int crow(int r,int hi){return (r&3)+8*(r>>2)+4*hi;}
#define SBAR() __builtin_amdgcn_sched_barrier(0)
__device__ __forceinline__ void cmask(f32x16&p0,f32x16&p1,int jb,int qrel,int hi){
  const float NEG=-INFINITY; int kb=64*jb+4*hi;
  #pragma unroll
  for(int r=0;r<16;++r){int kv=kb+(r&3)+8*(r>>2); if(kv>qrel)p0[r]=NEG; if(kv+32>qrel)p1[r]=NEG;}
}

constexpr int NSLOT=3, SLOTB=8192;
constexpr int LDS_K=0, LDS_V=NSLOT*SLOTB, LDS_WS=2*NSLOT*SLOTB, LDS_OST=LDS_WS+NW*64*4, LDS_BIAS=LDS_OST+NW*4096, LDS_RED=135168, LDS_BYTES=LDS_RED+1024;   static_assert(LDS_BIAS+SEQ*8<=LDS_RED,"attn lds");
constexpr float C2=0.125f*1.4426950408889634f;
__device__ __forceinline__ void glds16(const void*gsrc,unsigned lds_dst){unsigned keep;
  asm volatile("s_mov_b32 %0, m0\n\ts_mov_b32 m0, %2\n\ts_nop 0\n\tglobal_load_lds_dwordx4 %1, off\n\ts_mov_b32 m0, %0":"=&s"(keep):"v"(gsrc),"s"(lds_dst):"memory");}
__device__ __forceinline__ float max3f(float a,float b,float c){float r;asm("v_max3_f32 %0, %1, %2, %3":"=v"(r):"v"(a),"v"(b),"v"(c));return r;}
__device__ __forceinline__ float max2f(float a,float b){float r;asm("v_max_f32_e32 %0, %1, %2":"=v"(r):"v"(a),"v"(b));return r;}
__device__ __forceinline__ float fadd_s(float a,float b){float r;asm("v_add_f32_e32 %0, %1, %2":"=v"(r):"v"(a),"v"(b));return r;}
__device__ __forceinline__ float fsub_s(float a,float b){float r;asm("v_sub_f32_e32 %0, %1, %2":"=v"(r):"v"(a),"v"(b));return r;}
typedef float f32x2_t __attribute__((ext_vector_type(2))); typedef __bf16 bf16x2_t __attribute__((ext_vector_type(2)));
__device__ __forceinline__ unsigned cvtpk_s(float lo,float hi){f32x2_t v={lo,hi};bf16x2_t b=__builtin_convertvector(v,bf16x2_t);return __builtin_bit_cast(unsigned,b);}
#define WAIT_BAR(N) asm volatile("s_waitcnt vmcnt(" #N ") lgkmcnt(0)\n\ts_barrier":::"memory")

__device__ __forceinline__ void qkt(f32x16&p0,f32x16&p1,const char*Kslot,const bf16x8*qr,const f32x16&negm,int r32,int hi,bf16x8 kx0,bf16x8 kx1,bf16x8 qx){
  const char*kb=Kslot+hi*1024+r32*16;
  p0=__builtin_amdgcn_mfma_f32_32x32x16_bf16(kx0,qx,negm,0,0,0);p1=__builtin_amdgcn_mfma_f32_32x32x16_bf16(kx1,qx,negm,0,0,0);
  #pragma unroll
  for(int d0=0;d0<4;++d0){
    const bf16x8 b0=*reinterpret_cast<const bf16x8*>(kb+d0*2048);
    const bf16x8 b1=*reinterpret_cast<const bf16x8*>(kb+d0*2048+512);
    p0=__builtin_amdgcn_mfma_f32_32x32x16_bf16(b0,qr[d0],p0,0,0,0);p1=__builtin_amdgcn_mfma_f32_32x32x16_bf16(b1,qr[d0],p1,0,0,0);}
}
typedef __attribute__((address_space(3))) const char* lds_cptr;
typedef short v4i16_t __attribute__((ext_vector_type(4)));
__device__ __forceinline__ void kload8(bf16x8*kf,lds_cptr kp){
  kf[0]=*(const __attribute__((address_space(3))) bf16x8*)(kp);      kf[1]=*(const __attribute__((address_space(3))) bf16x8*)(kp+512);
  kf[2]=*(const __attribute__((address_space(3))) bf16x8*)(kp+2048); kf[3]=*(const __attribute__((address_space(3))) bf16x8*)(kp+2560);
  kf[4]=*(const __attribute__((address_space(3))) bf16x8*)(kp+4096); kf[5]=*(const __attribute__((address_space(3))) bf16x8*)(kp+4608);
  kf[6]=*(const __attribute__((address_space(3))) bf16x8*)(kp+6144); kf[7]=*(const __attribute__((address_space(3))) bf16x8*)(kp+6656);
}
__device__ __forceinline__ void kload2(bf16x8*kf,lds_cptr kp,int j){ kf[2*j]=*(const __attribute__((address_space(3))) bf16x8*)(kp+j*2048); kf[2*j+1]=*(const __attribute__((address_space(3))) bf16x8*)(kp+j*2048+512); }
__device__ __forceinline__ s16x4 vtr(lds_cptr p){ return __builtin_bit_cast(s16x4,__builtin_amdgcn_ds_read_tr16_b64_v4i16((__attribute__((address_space(3))) v4i16_t*)p)); }
__device__ __forceinline__ float rowmax(const f32x16&p0,const f32x16&p1){
  float a=max3f(p0[0],p0[1],p1[0]),b=max3f(p0[2],p0[3],p1[1]);a=max3f(a,p1[2],p1[3]);
  #pragma unroll
  for(int r=4;r<16;r+=4){a=max3f(a,p0[r],p0[r+1]);b=max3f(b,p0[r+2],p0[r+3]);a=max3f(a,p1[r],p1[r+1]);b=max3f(b,p1[r+2],p1[r+3]);}
  const float m=max2f(a,b);
  auto rr=__builtin_amdgcn_permlane32_swap(__float_as_uint(m),__float_as_uint(m),false,false);
  return max2f(__uint_as_float(rr[0]),__uint_as_float(rr[1]));
}
__device__ __forceinline__ void pv(f32x16*o,int vb,bf16x8 pa0,bf16x8 pa1,bf16x8 pa2,bf16x8 pa3){
  #pragma unroll
  for(int d0=0;d0<2;++d0){s16x4 lo[4],hi[4];
    #pragma unroll
    for(int ks=0;ks<4;++ks){
      asm volatile("ds_read_b64_tr_b16 %0,%1 offset:%c2":"=&v"(lo[ks]):"v"(vb),"i"(d0*4096+ks*1024):"memory");
      asm volatile("ds_read_b64_tr_b16 %0,%1 offset:%c2":"=&v"(hi[ks]):"v"(vb),"i"(d0*4096+ks*1024+512):"memory");}
    asm volatile("s_waitcnt lgkmcnt(0)":::"memory");SBAR();
    #define PK(k) (bf16x8){lo[k][0],lo[k][1],lo[k][2],lo[k][3],hi[k][0],hi[k][1],hi[k][2],hi[k][3]}
    o[d0]=__builtin_amdgcn_mfma_f32_32x32x16_bf16(pa0,PK(0),o[d0],0,0,0);
    o[d0]=__builtin_amdgcn_mfma_f32_32x32x16_bf16(pa1,PK(1),o[d0],0,0,0);
    o[d0]=__builtin_amdgcn_mfma_f32_32x32x16_bf16(pa2,PK(2),o[d0],0,0,0);
    o[d0]=__builtin_amdgcn_mfma_f32_32x32x16_bf16(pa3,PK(3),o[d0],0,0,0);
    #undef PK
  }
}

#ifndef ATTN_STORE16
#define ATTN_STORE16(p,v) (*(u32x4*)(p)=(v))
#endif
template<int THRL> __device__ __forceinline__ void attn_unit(int b,int h,int qb,const bf16*Q,const bf16*__restrict__ K,const bf16*__restrict__ V,bf16*O,float bound,int ui,const float*__restrict__ cumh,float*ssb,char*shm){
  const int tid=otid(),lane=tid&63,r32=lane&31,hi=lane>>5; const int wid=__builtin_amdgcn_readfirstlane(tid>>6);
  const long rowbase=(long)b*SEQ; const int q0=qb*QB;
  const bf16*Qw=Q+(long)b*QKV_BPAD+(rowbase+q0+wid*QBLK)*DM+h*D;
  const bf16*Kh=K+(long)b*QKV_BPAD+rowbase*DM+h*D,*Vh=V+(long)b*QKV_BPAD+rowbase*DM+h*D;
  const lds_cptr shm3=(lds_cptr)shm;
  const unsigned lds0=(unsigned)(uintptr_t)shm;
  float*wsf=(float*)(shm+LDS_WS)+wid*64;
  const bf16*ksrc0=Kh+(long)lane*DM+wid*8;
  const bf16*vsrc0=Vh+(long)(16*(wid&3)+(lane>>2))*DM+(wid>>2)*32+(lane&3)*8;
  const unsigned kdst=lds0+LDS_K+wid*1024, vdst=lds0+LDS_V+wid*1024;
  #define DMA_K(t,slot) glds16(ksrc+(long)(t)*KVBLK*DM,(unsigned)__builtin_amdgcn_readfirstlane(kdst+(slot)))
  #define DMA_V(t,slot) glds16(vsrc+(long)(t)*KVBLK*DM,(unsigned)__builtin_amdgcn_readfirstlane(vdst+(slot)))
  const int vb0=(int)(lds0+LDS_V)+((lane>>4)&1)*32+(lane&3)*8+(4*hi+((lane&15)>>2))*64;
  const char*Kbase=shm+LDS_K; bf16x8 kf[8];
  const lds_cptr kp0=shm3+LDS_K+hi*1024+r32*16; const lds_cptr vp0=shm3+LDS_V+((lane>>4)&1)*32+(lane&3)*8+(4*hi+((lane&15)>>2))*64;
  int NT=(q0+QB)/KVBLK;
  int ts;
  { __attribute__((address_space(3))) float*red=(__attribute__((address_space(3))) float*)(shm3+LDS_RED);
    const float cref=cumh[q0]; int cnt=0; const int nk=q0+QB;
    float cv[SEQ/(NW*64)];
    #pragma unroll
    for(int k=0;k<SEQ/(NW*64);++k){ const int i=tid+k*NW*64; cv[k]=(i<nk)?cumh[i]:0.f; }
    #pragma unroll
    for(int k=0;k<SEQ/(NW*64);++k){ const int i=tid+k*NW*64; if(i<nk){ const float x=cref-cv[k]; cnt+=(x<=-bound)?1:0; const unsigned u1=__float_as_uint(x)&0xffff0000u; const float r1=x-__uint_as_float(u1);
      const unsigned u2=__float_as_uint(r1)&0xffff0000u; const float r2=r1-__uint_as_float(u2); const unsigned u3=__float_as_uint(r2)&0xffff0000u;
      u32x2 w; w.x=(u1>>16)|u2; w.y=u3>>16; *(__attribute__((address_space(3))) u32x2*)(shm3+LDS_BIAS+i*8)=w; } }
    #pragma unroll
    for(int o=1;o<64;o<<=1)cnt+=__shfl_xor(cnt,o);
    if(lane==0)red[64+ui*8+wid]=(float)cnt;
    asm volatile("s_waitcnt lgkmcnt(0)\n\ts_barrier":::"memory");
    float tot=0.f;
    #pragma unroll
    for(int w=0;w<NW;++w)tot+=red[64+ui*8+w];
    ts=((int)tot>>6)&~1; if(ts>NT-4)ts=NT-4;
    ts=__builtin_amdgcn_readfirstlane(ts); }
  const bf16*ksrc=ksrc0+(long)ts*KVBLK*DM; const bf16*vsrc=vsrc0+(long)ts*KVBLK*DM; NT-=ts;
  const lds_cptr bp0=shm3+LDS_BIAS+r32*8+ts*512;
  bf16x8 qx; { const u32x4 t=(hi==0)?(u32x4){0x3F803F80u,0x00003F80u,0u,0u}:(u32x4){0u,0u,0u,0u}; qx=__builtin_bit_cast(bf16x8,t); }
  #define BIASLD(t,which) ({ const u32x2 w_=*(const __attribute__((address_space(3))) u32x2*)(bp0+(t)*512+(which)*256); const u32x4 t_=(u32x4){w_.x,w_.y,0u,0u}; __builtin_bit_cast(bf16x8,t_); })
  DMA_K(0,0);DMA_V(0,0);DMA_K(1,SLOTB);
  bf16x8 qr[4];
  #pragma unroll
  for(int d0=0;d0<4;++d0)qr[d0]=*reinterpret_cast<const bf16x8*>(&Qw[(long)r32*DM+d0*16+hi*8]);
  float mhat=0.f,l_reg=0.f;f32x16 o[2];o[0]=f32x16{};o[1]=f32x16{};f32x16 negm=f32x16{};asm volatile("":"+v"(negm));
  const int qrel=wid*QBLK+r32;
  #define CMASK(P0,P1,t) do{int jb_=(t)-(NT-4); if(jb_>=0)cmask(P0,P1,jb_,qrel,hi);}while(0)
  bool resc=false;
  #define START(P0,P1) do{ const float rm=rowmax(P0,P1); resc=false; \
    { const float dl=rm; mhat=fadd_s(mhat,dl); \
      _Pragma("unroll") for(int r=0;r<16;++r){P0[r]=fsub_s(P0[r],dl);P1[r]=fsub_s(P1[r],dl);} \
      _Pragma("unroll") for(int r=0;r<16;++r)negm[r]=-mhat; asm volatile("":"+v"(negm)); } \
    _Pragma("unroll") for(int r=0;r<16;++r)P0[r]=__builtin_amdgcn_exp2f(P0[r]); }while(0)
  #define RESC() do{ if(resc){ asm volatile("s_waitcnt lgkmcnt(0)":::"memory"); \
      _Pragma("unroll") for(int d_=0;d_<2;++d_) _Pragma("unroll") for(int r=0;r<16;++r)o[d_][r]*=wsf[crow(r,hi)]; } }while(0)
  f32x16 pA0,pA1,pB0,pB1;
  int sl_prev=0,sl_cur=0,sl_next=SLOTB;
  #define ROT() do{sl_prev=sl_cur;sl_cur=sl_next;sl_next=(sl_next==(NSLOT-1)*SLOTB)?0:sl_next+SLOTB;}while(0)
  DMA_K(2,2*SLOTB);
  WAIT_BAR(3);
  qkt(pA0,pA1,Kbase,qr,negm,r32,hi,BIASLD(0,0),BIASLD(0,1),qx);asm volatile("s_nop 15\n\ts_nop 7":"+v"(pA0),"+v"(pA1));CMASK(pA0,pA1,0);
  START(pA0,pA1);
  _Pragma("unroll") for(int r=0;r<16;++r)pA1[r]=__builtin_amdgcn_exp2f(pA1[r]);
  WAIT_BAR(0);
  DMA_K(3,0);DMA_V(1,SLOTB);
  ROT();
  kload8(kf,kp0+sl_cur);
  WAIT_BAR(2);
  s16x4 vlo[8],vhi[8]; u32x4 pw0,pw1,pw2,pw3;
  #define PKW(P,B) cvtpk_s(P[B],P[B+1])
  #define PAF(k) __builtin_bit_cast(bf16x8,pw##k)
  #define VFR(i) (bf16x8){vlo[i][0],vlo[i][1],vlo[i][2],vlo[i][3],vhi[i][0],vhi[i][1],vhi[i][2],vhi[i][3]}
  #define PIN(x) asm volatile("":"+v"(x))
  #define MX3(a,b,c) __builtin_fmaxf(__builtin_fmaxf((a),(b)),(c))
  #define GAPA(MF,A0,A1,A2,A3,W0,W1,PW) do{ MF; sacc+=A0; sacc+=A1; sacc+=A2; sacc+=A3; PIN(sacc); W0; W1; PIN(PW); SBAR(); }while(0)
  #define EX(v) __builtin_amdgcn_exp2f(v)
  #define GAPB(MF,X,B) do{ MF; X[B]=EX(X[B]); X[B+1]=EX(X[B+1]); X[B+2]=EX(X[B+2]); X[B+3]=EX(X[B+3]); PIN(X); SBAR(); }while(0)
  #define VRD(i) do{ vlo[i]=vtr(vp_+(((i)>>2)*4096+((i)&3)*1024)); vhi[i]=vtr(vp_+(((i)>>2)*4096+((i)&3)*1024+512)); }while(0)
  #define KRD(G,j) do{ if(G){ kload2(kf,kp0+sl_next,j); SBAR(); } }while(0)
  #define STEP(C0,C1,P0,P1,t,GK,GV,GL) do{ SBAR(); \
    const lds_cptr vp_=vp0+sl_prev; \
    C0=__builtin_amdgcn_mfma_f32_32x32x16_bf16(kbx0,qx,negm,0,0,0); C1=__builtin_amdgcn_mfma_f32_32x32x16_bf16(kbx1,qx,negm,0,0,0); SBAR(); \
    VRD(0); SBAR(); float sacc=(P0[0]+P0[1]); \
    GAPA(C0=__builtin_amdgcn_mfma_f32_32x32x16_bf16(kf[0],qr[0],C0,0,0,0), P0[2],P0[3],P0[4],P0[5],     pw0[0]=PKW(P0,0), pw0[1]=PKW(P0,2), pw0); \
    VRD(4); SBAR(); GAPA(C1=__builtin_amdgcn_mfma_f32_32x32x16_bf16(kf[1],qr[0],C1,0,0,0), P0[6],P0[7],P0[8],P0[9],     pw0[2]=PKW(P0,4), pw0[3]=PKW(P0,6), pw0); \
    VRD(1); SBAR(); GAPA(C0=__builtin_amdgcn_mfma_f32_32x32x16_bf16(kf[2],qr[1],C0,0,0,0),   P0[10],P0[11],P0[12],P0[13], pw1[0]=PKW(P0,8), pw1[1]=PKW(P0,10), pw1); \
    VRD(5); SBAR(); GAPA(C1=__builtin_amdgcn_mfma_f32_32x32x16_bf16(kf[3],qr[1],C1,0,0,0),   P0[14],P0[15],P1[0],P1[1],   pw1[2]=PKW(P0,12),pw1[3]=PKW(P0,14), pw1); \
    VRD(2); SBAR(); GAPA(C0=__builtin_amdgcn_mfma_f32_32x32x16_bf16(kf[4],qr[2],C0,0,0,0),   P1[2],P1[3],P1[4],P1[5],     pw2[0]=PKW(P1,0), pw2[1]=PKW(P1,2), pw2); \
    VRD(6); SBAR(); GAPA(C1=__builtin_amdgcn_mfma_f32_32x32x16_bf16(kf[5],qr[2],C1,0,0,0),   P1[6],P1[7],P1[8],P1[9],     pw2[2]=PKW(P1,4), pw2[3]=PKW(P1,6), pw2); \
    VRD(3); SBAR(); GAPA(C0=__builtin_amdgcn_mfma_f32_32x32x16_bf16(kf[6],qr[3],C0,0,0,0),   P1[10],P1[11],P1[12],P1[13], pw3[0]=PKW(P1,8), pw3[1]=PKW(P1,10), pw3); \
    VRD(7); SBAR(); GAPA(C1=__builtin_amdgcn_mfma_f32_32x32x16_bf16(kf[7],qr[3],C1,0,0,0),   P1[14],P1[15],0.f,0.f,       pw3[2]=PKW(P1,12),pw3[3]=PKW(P1,14), pw3); \
    l_reg+=sacc; \
    if(GK){DMA_K((t)+3,sl_cur);} if(GV){DMA_V((t)+1,sl_next);} \
    CMASK(C0,C1,t); \
    { float a=MX3(C0[0],C0[1],C1[0]),b=MX3(C0[2],C0[3],C1[1]); a=MX3(a,C1[2],C1[3]); \
      _Pragma("unroll") for(int r=4;r<16;r+=4){a=MX3(a,C0[r],C0[r+1]);b=MX3(b,C0[r+2],C0[r+3]);a=MX3(a,C1[r],C1[r+1]);b=MX3(b,C1[r+2],C1[r+3]);} \
      float rm=__builtin_fmaxf(a,b); { auto rr=__builtin_amdgcn_permlane32_swap(__float_as_uint(rm),__float_as_uint(rm),false,false); rm=__builtin_fmaxf(__uint_as_float(rr[0]),__uint_as_float(rr[1])); } \
      resc=false; \
      if(__builtin_expect(__any(rm>(float)THRL),0)){ const float dl=__builtin_fmaxf(rm,0.f); mhat+=dl; \
        _Pragma("unroll") for(int r=0;r<16;++r){C0[r]-=dl;C1[r]-=dl;} \
        _Pragma("unroll") for(int r=0;r<16;++r)negm[r]=-mhat; asm volatile("":"+v"(negm)); \
        const float f=__builtin_amdgcn_exp2f(-dl); l_reg*=f; if(hi==0)wsf[r32]=f; resc=true; } } \
    SBAR(); \
    GAPB(o[0]=__builtin_amdgcn_mfma_f32_32x32x16_bf16(PAF(0),VFR(0),o[0],0,0,0), C0,0); \
    GAPB(o[1]=__builtin_amdgcn_mfma_f32_32x32x16_bf16(PAF(0),VFR(4),o[1],0,0,0), C0,4); \
    KRD(GL,0); GAPB(o[0]=__builtin_amdgcn_mfma_f32_32x32x16_bf16(PAF(1),VFR(1),o[0],0,0,0), C0,8); \
    KRD(GL,1); GAPB(o[1]=__builtin_amdgcn_mfma_f32_32x32x16_bf16(PAF(1),VFR(5),o[1],0,0,0), C0,12); \
    KRD(GL,2); GAPB(o[0]=__builtin_amdgcn_mfma_f32_32x32x16_bf16(PAF(2),VFR(2),o[0],0,0,0), C1,0); \
    KRD(GL,3); GAPB(o[1]=__builtin_amdgcn_mfma_f32_32x32x16_bf16(PAF(2),VFR(6),o[1],0,0,0), C1,4); \
    GAPB(o[0]=__builtin_amdgcn_mfma_f32_32x32x16_bf16(PAF(3),VFR(3),o[0],0,0,0), C1,8); \
    GAPB(o[1]=__builtin_amdgcn_mfma_f32_32x32x16_bf16(PAF(3),VFR(7),o[1],0,0,0), C1,12); \
    if(GL){ kbx0=BIASLD((t)+1,0); kbx1=BIASLD((t)+1,1); } \
    }while(0)
  int t=1; bf16x8 kbx0=BIASLD(1,0),kbx1=BIASLD(1,1);
  #undef CMASK
  #define CMASK(P0,P1,t) do{}while(0)
  for(;t+5<NT;t+=2){
    STEP(pB0,pB1,pA0,pA1,t,true,true,true);     WAIT_BAR(2); RESC(); ROT();
    STEP(pA0,pA1,pB0,pB1,t+1,true,true,true);   WAIT_BAR(2); RESC(); ROT();
  }
  #undef CMASK
  #define CMASK(P0,P1,t) do{int jb_=(t)-(NT-4); if(jb_>=0)cmask(P0,P1,jb_,qrel,hi);}while(0)
  #define ENDW(tt) do{ if((tt)+3<NT){WAIT_BAR(2);} else if((tt)+2<NT){WAIT_BAR(1);} else {WAIT_BAR(0);} }while(0)
  for(;t+1<NT;t+=2){
    STEP(pB0,pB1,pA0,pA1,t,(t+3<NT),(t+1<NT),(t+1<NT));       ENDW(t);   RESC(); ROT();
    STEP(pA0,pA1,pB0,pB1,t+1,(t+4<NT),(t+2<NT),(t+2<NT));     ENDW(t+1); RESC(); ROT();
  }
  STEP(pB0,pB1,pA0,pA1,NT-1,false,false,false); RESC();
  { float sacc=pB0[0]+pB0[1]; _Pragma("unroll") for(int r=2;r<16;++r)sacc+=pB0[r]; _Pragma("unroll") for(int r=0;r<16;++r)sacc+=pB1[r]; l_reg+=sacc;
    pw0=(u32x4){PKW(pB0,0),PKW(pB0,2),PKW(pB0,4),PKW(pB0,6)};pw1=(u32x4){PKW(pB0,8),PKW(pB0,10),PKW(pB0,12),PKW(pB0,14)};pw2=(u32x4){PKW(pB1,0),PKW(pB1,2),PKW(pB1,4),PKW(pB1,6)};pw3=(u32x4){PKW(pB1,8),PKW(pB1,10),PKW(pB1,12),PKW(pB1,14)};
    SBAR(); pv(o,vb0+sl_cur,PAF(0),PAF(1),PAF(2),PAF(3)); }
  #undef PKW
  #undef PAF
  #undef VFR
  #undef PIN
  #undef MX3
  #undef GAPA
  #undef GAPB
  #undef EX
  #undef VRD
  #undef KRD
  #undef STEP
  #undef ENDW
  {auto rr=__builtin_amdgcn_permlane32_swap(__float_as_uint(l_reg),__float_as_uint(l_reg),false,false);l_reg=__uint_as_float(rr[0])+__uint_as_float(rr[1]);}
  if(hi==0)wsf[32+r32]=l_reg;asm volatile("s_waitcnt lgkmcnt(0)":::"memory");
  float rli[16];
  #pragma unroll
  for(int r=0;r<16;++r)rli[r]=__builtin_amdgcn_rcpf(wsf[32+crow(r,hi)]);
  bf16*Ow=O+(rowbase+q0+wid*QBLK)*OPITCH+h*D; float*ssw=ssb+(long)h*(BATCH*SEQ)+rowbase+q0+wid*QBLK;
  { bf16*stg=(bf16*)(shm+LDS_OST)+wid*2048;
    #pragma unroll
    for(int r=0;r<16;++r){const int orow=crow(r,hi);
      #pragma unroll
      for(int d0=0;d0<2;++d0)stg[orow*64+d0*32+r32]=__float2bfloat16(o[d0][r]*rli[r]);}
    asm volatile("s_waitcnt lgkmcnt(0)":::"memory");
    #pragma unroll
    for(int i=0;i<4;++i){const int row=i*8+(lane>>3),ch=lane&7; const u32x4 v=*(const u32x4*)(stg+row*64+ch*8); ATTN_STORE16(Ow+(long)row*OPITCH+ch*8,v);
      float q=0.f;
      #pragma unroll
      for(int e=0;e<4;++e){const float lo=__uint_as_float(v[e]<<16),hi2=__uint_as_float(v[e]&0xffff0000u); q+=lo*lo+hi2*hi2;}
      q+=__shfl_xor(q,1);q+=__shfl_xor(q,2);q+=__shfl_xor(q,4); if(ch==0)ssw[row]=q;} }
  asm volatile("s_waitcnt lgkmcnt(0)\n\ts_barrier":::"memory");
  #undef DMA_K
  #undef DMA_V
  #undef BIASLD
  #undef CMASK
  #undef START
  #undef RESC
  #undef ROT
}
constexpr int ATTN_LDS_BYTES=LDS_BYTES;
struct AttnTensors { const bf16* Q; const bf16* K; const bf16* V; bf16* O; const float* cum2; float* ssb; float* kpart; };
struct AttnUnit { int bh; int qb; };
struct StaticOrder {
  int vcu;
  __device__ __forceinline__ explicit StaticOrder(int grid,int block):vcu((block%8)*(grid/8)+block/8){}
  __device__ __forceinline__ bool next(int i,AttnUnit&u)const{ if(i>=4||vcu>=256)return false; const int s=(vcu>>3)&3,h0=vcu&7; u.bh=(vcu>>5)*NHEAD+((h0+2*i)&7); u.qb=(i==0)?s:(i==1)?7-s:(i==2)?8+s:15-s; return true; }
  __device__ __forceinline__ void a_ready(const AttnUnit&)const{}
  __device__ __forceinline__ void done(const AttnUnit&)const{}
};
template<class Sched> __device__ __forceinline__ void attn_pre(char*lds,const AttnTensors&T,const Sched&S){
  AttnUnit u;
  if(!S.next(0,u))return;
  const int tid=otid(),lane=tid&63; const int wid=__builtin_amdgcn_readfirstlane(tid>>6); const int b=u.bh/NHEAD;
  typedef __attribute__((address_space(3))) float ldsf;
  ldsf*red=(ldsf*)((lds_cptr)lds+LDS_RED);
  { const int hk=S.vcu&7,sk=(S.vcu>>3)&3; float mx=0.f; const bf16*Kh=T.K+(long)b*QKV_BPAD+((long)b*SEQ+sk*(SEQ/4))*DM+hk*D;
    for(int r=tid;r<SEQ/4;r+=NW*64){ const u32x4*pr=(const u32x4*)(Kh+(long)r*DM); float q=0.f;
      #pragma unroll
      for(int c=0;c<8;++c){ const u32x4 v=pr[c];
        #pragma unroll
        for(int e=0;e<4;++e){ const float lo=__uint_as_float(v[e]<<16),hi2=__uint_as_float(v[e]&0xffff0000u); q+=lo*lo+hi2*hi2; } }
      mx=fmaxf(mx,q); }
    #pragma unroll
    for(int o=1;o<64;o<<=1)mx=fmaxf(mx,__shfl_xor(mx,o));
    if(lane==0)red[wid]=mx;
    __syncthreads();
    if(tid==0){ float m=0.f;
      #pragma unroll
      for(int w=0;w<NW;++w)m=fmaxf(m,red[w]);
      T.kpart[(b*NHEAD+hk)*4+sk]=m; } }
  for(int ui=0;ui<4;++ui){ AttnUnit uu; if(!S.next(ui,uu))break; const int h=uu.bh%NHEAD;
    const long row=(long)b*SEQ+uu.qb*QB+(tid>>1);
    const u32x4*pr=(const u32x4*)(T.Q+(long)b*QKV_BPAD+row*DM+h*D+(tid&1)*32); const u32x4*pk=(const u32x4*)(T.K+(long)b*QKV_BPAD+row*DM+h*D+(tid&1)*32); float q=0.f,dg=0.f;
    #pragma unroll
    for(int c=0;c<4;++c){ const u32x4 v=pr[c],kv=pk[c];
      #pragma unroll
      for(int e=0;e<4;++e){ const float lo=__uint_as_float(v[e]<<16),hi2=__uint_as_float(v[e]&0xffff0000u); q+=lo*lo+hi2*hi2;
        dg+=lo*__uint_as_float(kv[e]<<16)+hi2*__uint_as_float(kv[e]&0xffff0000u); } }
    q+=__shfl_xor(q,1); dg+=__shfl_xor(dg,1);
    dg+=T.cum2[(long)uu.bh*SEQ+uu.qb*QB]-T.cum2[(long)uu.bh*SEQ+uu.qb*QB+(tid>>1)];
    #pragma unroll
    for(int o=2;o<64;o<<=1){q=fmaxf(q,__shfl_xor(q,o));dg=fminf(dg,__shfl_xor(dg,o));}
    if(lane==0){red[8+ui*8+wid]=q;red[96+ui*8+wid]=dg;} }
  __syncthreads();
}
template<class Sched,int THRL=24> __device__ __forceinline__ void attn_run(char*lds,const AttnTensors&T,const Sched&S){
  AttnUnit u;
  for(int i=0;S.next(i,u);++i){ S.a_ready(u);
    float bound;
    { typedef __attribute__((address_space(3))) float ldsf; const ldsf*red=(const ldsf*)((lds_cptr)lds+LDS_RED); float q2=0.f,dmin=3.0e38f;
      const float*kp=T.kpart+u.bh*4; const float k2=fmaxf(fmaxf(kp[0],kp[1]),fmaxf(kp[2],kp[3]));
      #pragma unroll
      for(int w=0;w<NW;++w){q2=fmaxf(q2,red[8+i*8+w]);dmin=fminf(dmin,red[96+i*8+w]);}
      const float qk=sqrtf(k2*q2)*1.001f;
      bound=qk+32.0f+0.05f-fmaxf(fminf(dmin,0.f),-qk); }
    attn_unit<THRL>(u.bh/NHEAD,u.bh%NHEAD,u.qb,T.Q,T.K,T.V,T.O,bound,i,T.cum2+(long)u.bh*SEQ,T.ssb,lds); S.done(u); }
}
#undef SBAR
#undef WAIT_BAR
}
constexpr int NWAVES = 8;
constexpr int BATCH = 8, SEQ = 4096, DM_ = 1024, DFF = 2816, NIN = 2568, DA = 512, HA = 8, HB = 8;
constexpr int M = BATCH * SEQ;
constexpr float EPS = 1e-6f;
constexpr size_t MiB = 1u << 20;
constexpr size_t WS_MOD = 0;
constexpr size_t WS_LOGF = 1 * MiB;
constexpr size_t WS_CUM = 2 * MiB;
constexpr size_t WS_SS = 3 * MiB;
constexpr size_t WS_SSA = 5 * MiB;
constexpr size_t WS_SSB = 6 * MiB;
constexpr size_t WS_WGU0 = 8 * MiB;
constexpr size_t WS_WGU1 = 20 * MiB;
constexpr size_t WS_WD0 = 32 * MiB;
constexpr size_t WS_WD1 = 38 * MiB;
constexpr size_t WS_WIN = 44 * MiB;
constexpr size_t WS_WOUT = 50 * MiB;
constexpr size_t WS_H = 64 * MiB;
constexpr size_t WS_HD = 128 * MiB;
constexpr size_t WS_ACT = 192 * MiB;
constexpr size_t BSLAB = (size_t)SEQ * DFF * 2;
constexpr size_t WS_ZG = WS_ACT;
constexpr size_t WS_Q = WS_ACT + 8 * MiB, WS_K = WS_ACT + 12 * MiB, WS_V = WS_ACT + 16 * MiB;
constexpr size_t PAD_ZG = (BSLAB - (size_t)SEQ * 1024 * 2) / 2, PAD_QKV = (BSLAB - (size_t)SEQ * 512 * 2) / 2;
static_assert(BSLAB == 22 * MiB && 8 * MiB + 3 * (size_t)SEQ * 512 * 2 <= BSLAB, "slab map");
constexpr size_t WS_Y = WS_H;
constexpr size_t WS_X1 = 416 * MiB;
constexpr size_t WS_END = 480 * MiB;
static_assert(WS_ACT + (size_t)M * DFF * 2 <= 416 * MiB && WS_X1 + (size_t)M * 1024 * 2 <= WS_END, "ws map");
constexpr int LDS_BYTES = 147456;
constexpr int LDS_BARST = LDS_BYTES - 64;
constexpr size_t WS_KPART = 7 * MiB + 65536;
constexpr size_t WS_CTL = 7 * MiB, CTL_BYTES = 16384;

#define GAS __attribute__((address_space(1)))
#define LAS __attribute__((address_space(3)))
typedef unsigned short bf16;
typedef unsigned v4u __attribute__((ext_vector_type(4)));
typedef unsigned v2u __attribute__((ext_vector_type(2)));
typedef float f32x4 __attribute__((ext_vector_type(4)));
typedef short bf16x8 __attribute__((ext_vector_type(8)));
#define LDS_WAIT() asm volatile("s_waitcnt lgkmcnt(0)" ::: "memory")
__device__ __forceinline__ unsigned f2bf(float f) { unsigned u = __builtin_bit_cast(unsigned, f); return (u + 0x7fffu + ((u >> 16) & 1u)) >> 16; }
typedef float pk_f32x2 __attribute__((ext_vector_type(2))); typedef __bf16 pk_bf16x2 __attribute__((ext_vector_type(2)));
__device__ __forceinline__ unsigned pk2(float lo, float hi) { const pk_f32x2 v = {lo, hi}; return __builtin_bit_cast(unsigned, __builtin_convertvector(v, pk_bf16x2)); }
__device__ __forceinline__ float bf_lo(unsigned w) { return __builtin_bit_cast(float, w << 16); }
__device__ __forceinline__ float bf_hi(unsigned w) { return __builtin_bit_cast(float, w & 0xffff0000u); }
template <int CTRL> __device__ __forceinline__ float dpp_f(float v) { return __builtin_bit_cast(float, __builtin_amdgcn_update_dpp(0, __builtin_bit_cast(int, v), CTRL, 0xF, 0xF, false)); }
__device__ __forceinline__ float wave_sum(float v) {
    v += dpp_f<0xB1>(v); v += dpp_f<0x4E>(v); v += dpp_f<0x141>(v); v += dpp_f<0x140>(v);
    const float r0 = __builtin_bit_cast(float, __builtin_amdgcn_readlane(__builtin_bit_cast(int, v), 0)), r1 = __builtin_bit_cast(float, __builtin_amdgcn_readlane(__builtin_bit_cast(int, v), 16));
    const float r2 = __builtin_bit_cast(float, __builtin_amdgcn_readlane(__builtin_bit_cast(int, v), 32)), r3 = __builtin_bit_cast(float, __builtin_amdgcn_readlane(__builtin_bit_cast(int, v), 48));
    return (r0 + r1) + (r2 + r3);
}

#define XB_TMO      128
#define XB_XCNT(j)  (256  + 64 * (j))
#define XB_XSUB(j)  (1280 + 64 * (j))
#define XB_XGEN(j)  (2304 + 64 * (j))
#define XB_TOP      3328
#define XB_TOPGEN   3392
#define XCD_BAR_WORDS 3456
#define XB_SPIN_CAP (1u << 18)

__device__ __forceinline__ unsigned xb_ld(unsigned* p)              { return __hip_atomic_load(p, __ATOMIC_RELAXED, __HIP_MEMORY_SCOPE_AGENT); }
__device__ __forceinline__ unsigned xb_add(unsigned* p, unsigned v) { return __hip_atomic_fetch_add(p, v, __ATOMIC_RELAXED, __HIP_MEMORY_SCOPE_AGENT); }
__device__ __forceinline__ unsigned xb_xcc_id() { return (unsigned)__builtin_amdgcn_s_getreg((3 << 11) | 20) & 0xFu; }
#define XB_SPIN(cond, bar) do { unsigned _sp = 0; while (cond) { __builtin_amdgcn_s_sleep(6); \
    if ((++_sp & 255u) == 0u) { if (xb_ld(&(bar)[XB_TMO])) break; if (_sp > XB_SPIN_CAP) { atomicAdd(&(bar)[XB_TMO], 1u); break; } } } } while (0)

struct XcdBarrier {
    unsigned* bar; unsigned x;
    volatile LAS unsigned* st;
};

__device__ __forceinline__ XcdBarrier xcd_barrier_post(unsigned* bar, volatile LAS unsigned* st) {
    XcdBarrier b; b.bar = bar; b.x = xb_xcc_id(); b.st = st;
    if (threadIdx.x == 0) st[3] = xb_add(&bar[XB_XCNT(b.x)], 1u);
    return b;
}
__device__ __forceinline__ void xcd_barrier_complete(unsigned* bar, unsigned x, unsigned& nloc, unsigned& nx) {
    const unsigned G = gridDim.x * gridDim.y * gridDim.z;
    unsigned sum, cnt, mine, sp = 0u;
    for (;;) {
        sum = 0u; cnt = 0u; mine = 0u;
#pragma unroll
        for (unsigned j = 0; j < 16; ++j) { const unsigned c = xb_ld(&bar[XB_XCNT(j)]); sum += c; cnt += (c > 0u) ? 1u : 0u; mine = (j == x) ? c : mine; }
        if (sum == G) break;
        __builtin_amdgcn_s_sleep(1);
        if ((++sp & 255u) == 0u) { if (xb_ld(&bar[XB_TMO])) break; if (sp > XB_SPIN_CAP) { atomicAdd(&bar[XB_TMO], 1u); break; } }
    }
    nloc = mine > 0u ? mine : 1u; nx = cnt > 0u ? cnt : 1u;
}
__device__ __forceinline__ unsigned xcd_census_uniform(unsigned* bar) {
    unsigned ok = (gridDim.x == 256u) ? 1u : 0u;
#pragma unroll
    for (unsigned j = 0; j < 16; ++j) { const unsigned c = xb_ld(&bar[XB_XCNT(j)]); ok &= (c == (j < 8u ? 32u : 0u)) ? 1u : 0u; }
    return ok;
}

__device__ __forceinline__ void xcd_barrier(const XcdBarrier& b) {
    asm volatile("s_waitcnt vmcnt(0)" ::: "memory");
    __syncthreads();
    if (threadIdx.x == 0) {
        unsigned* bar = b.bar;
        __builtin_amdgcn_s_waitcnt(0);
        unsigned nloc = b.st[0], nx = b.st[1];
        if (nloc == 0u) { xcd_barrier_complete(bar, b.x, nloc, nx); b.st[0] = nloc; b.st[1] = nx; b.st[2] = xcd_census_uniform(bar); }
        const unsigned old = xb_add(&bar[XB_XSUB(b.x)], 1u);
        const unsigned gen = old / nloc;
        if (old + 1u == (gen + 1u) * nloc) {
            __builtin_amdgcn_fence(__ATOMIC_RELEASE, "agent");
            asm volatile("s_waitcnt vmcnt(0)" ::: "memory");
            const unsigned og = xb_add(&bar[XB_TOP], 1u);
            const unsigned tg = og / nx;
            if (og + 1u == (tg + 1u) * nx) xb_add(&bar[XB_TOPGEN], 1u);
            else XB_SPIN(xb_ld(&bar[XB_TOPGEN]) == tg, bar);
            __builtin_amdgcn_fence(__ATOMIC_ACQUIRE, "agent");
            xb_add(&bar[XB_XGEN(b.x)], 1u);
            asm volatile("s_waitcnt vmcnt(0)" ::: "memory");
        } else {
            XB_SPIN(xb_ld(&bar[XB_XGEN(b.x)]) == gen, bar);
            __builtin_amdgcn_fence(__ATOMIC_ACQUIRE, "agent");
            asm volatile("s_waitcnt vmcnt(0)" ::: "memory");
        }
    }
    __syncthreads();
}

__device__ __forceinline__ void xcd_local_barrier(const XcdBarrier& b) {
    asm volatile("s_waitcnt vmcnt(0)" ::: "memory");
    __syncthreads();
    if (threadIdx.x == 0) {
        unsigned* bar = b.bar;
        __builtin_amdgcn_s_waitcnt(0);
        const unsigned nloc = b.st[0];
        const unsigned old = xb_add(&bar[XB_XSUB(b.x)], 1u);
        const unsigned gen = old / nloc;
        if (old + 1u == (gen + 1u) * nloc) xb_add(&bar[XB_XGEN(b.x)], 1u);
        else XB_SPIN(xb_ld(&bar[XB_XGEN(b.x)]) == gen, bar);
        __builtin_amdgcn_fence(__ATOMIC_ACQUIRE, "agent");
        asm volatile("s_waitcnt vmcnt(0)" ::: "memory");
    }
    __syncthreads();
}

struct Params {
    const float *x, *c, *w_ada, *b_ada, *pre_g, *post_g, *w_gate, *w_up, *w_down, *w_in, *ln_g, *ln_b, *sgu_w, *sgu_b, *b_f, *gn_a, *gn_b, *w_out;
    float* out; unsigned char* ws;
};

__device__ __forceinline__ void adaln_item(const Params& p, LAS unsigned char* lds, int cgp, int tid, int lane, int wave) {
    LAS float* sc = (LAS float*)lds;
    LAS float* red = (LAS float*)(lds + 32768);
    for (int idx = tid; idx < 8192; idx += 512) { const int b = idx >> 10, k = idx & 1023; const float v = p.c[idx]; sc[k * 8 + b] = v * pg8::fast_sigmoid(v); }
    __syncthreads();
    float acc[8];
#pragma unroll
    for (int b = 0; b < 8; ++b) acc[b] = 0.f;
    const float* wp = p.w_ada + (size_t)(wave * 128) * 9216 + cgp * 64 + lane;
#pragma unroll 1
    for (int k0 = 0; k0 < 128; k0 += 32) {
        float wv[32];
#pragma unroll
        for (int k = 0; k < 32; ++k) { const float* rowp = p.w_ada + (size_t)(wave * 128 + k0 + k) * 9216 + cgp * 64;
            wv[k] = __builtin_nontemporal_load(rowp + (unsigned)lane); }
        __builtin_amdgcn_sched_barrier(0);
#pragma unroll
        for (int k = 0; k < 32; ++k) { const f32x4 s0 = *(const LAS f32x4*)(sc + (wave * 128 + k0 + k) * 8), s1 = *(const LAS f32x4*)(sc + (wave * 128 + k0 + k) * 8 + 4);
            acc[0] += s0[0] * wv[k]; acc[1] += s0[1] * wv[k]; acc[2] += s0[2] * wv[k]; acc[3] += s0[3] * wv[k]; acc[4] += s1[0] * wv[k]; acc[5] += s1[1] * wv[k]; acc[6] += s1[2] * wv[k]; acc[7] += s1[3] * wv[k];
            if ((k & 7) == 7) __builtin_amdgcn_sched_barrier(0); }
    }
#pragma unroll
    for (int b = 0; b < 8; ++b) red[(wave * 8 + b) * 64 + lane] = acc[b];
    __syncthreads();
    { const int b = wave; float s = 0.f;
#pragma unroll
      for (int w = 0; w < 8; ++w) s += red[(w * 8 + b) * 64 + lane];
      const int j = cgp * 64 + lane; ((float*)(p.ws + WS_MOD))[b * 9216 + j] = s + p.b_ada[j]; }
    __syncthreads();
}
__device__ __forceinline__ void conv_decode(const Params& p, int it, const float*& W, int& ldw, int& k0, int& n0, bf16*& WT, int& K, int& drow0, const float*& kgain) {
    constexpr int I_GU = 16 * 88, I_D = 44 * 32, I_IN = 16 * 80;
    static_assert(I_GU == I_D, "items");
    int r = it; kgain = nullptr;
    if (r < 4 * I_GU) {
        const int which = r / I_GU; r -= which * I_GU; const int f = which >> 1, up = which & 1;
        const int kb = r / 88, nb = r % 88; n0 = nb * 32; k0 = kb * 64; ldw = DFF; K = 1024;
        W = (up ? p.w_up : p.w_gate) + (size_t)f * 1024 * DFF; WT = (bf16*)(p.ws + (f ? WS_WGU1 : WS_WGU0));
        drow0 = 256 * (n0 >> 7) + (n0 & 127) + (up ? 128 : 0); return; }
    r -= 4 * I_GU;
    if (r < 2 * I_D) { const int f = r / I_D; r -= f * I_D; const int kb = r / 32, nb = r % 32;
        W = p.w_down + (size_t)f * DFF * 1024; ldw = 1024; k0 = kb * 64; n0 = nb * 32; WT = (bf16*)(p.ws + (f ? WS_WD1 : WS_WD0)); K = DFF; drow0 = nb * 32; return; }
    r -= 2 * I_D;
    if (r < I_IN) { const int kb = r / 80, nb = r % 80; W = p.w_in; ldw = NIN; k0 = kb * 64; n0 = nb * 32; WT = (bf16*)(p.ws + WS_WIN); K = 1024; drow0 = nb * 32; return; }
    r -= I_IN;
    { const int kb = r / 32, nb = r % 32;
      W = p.w_out; ldw = 1024; k0 = kb * 64; n0 = nb * 32; WT = (bf16*)(p.ws + WS_WOUT); K = 1024; drow0 = nb * 32; kgain = (kb < 8 ? p.gn_a + kb * 64 : p.gn_b + (kb - 8) * 64); }
}
__device__ __forceinline__ void conv_load(const float* W, int ldw, int k0, int n0, const float* kgain, int lane, float (&r)[32]) {
#pragma unroll
    for (int i = 0; i < 32; ++i) { const int kk = 2 * i + (lane >> 5); r[i] = __builtin_nontemporal_load(W + (size_t)(k0 + kk) * ldw + n0 + (lane & 31)); }
    if (kgain) {
#pragma unroll
        for (int i = 0; i < 32; ++i) r[i] *= kgain[2 * i + (lane >> 5)]; }
}
__device__ __forceinline__ void conv_store(const float (&r)[32], bf16* WT, int K, int drow0, int k0, LAS float* scr, int lane) {
#pragma unroll
    for (int i = 0; i < 32; ++i) { const int kk = 2 * i + (lane >> 5); scr[kk * 33 + (lane & 31)] = r[i]; }
    LDS_WAIT(); asm volatile("" ::: "memory");
    const int c = lane & 7;
#pragma unroll
    for (int j = 0; j < 4; ++j) { const int n = (lane >> 3) + 8 * j; const LAS float* s = scr + (8 * c) * 33 + n;
        v4u o; o.x = pk2(s[0 * 33], s[1 * 33]); o.y = pk2(s[2 * 33], s[3 * 33]); o.z = pk2(s[4 * 33], s[5 * 33]); o.w = pk2(s[6 * 33], s[7 * 33]);
        *(GAS v4u*)(WT + (size_t)(drow0 + n) * K + k0 + 8 * c) = o; }
    LDS_WAIT(); asm volatile("" ::: "memory");
}
__device__ __forceinline__ void convert_weights(const Params& p, LAS unsigned char* lds, int gw, int NGW, int lane, int wave) {
    LAS float* scr = (LAS float*)(lds + wave * 16384);
    constexpr int NITEMS = 6 * (16 * 88) + 16 * 80 + 16 * 32;
    int it = gw; if (it >= NITEMS) return;
    const float *Wa, *Wb, *ga, *gb; bf16 *Ta, *Tb; int la, lb, ka, kb_, na, nb_, Ka, Kb, da, db;
    float ra[32], rb[32];
    conv_decode(p, it, Wa, la, ka, na, Ta, Ka, da, ga); conv_load(Wa, la, ka, na, ga, lane, ra);
    for (;;) {
        int itn = it + NGW; bool more = itn < NITEMS;
        if (more) { conv_decode(p, itn, Wb, lb, kb_, nb_, Tb, Kb, db, gb); conv_load(Wb, lb, kb_, nb_, gb, lane, rb); }
        conv_store(ra, Ta, Ka, da, ka, scr, lane);
        if (!more) break;
        it = itn; itn = it + NGW; more = itn < NITEMS;
        if (more) { conv_decode(p, itn, Wa, la, ka, na, Ta, Ka, da, ga); conv_load(Wa, la, ka, na, ga, lane, ra); }
        conv_store(rb, Tb, Kb, db, kb_, scr, lane);
        if (!more) break;
        it = itn;
    }
}

template <int MODE, bool XIN16 = false, bool XOUT16 = false> __device__ __forceinline__ void ew_phase(const Params& p, LAS unsigned char* lds, int gw, int lane, const float* xin, int sub_res, float coef, int sub_next) {
    const int row0 = gw * 16; if (row0 >= M) return;
    asm volatile("" : "+v"(lane));
    const int b = row0 / SEQ;
    const unsigned lo = 4u * (unsigned)lane;
    const float* mod = (const float*)(p.ws + WS_MOD) + (size_t)b * 9216;
    f32x4 G[4], A[4], S[4];
    if (MODE & 1) {
#pragma unroll
        for (int j = 0; j < 4; ++j) { const unsigned col = lo + 256u * j; const f32x4 gt = *(const f32x4*)(mod + sub_res * 3072 + 2048 + col), pg = *(const f32x4*)(p.post_g + sub_res * 1024 + col); G[j] = coef * (1.0f + gt) * pg; }
        asm volatile("" : "+v"(G[0]), "+v"(G[1]), "+v"(G[2]), "+v"(G[3]) :: "memory");
    }
    if (MODE & 2) {
#pragma unroll
        for (int j = 0; j < 4; ++j) { const unsigned col = lo + 256u * j; const f32x4 sh = *(const f32x4*)(mod + sub_next * 3072 + col), scl = *(const f32x4*)(mod + sub_next * 3072 + 1024 + col), pg = *(const f32x4*)(p.pre_g + sub_next * 1024 + col);
            A[j] = pg * (1.0f + scl); S[j] = sh; }
        asm volatile("" : "+v"(A[0]), "+v"(A[1]), "+v"(A[2]), "+v"(A[3]) :: "memory");
        if (!(MODE & 4)) asm volatile("" : "+v"(S[0]), "+v"(S[1]), "+v"(S[2]), "+v"(S[3]));
    }
    const LAS f32x4* wfl = (const LAS f32x4*)lds + lane;
    const bf16* HD = (const bf16*)(p.ws + WS_HD);
    bf16* H = (bf16*)(p.ws + WS_H);
    bf16* X1 = (bf16*)(p.ws + WS_X1);
    float rs4[4] = {0.f, 0.f, 0.f, 0.f};
    if (MODE & 1) {
        const float* ss = (const float*)(p.ws + WS_SS) + row0 + (unsigned)((lane & 15) * M + (lane >> 4));
#pragma unroll
        for (int i = 0; i < 4; ++i) { float q = ss[4 * i]; q += __shfl_xor(q, 1); q += __shfl_xor(q, 2); q += __shfl_xor(q, 4); q += __shfl_xor(q, 8); rs4[i] = __builtin_amdgcn_rsqf(q * (1.0f / 1024.0f) + EPS); }
        asm volatile("" : "+v"(rs4[0]), "+v"(rs4[1]), "+v"(rs4[2]), "+v"(rs4[3]) :: "memory");
    }
    constexpr int NR = (MODE & 4) ? 1 : 2;
#pragma unroll 1
    for (int rp = 0; rp < 16 / NR; ++rp) {
        f32x4 v[NR][4]; v2u hw[NR][4];
#pragma unroll
        for (int k = 0; k < NR; ++k) { const int row = row0 + NR * rp + k;
#pragma unroll
            for (int j = 0; j < 4; ++j) {
                if (XIN16) { const v2u xw = __builtin_nontemporal_load((const v2u*)(X1 + (size_t)row * 1024 + (lo + 256u * j))); v[k][j] = (f32x4){bf_lo(xw.x), bf_hi(xw.x), bf_lo(xw.y), bf_hi(xw.y)}; }
                else v[k][j] = __builtin_nontemporal_load((const f32x4*)(xin + (size_t)row * 1024 + (lo + 256u * j)));
                if (MODE & 1) hw[k][j] = __builtin_nontemporal_load((const v2u*)(HD + (size_t)row * 1024 + (lo + 256u * j))); } }
#pragma unroll
        for (int k = 0; k < NR; ++k) { const int rr = NR * rp + k, row = row0 + rr;
            if (MODE & 1) {
                const int i = rr >> 2; const float sel = i == 0 ? rs4[0] : (i == 1 ? rs4[1] : (i == 2 ? rs4[2] : rs4[3]));
                const float rstd = __shfl(sel, (rr & 3) * 16);
#pragma unroll
                for (int j = 0; j < 4; ++j) { const f32x4 hv = (f32x4){bf_lo(hw[k][j].x), bf_hi(hw[k][j].x), bf_lo(hw[k][j].y), bf_hi(hw[k][j].y)};
                    v[k][j] = v[k][j] + G[j] * hv * rstd;
                    if (XOUT16) { v2u xw; xw.x = pk2(v[k][j][0], v[k][j][1]); xw.y = pk2(v[k][j][2], v[k][j][3]); __builtin_nontemporal_store(xw, (v2u*)(X1 + (size_t)row * 1024 + (lo + 256u * j))); }
                    else __builtin_nontemporal_store(v[k][j], (f32x4*)(p.out + (size_t)row * 1024 + (lo + 256u * j))); }
            }
            if (MODE & 2) {
                float s2 = 0.f;
#pragma unroll
                for (int j = 0; j < 4; ++j) s2 += (v[k][j][0] * v[k][j][0] + v[k][j][1] * v[k][j][1]) + (v[k][j][2] * v[k][j][2] + v[k][j][3] * v[k][j][3]);
                const float r2 = __builtin_amdgcn_rsqf(wave_sum(s2) * (1.0f / 1024.0f) + EPS);
                f32x4 hq[4];
#pragma unroll
                for (int j = 0; j < 4; ++j) { const f32x4 sj = (MODE & 4) ? *(const f32x4*)(mod + sub_next * 3072 + (lo + 256u * j)) : S[j];
                    hq[j] = v[k][j] * r2 * A[j] + sj;
                    v2u w; w.x = pk2(hq[j][0], hq[j][1]); w.y = pk2(hq[j][2], hq[j][3]);
                    *(v2u*)(H + (size_t)row * 1024 + (lo + 256u * j)) = w; }
                if (MODE & 4) {
                    f32x4 d0 = (f32x4){0.f, 0.f, 0.f, 0.f}, d1 = d0;
#pragma unroll
                    for (int j = 0; j < 4; ++j)
#pragma unroll
                        for (int e = 0; e < 4; ++e) { d0 += hq[j][e] * wfl[((j * 4 + e) * 2 + 0) * 64]; d1 += hq[j][e] * wfl[((j * 4 + e) * 2 + 1) * 64]; }
                    const bool b5 = lane & 32, b4 = lane & 16, b3 = lane & 8;
                    const f32x4 snd = b5 ? d0 : d1; f32x4 k4 = b5 ? d1 : d0;
                    k4[0] += __shfl_xor(snd[0], 32); k4[1] += __shfl_xor(snd[1], 32); k4[2] += __shfl_xor(snd[2], 32); k4[3] += __shfl_xor(snd[3], 32);
                    const float s0 = b4 ? k4[0] : k4[2], s1 = b4 ? k4[1] : k4[3]; float k0 = b4 ? k4[2] : k4[0], k1 = b4 ? k4[3] : k4[1];
                    k0 += __shfl_xor(s0, 16); k1 += __shfl_xor(s1, 16);
                    float mine = (b3 ? k1 : k0) + __shfl_xor(b3 ? k0 : k1, 8);
                    mine += dpp_f<0xB1>(mine); mine += dpp_f<0x4E>(mine); mine += dpp_f<0x141>(mine);
                    if ((lane & 7) == 0) { const int hh = lane >> 3; const float z = mine + p.b_f[hh];
                        const float ls = (z < 0.f ? z : 0.f) - 0.6931471805599453f * __builtin_amdgcn_logf(1.0f + __builtin_amdgcn_exp2f(-1.4426950408889634f * fabsf(z)));
                        ((float*)(p.ws + WS_LOGF))[((size_t)(b * 8 + hh)) * SEQ + (row - b * SEQ)] = ls; }
                }
            }
        }
    }
}
__device__ __forceinline__ void ew_fill_wf(const Params& p, LAS unsigned char* lds, int tid) {
    for (int idx = tid; idx < 2048; idx += NWAVES * 64) { const int l = idx & 63, half = (idx >> 6) & 1, e = (idx >> 7) & 3, j = idx >> 9;
        ((LAS f32x4*)lds)[idx] = *(const f32x4*)(p.w_in + (size_t)(4 * l + 256 * j + e) * NIN + 2560 + 4 * half); }
    __syncthreads();
}
__device__ __forceinline__ void scan_seq(const Params& p, int seq, int lane) {
    const float* src = (const float*)(p.ws + WS_LOGF) + (size_t)seq * SEQ + lane * 64;
    float* dst = (float*)(p.ws + WS_CUM) + (size_t)seq * SEQ + lane * 64;
    f32x4 v[16]; float run = 0.f;
#pragma unroll
    for (int i = 0; i < 16; ++i) { v[i] = *(const f32x4*)(src + 4 * i);
        run += v[i][0]; v[i][0] = run; run += v[i][1]; v[i][1] = run; run += v[i][2]; v[i][2] = run; run += v[i][3]; v[i][3] = run; }
    float incl = run;
#pragma unroll
    for (int o = 1; o < 64; o <<= 1) { const float t = __shfl_up(incl, o); if (lane >= o) incl += t; }
    const float excl = incl - run;
#pragma unroll
    for (int i = 0; i < 16; ++i) *(f32x4*)(dst + 4 * i) = (v[i] + excl) * 1.4426950408889634f;
}
constexpr int SGU_PITCH = 1044;
__device__ __forceinline__ void sgu_unit(const Params& p, LAS unsigned char* lds, int unit, int lane, int wave) {
    const int R0 = unit * 128;
    const bf16* ZG = (const bf16*)(p.ws + WS_ZG) + (size_t)(unit >> 5) * PAD_ZG;
    bf16* Y = (bf16*)(p.ws + WS_Y);
    float* ssa = (float*)(p.ws + WS_SSA);
    {
        const f32x4 g0 = *(const f32x4*)(p.ln_g + 8 * lane), g1 = *(const f32x4*)(p.ln_g + 8 * lane + 4), b0 = *(const f32x4*)(p.ln_b + 8 * lane), b1 = *(const f32x4*)(p.ln_b + 8 * lane + 4);
        v4u wv[16];
#pragma unroll
        for (int rr = 0; rr < 16; ++rr) wv[rr] = __builtin_nontemporal_load((const v4u*)(ZG + (size_t)(R0 + wave * 16 + rr) * 1024 + 512 + 8 * lane));
#pragma unroll
        for (int rr = 0; rr < 16; ++rr) { const int r = wave * 16 + rr; const v4u w = wv[rr];
            f32x4 a = (f32x4){bf_lo(w.x), bf_hi(w.x), bf_lo(w.y), bf_hi(w.y)}, c = (f32x4){bf_lo(w.z), bf_hi(w.z), bf_lo(w.w), bf_hi(w.w)};
            const float mean = wave_sum((a[0] + a[1]) + (a[2] + a[3]) + (c[0] + c[1]) + (c[2] + c[3])) * (1.0f / 512.0f);
            a = a - mean; c = c - mean;
            const float var = wave_sum((a[0] * a[0] + a[1] * a[1]) + (a[2] * a[2] + a[3] * a[3]) + (c[0] * c[0] + c[1] * c[1]) + (c[2] * c[2] + c[3] * c[3])) * (1.0f / 512.0f);
            const float rstd = __builtin_amdgcn_rsqf(var + EPS);
            a = a * rstd * g0 + b0; c = c * rstd * g1 + b1;
            LAS unsigned* d = (LAS unsigned*)(lds + r * SGU_PITCH + 16 * lane);
            d[0] = pk2(a[0], a[1]); d[1] = pk2(a[2], a[3]); d[2] = pk2(c[0], c[1]); d[3] = pk2(c[2], c[3]); }
    }
    __syncthreads();
    const int fr = lane & 15, fq = lane >> 4;
    const int h = wave;
    bf16x8 vfr[4][4];
#pragma unroll
    for (int ks = 0; ks < 4; ++ks) { const LAS unsigned short* vb = (const LAS unsigned short*)(lds + (32 * ks + 8 * fq) * SGU_PITCH + (64 * h + fr) * 2);
#pragma unroll
        for (int nt = 0; nt < 4; ++nt) { bf16x8 vf;
#pragma unroll
            for (int e = 0; e < 8; ++e) vf[e] = (short)vb[e * (SGU_PITCH / 2) + 16 * nt];
            vfr[ks][nt] = vf; } }
    const float* Wh = p.sgu_w + (size_t)h * 16384 + (size_t)fr * 128 + 8 * fq;
#pragma unroll 1
    for (int rt2 = 0; rt2 < 8; rt2 += 2) {
        f32x4 wv[2][4][2]; v2u uw[2][4]; float bs[2];
#pragma unroll
        for (int t = 0; t < 2; ++t) { const int i = (rt2 + t) * 16 + fr;
#pragma unroll
            for (int ks = 0; ks < 4; ++ks) { wv[t][ks][0] = *(const f32x4*)(Wh + (size_t)(rt2 + t) * 2048 + 32 * ks); wv[t][ks][1] = *(const f32x4*)(Wh + (size_t)(rt2 + t) * 2048 + 32 * ks + 4); }
#pragma unroll
            for (int nt = 0; nt < 4; ++nt) uw[t][nt] = __builtin_nontemporal_load((const v2u*)(ZG + (size_t)(R0 + i) * 1024 + 64 * h + 16 * nt + 4 * fq));
            bs[t] = p.sgu_b[h * 128 + i]; }
        __builtin_amdgcn_sched_barrier(0);
#pragma unroll
        for (int t = 0; t < 2; ++t) { const int i = (rt2 + t) * 16 + fr; const size_t rowoff = (size_t)(R0 + i) * 1024;
            f32x4 acc[4];
#pragma unroll
            for (int nt = 0; nt < 4; ++nt) acc[nt] = (f32x4){0.f, 0.f, 0.f, 0.f};
#pragma unroll
            for (int ks = 0; ks < 4; ++ks) if (ks < 2 || rt2 >= 4) {
                const f32x4 w0 = wv[t][ks][0], w1 = wv[t][ks][1];
                v4u wu; wu.x = pk2(w0[0], w0[1]); wu.y = pk2(w0[2], w0[3]); wu.z = pk2(w1[0], w1[1]); wu.w = pk2(w1[2], w1[3]);
                const bf16x8 wfrag = __builtin_bit_cast(bf16x8, wu);
#pragma unroll
                for (int nt = 0; nt < 4; ++nt) acc[nt] = __builtin_amdgcn_mfma_f32_16x16x32_bf16(vfr[ks][nt], wfrag, acc[nt], 0, 0, 0);
            }
            float q = 0.f;
#pragma unroll
            for (int nt = 0; nt < 4; ++nt) { const int c = 64 * h + 16 * nt + 4 * fq;
                const f32x4 uv = (f32x4){bf_lo(uw[t][nt].x), bf_hi(uw[t][nt].x), bf_lo(uw[t][nt].y), bf_hi(uw[t][nt].y)};
                const f32x4 y = uv * (acc[nt] + bs[t]);
                v2u o; o.x = pk2(y[0], y[1]); o.y = pk2(y[2], y[3]);
                const f32x4 yr = (f32x4){bf_lo(o.x), bf_hi(o.x), bf_lo(o.y), bf_hi(o.y)};
                q += (yr[0] * yr[0] + yr[1] * yr[1]) + (yr[2] * yr[2] + yr[3] * yr[3]);
                *(v2u*)(Y + rowoff + c) = o; }
            q += __shfl_xor(q, 16); q += __shfl_xor(q, 32);
            if (fq == 0) ssa[(size_t)h * M + R0 + i] = q;
        }
    }
    __syncthreads();
}
__device__ __forceinline__ void ynorm_phase(const Params& p, int gw, int lane) {
    const int row0 = gw * 16; if (row0 >= M) return;
    asm volatile("" : "+v"(lane));
    const f32x4 ga0 = *(const f32x4*)(p.gn_a + 8 * lane), ga1 = *(const f32x4*)(p.gn_a + 8 * lane + 4), gb0 = *(const f32x4*)(p.gn_b + 8 * lane), gb1 = *(const f32x4*)(p.gn_b + 8 * lane + 4);
    const float* ssa = (const float*)(p.ws + WS_SSA); const float* ssb = (const float*)(p.ws + WS_SSB);
    bf16* Y = (bf16*)(p.ws + WS_Y);
    for (int rr = 0; rr < 16; ++rr) { const int row = row0 + rr;
        float qa = 0.f, qb = 0.f;
#pragma unroll
        for (int h = 0; h < 8; ++h) { qa += ssa[(size_t)h * M + row]; qb += ssb[(size_t)h * M + row]; }
        const float ra = __builtin_amdgcn_rsqf(qa * (1.0f / 512.0f) + EPS), rb = __builtin_amdgcn_rsqf(qb * (1.0f / 512.0f) + EPS);
        v4u* pa = (v4u*)(Y + (size_t)row * 1024 + 8 * lane); v4u* pb = (v4u*)(Y + (size_t)row * 1024 + 512 + 8 * lane);
        const v4u wa = *pa, wb = *pb; v4u oa, ob;
        oa.x = pk2(bf_lo(wa.x) * ra * ga0[0], bf_hi(wa.x) * ra * ga0[1]); oa.y = pk2(bf_lo(wa.y) * ra * ga0[2], bf_hi(wa.y) * ra * ga0[3]);
        oa.z = pk2(bf_lo(wa.z) * ra * ga1[0], bf_hi(wa.z) * ra * ga1[1]); oa.w = pk2(bf_lo(wa.w) * ra * ga1[2], bf_hi(wa.w) * ra * ga1[3]);
        ob.x = pk2(bf_lo(wb.x) * rb * gb0[0], bf_hi(wb.x) * rb * gb0[1]); ob.y = pk2(bf_lo(wb.y) * rb * gb0[2], bf_hi(wb.y) * rb * gb0[3]);
        ob.z = pk2(bf_lo(wb.z) * rb * gb1[0], bf_hi(wb.z) * rb * gb1[1]); ob.w = pk2(bf_lo(wb.w) * rb * gb1[2], bf_hi(wb.w) * rb * gb1[3]);
        *pa = oa; *pb = ob; }
}

#ifndef PROBE
#define PROBE 0
#endif
#ifndef STAG_TICKS
#define STAG_TICKS 700
#endif
__device__ __forceinline__ void stagger_start(int bx) {
    const unsigned long long d = (unsigned long long)(((unsigned)bx * 97u) & 255u) * STAG_TICKS / 256u, t0 = __builtin_amdgcn_s_memrealtime();
    while (__builtin_amdgcn_s_memrealtime() - t0 < d) __builtin_amdgcn_s_sleep(8);
}
#define REPS(cond) for (int rep_ = 0; rep_ < ((cond) ? 2 : 1); ++rep_)
__global__ void __launch_bounds__(NWAVES * 64, 2) mega_fwd(Params p) {
    extern __shared__ __attribute__((aligned(16))) unsigned char lds_raw[];
    cg::grid_group grid = cg::this_grid();
    LAS unsigned char* lds = (LAS unsigned char*)lds_raw;
    if (threadIdx.x < 16) ((LAS unsigned*)(lds + LDS_BARST))[threadIdx.x] = 0u;
    __syncthreads();
    const XcdBarrier bar = xcd_barrier_post((unsigned*)(p.ws + WS_CTL), (volatile LAS unsigned*)(lds + LDS_BARST));
    if (p.ws == nullptr) grid.sync();
    const int G = gridDim.x, NGW = G * NWAVES;
    int bx = blockIdx.x;
    int cgx = blockIdx.x;
    int sid = blockIdx.x;
    bool uni = false;
#define GRID_SYNC() do { if (uni) xcd_local_barrier(bar); else xcd_barrier(bar); } while (0)
#define LANEVARS const int tid = otid(), lane = tid & 63, wave = __builtin_amdgcn_readfirstlane(tid >> 6), gw = bx * NWAVES + wave; (void)tid; (void)lane; (void)wave; (void)gw
    bf16* H = (bf16*)(p.ws + WS_H); bf16* HD = (bf16*)(p.ws + WS_HD); bf16* ACT = (bf16*)(p.ws + WS_ACT);
    float* SS = (float*)(p.ws + WS_SS);

    REPS(PROBE == 3) { LANEVARS; for (int it = bx; it < 144; it += G) adaln_item(p, lds, it, tid, lane, wave);
      convert_weights(p, lds, gw, NGW, lane, wave); __syncthreads(); }
    xcd_barrier(bar);
    { volatile LAS unsigned* st = (volatile LAS unsigned*)(lds + LDS_BARST);
      const unsigned u_ = __builtin_amdgcn_readfirstlane(st[2]), r_ = __builtin_amdgcn_readfirstlane(st[3]), x_ = bar.x;
#ifndef FORCE_FALLBACK
#define FORCE_FALLBACK 0
#endif
      if (!FORCE_FALLBACK && u_ != 0u && r_ < 32u && x_ < 8u) { uni = true; bx = (int)(x_ * 32u + r_); cgx = (int)(r_ * 8u + x_); sid = r_ < 8u ? (int)(x_ * 8u + r_) : (1 << 20); } }
    REPS(PROBE == 5) { LANEVARS; for (int g = gw; g * 16 < M; g += NGW) ew_phase<2>(p, lds, g, lane, p.x, 0, 0.f, 0); }
    GRID_SYNC();
    REPS(PROBE == 4 || PROBE >= 6) { pg8::Gemm g{H, (const bf16*)(p.ws + WS_WGU0), M, 2 * DFF, 1024}; pg8::StaticOrder S; S.init(M, 2 * DFF, G, cgx);
      pg8::EpiSwiGLU E{ACT, DFF, (rep_ == 1 && PROBE >= 6) ? PROBE - 6 : 0}; pg8::gemm_phase<pg8::EpiSwiGLU, pg8::StaticOrder, true, true>(lds, g, S, E); }
    GRID_SYNC();
    REPS(PROBE == 4) { pg8::Gemm g{ACT, (const bf16*)(p.ws + WS_WD0), M, 1024, DFF}; pg8::StaticOrder S; S.init(M, 1024, G, cgx);
      pg8::EpiBf16Ss E{HD, 1024, SS, M}; pg8::gemm_phase<pg8::EpiBf16Ss, pg8::StaticOrder, true, true>(lds, g, S, E); }
    GRID_SYNC();
    REPS(PROBE == 5) { LANEVARS; __syncthreads(); ew_fill_wf(p, lds, tid); for (int g = gw; g * 16 < M; g += NGW) ew_phase<7, false, true>(p, lds, g, lane, p.x, 0, 0.5f, 1); }
    GRID_SYNC();
    { LANEVARS; if (wave == 0) for (int s = sid; s < BATCH * HB; s += G) scan_seq(p, s, lane); }
    REPS(PROBE == 4) { pg8::Gemm g{H, (const bf16*)(p.ws + WS_WIN), M, 2560, 1024}; pg8::StaticOrder S; S.init(M, 2560, G, cgx);
      static_assert(WS_K - WS_Q == WS_V - WS_K, "qkv stride");
      pg8::EpiMixIn E{(bf16*)(p.ws + WS_ZG), (bf16*)(p.ws + WS_Q), (WS_K - WS_Q) / 2, attn_body::C2, PAD_ZG, PAD_QKV};
      pg8::gemm_phase<pg8::EpiMixIn, pg8::StaticOrder, true, true>(lds, g, S, E); }
    GRID_SYNC();
    { const attn_body::AttnTensors AT{(const attn_body::bf16*)(p.ws + WS_Q), (const attn_body::bf16*)(p.ws + WS_K), (const attn_body::bf16*)(p.ws + WS_V),
                                      (attn_body::bf16*)(p.ws + WS_Y) + 512, (const float*)(p.ws + WS_CUM), (float*)(p.ws + WS_SSB), (float*)(p.ws + WS_KPART)};
      const attn_body::StaticOrder S(G, cgx);
      attn_body::attn_pre<attn_body::StaticOrder>((char*)lds_raw, AT, S);
      { LANEVARS; for (int u = bx; u < M / 128; u += G) sgu_unit(p, lds, u, lane, wave); }
      GRID_SYNC();
      attn_body::attn_run<attn_body::StaticOrder>((char*)lds_raw, AT, S); }
    GRID_SYNC();
    { pg8::Gemm g{(const bf16*)(p.ws + WS_Y), (const bf16*)(p.ws + WS_WOUT), M, 1024, 1024}; pg8::StaticOrder S; S.init(M, 1024, G, cgx);
      LAS pg8::f32x2* tab = (LAS pg8::f32x2*)(lds + 131072);
      pg8::Unit u0{0, 0}, u1{0, 0}; const bool has0 = S.next(0, u0), has1 = S.next(1, u1); pg8::Unit u2; const bool has2 = S.next(2, u2);
      { LANEVARS; const int ui = tid >> 8, r = tid & 255; const int pmu = ui ? u1.pm : u0.pm;
        if (ui ? has1 : has0) { const float* ssa = (const float*)(p.ws + WS_SSA) + (size_t)pmu * 256 + r; const float* ssb = (const float*)(p.ws + WS_SSB) + (size_t)pmu * 256 + r; float qa = 0.f, qb = 0.f;
#pragma unroll
          for (int h = 0; h < 8; ++h) { qa += ssa[(size_t)h * M]; qb += ssb[(size_t)h * M]; }
          const float ra = __builtin_amdgcn_rsqf(qa * (1.0f / 512.0f) + EPS), rb = __builtin_amdgcn_rsqf(qb * (1.0f / 512.0f) + EPS);
          tab[ui * 256 + r] = (pg8::f32x2){ra / rb, rb}; }
        __syncthreads(); }
      if (!has2 && (!has1 || u1.pm != u0.pm)) {
        pg8::EpiRowScaleSs E{HD, 1024, SS, M, tab, u0.pm}; pg8::gemm_phase<pg8::EpiRowScaleSs, pg8::StaticOrder, true, true>(lds, g, S, E); }
    }
    GRID_SYNC();
    { LANEVARS; for (int g = gw; g * 16 < M; g += NGW) ew_phase<3, true, true>(p, lds, g, lane, p.x, 1, 1.0f, 2); }
    GRID_SYNC();
    REPS(PROBE == 4) { pg8::Gemm g{H, (const bf16*)(p.ws + WS_WGU1), M, 2 * DFF, 1024}; pg8::StaticOrder S; S.init(M, 2 * DFF, G, cgx);
      pg8::EpiSwiGLU E{ACT, DFF, 0}; pg8::gemm_phase<pg8::EpiSwiGLU, pg8::StaticOrder, true, true>(lds, g, S, E); }
    GRID_SYNC();
    REPS(PROBE == 4) { pg8::Gemm g{ACT, (const bf16*)(p.ws + WS_WD1), M, 1024, DFF}; pg8::StaticOrder S; S.init(M, 1024, G, cgx);
      pg8::EpiBf16Ss E{HD, 1024, SS, M}; pg8::gemm_phase<pg8::EpiBf16Ss, pg8::StaticOrder, true, true>(lds, g, S, E); }
    GRID_SYNC();
    { LANEVARS; for (int g = gw; g * 16 < M; g += NGW) ew_phase<1, true, false>(p, lds, g, lane, p.x, 2, 0.5f, 0); }
}

extern "C" void kernel_launch(void* const* d_in, const int* in_sizes, int n_in, void* d_out, int out_size, void* d_ws, size_t ws_size, hipStream_t stream) {
    static int grid = 0;
    if (grid == 0) {
        if (n_in != 18 || out_size != M * 1024 || ws_size < WS_END) { fprintf(stderr, "kernel_launch: unexpected problem shape (n_in %d out %d ws %zu)\n", n_in, out_size, ws_size); grid = -1; return; }
        int dev = 0, cus = 0, per_cu = 0;
        (void)hipGetDevice(&dev); (void)hipDeviceGetAttribute(&cus, hipDeviceAttributeMultiprocessorCount, dev);
        if (hipFuncSetAttribute((const void*)mega_fwd, hipFuncAttributeMaxDynamicSharedMemorySize, LDS_BYTES) != hipSuccess) { fprintf(stderr, "kernel_launch: hipFuncSetAttribute failed\n"); grid = -1; return; }
        if (hipOccupancyMaxActiveBlocksPerMultiprocessor(&per_cu, (const void*)mega_fwd, NWAVES * 64, LDS_BYTES) != hipSuccess || per_cu < 1) { fprintf(stderr, "kernel_launch: occupancy query says %d\n", per_cu); per_cu = 1; }
        (void)hipGetLastError();
        grid = cus * 1;
        if (grid <= 0) grid = 256;
    }
    if (grid < 0) return;
    if (hipMemsetAsync((char*)d_ws + WS_CTL, 0, CTL_BYTES, stream) != hipSuccess) { fprintf(stderr, "kernel_launch: memset failed\n"); return; }
    Params p{};
    p.x = (const float*)d_in[0]; p.c = (const float*)d_in[1]; p.w_ada = (const float*)d_in[2]; p.b_ada = (const float*)d_in[3]; p.pre_g = (const float*)d_in[4]; p.post_g = (const float*)d_in[5];
    p.w_gate = (const float*)d_in[6]; p.w_up = (const float*)d_in[7]; p.w_down = (const float*)d_in[8]; p.w_in = (const float*)d_in[9]; p.ln_g = (const float*)d_in[10]; p.ln_b = (const float*)d_in[11];
    p.sgu_w = (const float*)d_in[12]; p.sgu_b = (const float*)d_in[13]; p.b_f = (const float*)d_in[14]; p.gn_a = (const float*)d_in[15]; p.gn_b = (const float*)d_in[16]; p.w_out = (const float*)d_in[17];
    p.out = (float*)d_out; p.ws = (unsigned char*)d_ws;
    void* args[] = {&p};
    hipError_t e = hipLaunchCooperativeKernel((const void*)mega_fwd, dim3(grid), dim3(NWAVES * 64), args, LDS_BYTES, stream);
    if (e != hipSuccess) fprintf(stderr, "kernel_launch: cooperative launch failed: %s (grid %d)\n", hipGetErrorString(e), grid);
}
```
